# Optimizing an MI355X kernel written in HIP

```python
import math
import jax, jax.numpy as jnp
from jax import lax
import numpy as np


D_MODEL = 1024
BATCH = 32
SEQ = 2048
DEPTH = 2

N_MIXERS = 2
N_HEADS = 8
HEAD_DIM = 64
V_DIM = 2 * HEAD_DIM
Q_BLOCK = 128
ROPE_THETA = 10000.0
CONV_WIDTH = 3
D_FF = 2816
RMS_EPS = 1e-5
N_ATTN_LAYERS = (DEPTH + N_MIXERS - 1) // N_MIXERS
N_CONV_LAYERS = (DEPTH + N_MIXERS - 2) // N_MIXERS

kernel_name = 'hybrid_diffattn_shortconv_encoder'


def rms_norm(x, g):
    xf = x.astype(jnp.float32)
    y = xf * lax.rsqrt(jnp.mean(xf * xf, axis=-1, keepdims=True) + RMS_EPS)
    return (y * g.astype(jnp.float32)).astype(x.dtype)


def dwconv3(x, w):
    xp = jnp.pad(x, ((0, 0), (1, 1), (0, 0)))
    return xp[:, :-2] * w[0] + xp[:, 1:-1] * w[1] + xp[:, 2:] * w[2]


def rotary_cos_sin(positions, dim):
    inv_freq = ROPE_THETA ** (-jnp.arange(0, dim, 2, dtype=jnp.float32) / dim)
    ang = positions.astype(jnp.float32)[..., None] * inv_freq
    return jnp.cos(ang), jnp.sin(ang)


def apply_rotary(x, cos, sin):
    x1, x2 = jnp.split(x.astype(jnp.float32), 2, axis=-1)
    c = cos[:, :, None, :]
    s = sin[:, :, None, :]
    return jnp.concatenate([x1 * c - x2 * s, x2 * c + x1 * s], axis=-1).astype(x.dtype)


def diff_attention(h, positions, w_qkv, lq1, lk1, lq2, lk2, subln_g, w_o, lambda_init):
    B, S, _ = h.shape
    q, k, v = jnp.split(h @ w_qkv, 3, axis=-1)
    q = q.reshape(B, S, 2 * N_HEADS, HEAD_DIM)
    k = k.reshape(B, S, 2 * N_HEADS, HEAD_DIM)
    v = v.reshape(B, S, N_HEADS, V_DIM)
    cos, sin = rotary_cos_sin(positions, HEAD_DIM)
    q = apply_rotary(q, cos, sin) * (HEAD_DIM ** -0.5)
    k = apply_rotary(k, cos, sin)
    q = q.reshape(B, S, N_HEADS, 2, HEAD_DIM)
    k = k.reshape(B, S, N_HEADS, 2, HEAD_DIM)
    lq1f, lk1f = lq1.astype(jnp.float32), lk1.astype(jnp.float32)
    lq2f, lk2f = lq2.astype(jnp.float32), lk2.astype(jnp.float32)
    lam = jnp.exp(jnp.sum(lq1f * lk1f)) - jnp.exp(jnp.sum(lq2f * lk2f)) + lambda_init
    nb = S // Q_BLOCK
    qb = q.reshape(B, nb, Q_BLOCK, N_HEADS, 2, HEAD_DIM).transpose(1, 0, 2, 3, 4, 5)

    def attend(q_blk):
        s = jnp.einsum('bqhcd,bkhcd->bhcqk', q_blk, k, preferred_element_type=jnp.float32)
        p = jax.nn.softmax(s, axis=-1)
        a = p[:, :, 0] - lam * p[:, :, 1]
        return jnp.einsum('bhqk,bkhe->bqhe', a.astype(v.dtype), v)

    o = lax.map(attend, qb)
    o = o.transpose(1, 0, 2, 3, 4).reshape(B, S, N_HEADS, V_DIM)
    o = rms_norm(o, subln_g) * (1.0 - lambda_init)
    return o.reshape(B, S, N_HEADS * V_DIM) @ w_o


def short_conv_mixer(h, w_in, conv_w, w_out):
    b, c, u = jnp.split(h @ w_in, 3, axis=-1)
    return (b * dwconv3(c * u, conv_w)) @ w_out


def conv_ffn(h, w_up, conv_w, conv_b, w_down):
    u = dwconv3(h @ w_up, conv_w) + conv_b
    gate, val = jnp.split(u, 2, axis=-1)
    return (jax.nn.silu(gate) * val) @ w_down


def setup_inputs(seed: int = 0) -> dict:
    key = jax.random.key(seed)
    ks = jax.random.split(key, 24)

    def nrm(k, shape, scale):
        return jax.random.normal(k, shape, dtype=jnp.float32) * scale

    NA, NC, L = N_ATTN_LAYERS, N_CONV_LAYERS, DEPTH
    x = nrm(ks[0], (BATCH, SEQ, D_MODEL), 1.0)
    positions = jnp.broadcast_to(jnp.arange(SEQ, dtype=jnp.int32), (BATCH, SEQ))
    return {
        'x': x,
        'positions': positions,
        'attn_norm_g': 1.0 + nrm(ks[1], (NA, D_MODEL), 0.02),
        'attn_w_qkv': nrm(ks[2], (NA, D_MODEL, 3 * D_MODEL), D_MODEL ** -0.5),
        'attn_lambda_q1': nrm(ks[3], (NA, HEAD_DIM), 0.1),
        'attn_lambda_k1': nrm(ks[4], (NA, HEAD_DIM), 0.1),
        'attn_lambda_q2': nrm(ks[5], (NA, HEAD_DIM), 0.1),
        'attn_lambda_k2': nrm(ks[6], (NA, HEAD_DIM), 0.1),
        'attn_subln_g': 1.0 + nrm(ks[7], (NA, V_DIM), 0.02),
        'attn_w_o': nrm(ks[8], (NA, D_MODEL, D_MODEL), D_MODEL ** -0.5),
        'conv_norm_g': 1.0 + nrm(ks[9], (NC, D_MODEL), 0.02),
        'conv_w_in': nrm(ks[10], (NC, D_MODEL, 3 * D_MODEL), D_MODEL ** -0.5),
        'conv_w': nrm(ks[11], (NC, CONV_WIDTH, D_MODEL), CONV_WIDTH ** -0.5),
        'conv_w_out': nrm(ks[12], (NC, D_MODEL, D_MODEL), D_MODEL ** -0.5),
        'ffn_norm_g': 1.0 + nrm(ks[13], (L, D_MODEL), 0.02),
        'ffn_w_up': nrm(ks[14], (L, D_MODEL, 2 * D_FF), D_MODEL ** -0.5),
        'ffn_conv_w': nrm(ks[15], (L, CONV_WIDTH, 2 * D_FF), CONV_WIDTH ** -0.5),
        'ffn_conv_b': nrm(ks[16], (L, 2 * D_FF), 0.02),
        'ffn_w_down': nrm(ks[17], (L, D_FF, D_MODEL), D_FF ** -0.5),
        'final_norm_g': 1.0 + nrm(ks[18], (D_MODEL,), 0.02),
    }


def reference(x, positions, attn_norm_g, attn_w_qkv, attn_lambda_q1, attn_lambda_k1, attn_lambda_q2, attn_lambda_k2, attn_subln_g, attn_w_o, conv_norm_g, conv_w_in, conv_w, conv_w_out, ffn_norm_g, ffn_w_up, ffn_conv_w, ffn_conv_b, ffn_w_down, final_norm_g):
    for i in range(DEPTH):
        if i % N_MIXERS == 0:
            a = i // N_MIXERS
            lambda_init = 0.8 - 0.6 * math.exp(-0.3 * i)
            h = rms_norm(x, attn_norm_g[a])
            x = x + diff_attention(h, positions, attn_w_qkv[a], attn_lambda_q1[a], attn_lambda_k1[a],
                                   attn_lambda_q2[a], attn_lambda_k2[a], attn_subln_g[a], attn_w_o[a],
                                   lambda_init)
        else:
            c = i // N_MIXERS
            h = rms_norm(x, conv_norm_g[c])
            x = x + short_conv_mixer(h, conv_w_in[c], conv_w[c], conv_w_out[c])
        h = rms_norm(x, ffn_norm_g[i])
        x = x + conv_ffn(h, ffn_w_up[i], ffn_conv_w[i], ffn_conv_b[i], ffn_w_down[i])
    return rms_norm(x, final_norm_g)
```

```cpp
#include <hip/hip_runtime.h>
#include <hip/hip_cooperative_groups.h>
#include <cstdio>
#include <cstdint>
namespace pg8 {
#define PG8_LAS __attribute__((address_space(3)))
typedef unsigned short bf16_t;
typedef short bf16x8 __attribute__((ext_vector_type(8)));
typedef float f32x4 __attribute__((ext_vector_type(4)));
typedef unsigned u32x4 __attribute__((ext_vector_type(4)));
constexpr int BM = 256, BK = 64, HALF = 128, HTB = HALF * BK * 2  , STAGE_BYTES = 8 * HTB, NXCD = 8, WGM = 8;

__host__ __device__ __forceinline__ int lds_byte(int r, int c) { const int st = (r >> 4) * 2 + (c >> 5), rr = r & 15, cc = c & 31, ob = rr * 64 + cc * 2; return st * 1024 + (ob ^ (((ob >> 9) & 1) << 5)); }
__host__ __device__ __forceinline__ void stage_rc(int b, int& R, int& C) { const int st = b / 1024, sb = b % 1024, swz = sb ^ (((sb >> 9) & 1) << 5); R = (st >> 1) * 16 + swz / 64; C = (st & 1) * 32 + (swz % 64) / 2; }
__host__ __device__ __forceinline__ int perm32(int rho) { const int n = rho >> 4, i = rho & 15; return 8 * (i >> 2) + 4 * n + (i & 3); }

struct Unit { int pm, pn; };
struct Gemm { const bf16_t* A; const bf16_t* Bt; int M, N, K; };

struct StaticOrder {
    int nM, nN, nwg, G, c;
    __host__ __device__ void init(int M, int N, int G_, int c_) { nM = M / BM; nN = N / BM; nwg = nM * nN; G = G_; c = c_; }
    __host__ __device__ bool next(int i, Unit& u) const {
        const long L = (long)i * G + c; if (L >= nwg) return false;
        int wgid = (int)L; { const int q = nwg / NXCD, r = nwg % NXCD, xcd = wgid % NXCD, off = wgid / NXCD; wgid = (xcd < r ? xcd * (q + 1) : r * (q + 1) + (xcd - r) * q) + off; }
        const int nig = WGM * nN, gid = wgid / nig, fm = gid * WGM, gsz = (nM - fm) < WGM ? (nM - fm) : WGM;
        u.pm = fm + ((wgid % nig) % gsz); u.pn = (wgid % nig) / gsz; return true;
    }
    __device__ __forceinline__ void a_ready(const Unit&) const {}
    __device__ __forceinline__ void done(const Unit&) const {}
};

__device__ __forceinline__ unsigned cvt_pk_bf16(float lo, float hi) { unsigned r; asm volatile("v_cvt_pk_bf16_f32 %0, %1, %2" : "=v"(r) : "v"(lo), "v"(hi)); return r; }
typedef float f32x2 __attribute__((ext_vector_type(2)));

__device__ __forceinline__ float row_rstd(const float* ssq, int row) {
    const f32x4* p = (const f32x4*)(ssq + (size_t)row * 16);
    const f32x4 a = p[0], b = p[1], c = p[2], d = p[3];
    const float s = (((a[0] + a[1]) + (a[2] + a[3])) + ((b[0] + b[1]) + (b[2] + b[3]))) + (((c[0] + c[1]) + (c[2] + c[3])) + ((d[0] + d[1]) + (d[2] + d[3])));
    return __builtin_amdgcn_rsqf(s * (1.0f / 1024.0f) + 1e-5f);
}
struct EpiRope {
    static constexpr bool PERM = true, AFTER_DRAIN = false;
    bf16_t* Q; bf16_t* K; bf16_t* V; const float* ssq; const float* tcos; const float* tsin; float qscale;
    __device__ __forceinline__ void operator()(const f32x4 (&acc)[2][2][4][2], const Unit& u, int wr, int wc, int fr, int fq) const {
        const int t = u.pn >> 2;
        const int colt = (u.pn & 3) * BM + wc * 32 + 8 * fq;
        const int row0 = u.pm * BM + wr * 64 + fr;
        const int fi = 4 * ((wc & 1) * 4 + fq);
        if (t < 2) {
            bf16_t* base = (t == 0) ? Q : K; const float sc = (t == 0) ? qscale : 1.f;
#pragma unroll
            for (int ai = 0; ai < 2; ++ai)
#pragma unroll
                for (int m = 0; m < 4; ++m) {
                    const int row = row0 + ai * HALF + m * 16;
                    const float rs = row_rstd(ssq, row) * sc;
                    bf16_t* rowp = base + (size_t)row * 1024 + colt;
                    const f32x4 c4 = *(const f32x4*)(tcos + (size_t)row * 32 + fi), s4 = *(const f32x4*)(tsin + (size_t)row * 32 + fi);
#pragma unroll
                    for (int bj = 0; bj < 2; ++bj) {
                        const f32x4 x1 = acc[ai][bj][m][0] * rs, x2 = acc[ai][bj][m][1] * rs;
                        const f32x4 y1 = x1 * c4 - x2 * s4, y2 = x2 * c4 + x1 * s4;
                        u32x4 w; w.x = cvt_pk_bf16(y1[0], y1[1]); w.y = cvt_pk_bf16(y1[2], y1[3]); w.z = cvt_pk_bf16(y2[0], y2[1]); w.w = cvt_pk_bf16(y2[2], y2[3]);
                        *(u32x4*)(rowp + bj * HALF) = w;
                    }
                }
        } else {
#pragma unroll
            for (int ai = 0; ai < 2; ++ai)
#pragma unroll
                for (int m = 0; m < 4; ++m) {
                    const int row = row0 + ai * HALF + m * 16;
                    const float rs = row_rstd(ssq, row);
                    bf16_t* rowp = V + (size_t)row * 1024 + colt;
#pragma unroll
                    for (int bj = 0; bj < 2; ++bj) {
                        const f32x4 v0 = acc[ai][bj][m][0] * rs, v1 = acc[ai][bj][m][1] * rs;
                        u32x4 w; w.x = cvt_pk_bf16(v0[0], v0[1]); w.y = cvt_pk_bf16(v0[2], v0[3]); w.z = cvt_pk_bf16(v1[0], v1[1]); w.w = cvt_pk_bf16(v1[2], v1[3]);
                        *(u32x4*)(rowp + bj * HALF) = w;
                    }
                }
        }
    }
};
struct EpiScale {
    static constexpr bool PERM = true, AFTER_DRAIN = false;
    bf16_t* O; int ldc; const float* ssq; int row_off;
    __device__ __forceinline__ void operator()(const f32x4 (&acc)[2][2][4][2], const Unit& u, int wr, int wc, int fr, int fq) const {
        const int row0 = u.pm * BM + wr * 64 + fr, col0 = u.pn * BM + wc * 32 + 8 * fq;
#pragma unroll
        for (int ai = 0; ai < 2; ++ai)
#pragma unroll
            for (int m = 0; m < 4; ++m) {
                const int row = row0 + ai * HALF + m * 16;
                const float rs = row_rstd(ssq, row_off + row);
                bf16_t* rowp = O + (size_t)row * ldc + col0;
#pragma unroll
                for (int bj = 0; bj < 2; ++bj) {
                    const f32x4 v0 = acc[ai][bj][m][0] * rs, v1 = acc[ai][bj][m][1] * rs;
                    u32x4 w; w.x = cvt_pk_bf16(v0[0], v0[1]); w.y = cvt_pk_bf16(v0[2], v0[3]); w.z = cvt_pk_bf16(v1[0], v1[1]); w.w = cvt_pk_bf16(v1[2], v1[3]);
                    *(u32x4*)(rowp + bj * HALF) = w;
                }
            }
    }
};
struct EpiRes {
    static constexpr bool PERM = false, AFTER_DRAIN = false;
    const float* base; float* out; bf16_t* xb; float* ssq_out;
    __device__ __forceinline__ void operator()(const f32x4 (&acc)[2][2][4][2], const Unit& u, int wr, int wc, int fr, int fq) const {
        typedef unsigned u32x2v __attribute__((ext_vector_type(2)));
        const int row0 = u.pm * BM + wr * 64 + fr, col0 = u.pn * BM + wc * 32 + 4 * fq;
#pragma unroll
        for (int ai = 0; ai < 2; ++ai)
#pragma unroll
            for (int m = 0; m < 4; ++m) {
                const int row = row0 + ai * HALF + m * 16; const size_t off = (size_t)row * 1024 + col0; float ss = 0.f;
#pragma unroll
                for (int bj = 0; bj < 2; ++bj)
#pragma unroll
                    for (int n = 0; n < 2; ++n) {
                        const f32x4 bs = *(const f32x4*)(base + off + bj * HALF + n * 16);
                        const f32x4 o = bs + acc[ai][bj][m][n];
                        *(f32x4*)(out + off + bj * HALF + n * 16) = o;
                        ss += (o[0] * o[0] + o[1] * o[1]) + (o[2] * o[2] + o[3] * o[3]);
                        if (xb) { u32x2v w; w.x = cvt_pk_bf16(o[0], o[1]); w.y = cvt_pk_bf16(o[2], o[3]); *(u32x2v*)(xb + off + bj * HALF + n * 16) = w; }
                    }
                ss += __shfl_xor(ss, 16); ss += __shfl_xor(ss, 32);
                if (fq == 0) ssq_out[(size_t)row * 16 + u.pn * 4 + wc] = ss;
            }
    }
};
template <class Epi, class Sched, bool ALIGN_EPI = false, bool SP2 = false>
__device__ __forceinline__ void gemm_phase(PG8_LAS unsigned char* lds, const Gemm g, const Sched& S, const Epi& E) {
    int tid = threadIdx.x; asm volatile("" : "+v"(tid));
    const int wid = __builtin_amdgcn_readfirstlane(tid >> 6), lane = tid & 63, wr = wid >> 2, wc = wid & 3, fr = lane & 15, fq = lane >> 4;
    const int K = g.K, nt = K / BK;
    unsigned voffA[2], voffB[2];
#pragma unroll
    for (int i = 0; i < 2; ++i) { int R, C; stage_rc(tid * 16 + i * 8192, R, C); const int Rb = Epi::PERM ? ((R & ~31) + perm32(R & 31)) : R;
        voffA[i] = (unsigned)(R * K + C) * 2u; voffB[i] = (unsigned)(Rb * K + C) * 2u; }
    const size_t kstep = (size_t)(BK * 2);
    const size_t hstep = (size_t)HALF * K * 2;
    const size_t tstep = 2 * hstep;
    const unsigned ldsw = (unsigned)wid * 1024u;
    const int aoff = lds_byte(wr * 64 + fr, fq * 8), boff = lds_byte(wc * 32 + fr, fq * 8);
#define PG8_SA(b, h) (((b) * 2 + (h)) * HTB)
#define PG8_SB(b, h) ((4 + (b) * 2 + (h)) * HTB)
#define PG8_STAGE(bufoff, gbase, voff) do { _Pragma("unroll") for (int _i = 0; _i < 2; ++_i) \
        __builtin_amdgcn_global_load_lds((const unsigned*)((const char*)(gbase) + (voff)[_i]), (PG8_LAS unsigned*)(lds + (bufoff) + ldsw + _i * 8192), 16, 0, 0); } while (0)
#define PG8_LDA(dst, b, h) do { _Pragma("unroll") for (int m = 0; m < 4; ++m) _Pragma("unroll") for (int k = 0; k < 2; ++k) dst[m][k] = *(const PG8_LAS bf16x8*)(lds + PG8_SA(b, h) + aoff + m * 2048 + k * 1024); } while (0)
#define PG8_LDB(dst, b, h) do { _Pragma("unroll") for (int n = 0; n < 2; ++n) _Pragma("unroll") for (int k = 0; k < 2; ++k) dst[n][k] = *(const PG8_LAS bf16x8*)(lds + PG8_SB(b, h) + boff + n * 2048 + k * 1024); } while (0)
#define PG8_MMA(ai, bj, At, Bt) do { __builtin_amdgcn_s_setprio(1); _Pragma("unroll") for (int m = 0; m < 4; ++m) _Pragma("unroll") for (int n = 0; n < 2; ++n) _Pragma("unroll") for (int k = 0; k < 2; ++k) \
        acc[ai][bj][m][n] = __builtin_amdgcn_mfma_f32_16x16x32_bf16(Bt[n][k], At[m][k], acc[ai][bj][m][n], 0, 0, 0); __builtin_amdgcn_s_setprio(0); } while (0)
#define PG8_WAIT_V(n) asm volatile("s_waitcnt vmcnt(" #n ")" ::: "memory")
#define PG8_WAIT_L(n) asm volatile("s_waitcnt lgkmcnt(" #n ")" ::: "memory")
#define PG8_BAR __builtin_amdgcn_s_barrier()
#define PG8_SCHED __builtin_amdgcn_sched_barrier(0)
    Unit cur, nxt; int ui = 0;
    if (!S.next(0, cur)) return;
    f32x4 acc[2][2][4][2];
#pragma unroll
    for (int a = 0; a < 2; ++a)
#pragma unroll
        for (int b = 0; b < 2; ++b)
#pragma unroll
            for (int m = 0; m < 4; ++m)
#pragma unroll
                for (int n = 0; n < 2; ++n) acc[a][b][m][n] = (f32x4){0.f, 0.f, 0.f, 0.f};
    bf16x8 At[4][2], B0[2][2], B1[2][2];
    const char* cA = (const char*)g.A + (size_t)cur.pm * tstep; const char* cB = (const char*)g.Bt + (size_t)cur.pn * tstep;
    S.a_ready(cur);
    if constexpr (SP2) {
        PG8_STAGE(PG8_SB(0, 0), cB, voffB); PG8_STAGE(PG8_SB(0, 1), cB + hstep, voffB); PG8_STAGE(PG8_SA(0, 0), cA, voffA); PG8_STAGE(PG8_SA(0, 1), cA + hstep, voffA);
        if (wr == 1) PG8_BAR;
        PG8_WAIT_V(2); PG8_BAR;
        PG8_STAGE(PG8_SB(1, 0), cB + kstep, voffB); PG8_STAGE(PG8_SA(1, 0), cA + kstep, voffA); PG8_STAGE(PG8_SB(1, 1), cB + hstep + kstep, voffB);
        PG8_WAIT_V(6); PG8_BAR;
    } else {
        PG8_STAGE(PG8_SB(0, 0), cB, voffB); PG8_STAGE(PG8_SA(0, 0), cA, voffA); PG8_STAGE(PG8_SB(0, 1), cB + hstep, voffB); PG8_STAGE(PG8_SA(0, 1), cA + hstep, voffA);
        if (wr == 1) PG8_BAR;
        PG8_WAIT_V(4); PG8_BAR;
        PG8_STAGE(PG8_SB(1, 0), cB + kstep, voffB); PG8_STAGE(PG8_SA(1, 0), cA + kstep, voffA); PG8_STAGE(PG8_SB(1, 1), cB + hstep + kstep, voffB);
        PG8_WAIT_V(6); PG8_BAR;
    }
    for (;;) {
        const bool has_next = S.next(ui + 1, nxt);
        const char* nA = has_next ? (const char*)g.A + (size_t)nxt.pm * tstep : cA; const char* nB = has_next ? (const char*)g.Bt + (size_t)nxt.pn * tstep : cB;
        for (int t = 0; t < nt; t += 2) {
            const bool last = (t == nt - 2);
            const char* a1 = cA + (size_t)(t + 1) * kstep;
            const char* a2 = last ? nA : cA + (size_t)(t + 2) * kstep; const char* b2 = last ? nB : cB + (size_t)(t + 2) * kstep;
            const char* a3 = a2 + kstep; const char* b3 = b2 + kstep;
            if (last && has_next) S.a_ready(nxt);
            if constexpr (SP2) {
            PG8_LDB(B0, 0, 0); PG8_LDB(B1, 0, 1); PG8_SCHED; PG8_LDA(At, 0, 0); PG8_STAGE(PG8_SA(1, 1), a1 + hstep, voffA);
            PG8_WAIT_V(8); PG8_WAIT_L(0); PG8_BAR; PG8_MMA(0, 0, At, B0); PG8_MMA(0, 1, At, B1); PG8_BAR; PG8_SCHED;
            PG8_LDA(At, 0, 1); PG8_STAGE(PG8_SB(0, 0), b2, voffB); PG8_STAGE(PG8_SB(0, 1), b2 + hstep, voffB); PG8_STAGE(PG8_SA(0, 0), a2, voffA);
            PG8_WAIT_V(8); PG8_WAIT_L(0); PG8_BAR; PG8_MMA(1, 0, At, B0); PG8_MMA(1, 1, At, B1); PG8_BAR; PG8_SCHED;
            PG8_LDB(B0, 1, 0); PG8_LDB(B1, 1, 1); PG8_SCHED; PG8_LDA(At, 1, 0); PG8_STAGE(PG8_SA(0, 1), a2 + hstep, voffA);
            PG8_WAIT_V(8); PG8_WAIT_L(0); PG8_BAR; PG8_MMA(0, 0, At, B0); PG8_MMA(0, 1, At, B1); PG8_BAR; PG8_SCHED;
            PG8_LDA(At, 1, 1); PG8_STAGE(PG8_SB(1, 0), b3, voffB); PG8_STAGE(PG8_SB(1, 1), b3 + hstep, voffB); PG8_STAGE(PG8_SA(1, 0), a3, voffA);
            PG8_WAIT_V(8); PG8_WAIT_L(0); PG8_BAR; PG8_MMA(1, 0, At, B0); PG8_MMA(1, 1, At, B1); PG8_BAR; PG8_SCHED;
            } else {
            PG8_LDB(B0, 0, 0); PG8_SCHED; PG8_LDA(At, 0, 0); PG8_STAGE(PG8_SA(1, 1), a1 + hstep, voffA);
            PG8_WAIT_L(8); PG8_BAR; PG8_WAIT_L(0); PG8_MMA(0, 0, At, B0); PG8_BAR; PG8_SCHED;
            PG8_LDB(B1, 0, 1); PG8_STAGE(PG8_SB(0, 0), b2, voffB);
            PG8_BAR; PG8_WAIT_L(0); PG8_MMA(0, 1, At, B1); PG8_BAR;
            PG8_LDA(At, 0, 1); PG8_STAGE(PG8_SA(0, 0), a2, voffA);
            PG8_BAR; PG8_WAIT_L(0); PG8_MMA(1, 0, At, B0); PG8_BAR; PG8_SCHED;
            PG8_STAGE(PG8_SB(0, 1), b2 + hstep, voffB);
            PG8_WAIT_V(6); PG8_BAR; PG8_MMA(1, 1, At, B1); PG8_BAR;
            PG8_LDB(B0, 1, 0); PG8_SCHED; PG8_LDA(At, 1, 0); PG8_STAGE(PG8_SA(0, 1), a2 + hstep, voffA);
            PG8_WAIT_L(8); PG8_BAR; PG8_WAIT_L(0); PG8_MMA(0, 0, At, B0); PG8_BAR; PG8_SCHED;
            PG8_LDB(B1, 1, 1); PG8_STAGE(PG8_SB(1, 0), b3, voffB);
            PG8_BAR; PG8_WAIT_L(0); PG8_MMA(0, 1, At, B1); PG8_BAR;
            PG8_LDA(At, 1, 1); PG8_STAGE(PG8_SA(1, 0), a3, voffA);
            PG8_BAR; PG8_WAIT_L(0); PG8_MMA(1, 0, At, B0); PG8_BAR; PG8_SCHED;
            PG8_STAGE(PG8_SB(1, 1), b3 + hstep, voffB);
            PG8_WAIT_V(6); PG8_BAR; PG8_MMA(1, 1, At, B1); PG8_BAR;
            }
        }
        if constexpr (ALIGN_EPI) { if (wr == 0) PG8_BAR; }
        if constexpr (!Epi::AFTER_DRAIN) { E(acc, cur, wr, wc, fr, fq); S.done(cur); }
        if (!has_next) break;
#pragma unroll
        for (int a = 0; a < 2; ++a)
#pragma unroll
            for (int b = 0; b < 2; ++b)
#pragma unroll
                for (int m = 0; m < 4; ++m)
#pragma unroll
                    for (int n = 0; n < 2; ++n) acc[a][b][m][n] = (f32x4){0.f, 0.f, 0.f, 0.f};
        cur = nxt; cA = nA; cB = nB; ++ui;
        if constexpr (ALIGN_EPI) { if (wr == 1) PG8_BAR; }
    }
    PG8_WAIT_V(0);
    if constexpr (!ALIGN_EPI) { if (wr == 0) PG8_BAR; }
    PG8_BAR;
    if constexpr (Epi::AFTER_DRAIN) { E.fused(acc, cur, wr, wc, fr, fq, lds, wid, lane); S.done(cur); }
#undef PG8_SA
#undef PG8_SB
#undef PG8_STAGE
#undef PG8_LDA
#undef PG8_LDB
#undef PG8_MMA
#undef PG8_WAIT_V
#undef PG8_WAIT_L
#undef PG8_BAR
#undef PG8_SCHED
}
}

namespace att {
typedef unsigned short bf16_t;
using bf16x8 = __attribute__((ext_vector_type(8))) short;
using s16x4  = __attribute__((ext_vector_type(4))) short;
using f32x16 = __attribute__((ext_vector_type(16))) float;
using u32x4  = __attribute__((ext_vector_type(4))) unsigned;
using f32x4a = __attribute__((ext_vector_type(4))) float;
constexpr int DV = 128, DQK = 64, NW = 8, QBLK = 32, KVBLK = 64, LD = 1024, SEQ = 2048;
constexpr int SHM_V = KVBLK * DV * 2, SHM_K = KVBLK * DQK * 2, OFF_V = 0, OFF_K = 2 * SHM_V, OFF_WS = OFF_K + 2 * SHM_K, SHM_TOTAL = OFF_WS + NW * 64 * 4;
constexpr float THR2 = 11.5f;
#define AKSW(row, colB) ((row) * 128 + ((colB) ^ ((((row) >> 1) & 7) << 4)))
#define ASBAR() __builtin_amdgcn_sched_barrier(0)
__device__ __forceinline__ int crow(int r, int hi) { return (r & 3) + 8 * (r >> 2) + 4 * hi; }
__device__ __forceinline__ unsigned cvtpk(float lo, float hi) { unsigned r; asm volatile("v_cvt_pk_bf16_f32 %0, %1, %2" : "=v"(r) : "v"(lo), "v"(hi)); return r; }

__device__ __forceinline__ void partialSM(f32x16& p0, f32x16& p1, float& m_reg, float& mn, float& alpha) {
  float pmax = p0[0];
#pragma unroll
  for (int r = 1; r < 16; ++r) pmax = fmaxf(pmax, p0[r]);
#pragma unroll
  for (int r = 0; r < 16; ++r) pmax = fmaxf(pmax, p1[r]);
  { auto rr = __builtin_amdgcn_permlane32_swap(__float_as_uint(pmax), __float_as_uint(pmax), false, false);
    pmax = fmaxf(__uint_as_float(rr[0]), __uint_as_float(rr[1])); }
  if (__builtin_expect(__all(pmax - m_reg <= THR2), 1)) { mn = m_reg; alpha = 1.f; }
  else { mn = fmaxf(m_reg, pmax); alpha = __builtin_amdgcn_exp2f(m_reg - mn); m_reg = mn; }
#pragma unroll
  for (int r = 0; r < 16; ++r) p0[r] = p0[r] - mn;
#pragma unroll
  for (int r = 0; r < 16; ++r) p1[r] = p1[r] - mn;
#pragma unroll
  for (int r = 0; r < 16; ++r) p0[r] = __builtin_amdgcn_exp2f(p0[r]);
}
__device__ __forceinline__ void finishSM(f32x16& p0, f32x16& p1, float alpha, float& l_reg, bf16x8& pa0, bf16x8& pa1, bf16x8& pa2, bf16x8& pa3) {
#pragma unroll
  for (int r = 0; r < 16; ++r) p1[r] = __builtin_amdgcn_exp2f(p1[r]);
  float ps = 0;
#pragma unroll
  for (int r = 0; r < 16; ++r) ps += p0[r];
#pragma unroll
  for (int r = 0; r < 16; ++r) ps += p1[r];
  { auto rr = __builtin_amdgcn_permlane32_swap(__float_as_uint(ps), __float_as_uint(ps), false, false);
    ps = __uint_as_float(rr[0]) + __uint_as_float(rr[1]); }
  l_reg = l_reg * alpha + ps;
#define APK4(P, BASE, OUT) do { unsigned a0 = cvtpk(P[BASE + 0], P[BASE + 1]), a1 = cvtpk(P[BASE + 2], P[BASE + 3]);   \
    unsigned b0 = cvtpk(P[BASE + 4], P[BASE + 5]), b1 = cvtpk(P[BASE + 6], P[BASE + 7]);                              \
    auto r0 = __builtin_amdgcn_permlane32_swap(a0, b0, false, false); auto r1 = __builtin_amdgcn_permlane32_swap(a1, b1, false, false); \
    u32x4 w = {r0[0], r1[0], r0[1], r1[1]}; OUT = *reinterpret_cast<bf16x8*>(&w); } while (0)
  APK4(p0, 0, pa0); APK4(p0, 8, pa1); APK4(p1, 0, pa2); APK4(p1, 8, pa3);
#undef APK4
}
__device__ __forceinline__ void qkt(f32x16& p0, f32x16& p1, const char* Ks, const bf16x8* qr, int r32, int hi) {
  p0 = f32x16{}; p1 = f32x16{};
#pragma unroll
  for (int d0 = 0; d0 < 4; ++d0) { const int cb = d0 * 32 + hi * 16;
    const bf16x8 b0 = *reinterpret_cast<const bf16x8*>(Ks + AKSW(r32, cb));
    const bf16x8 b1 = *reinterpret_cast<const bf16x8*>(Ks + AKSW(32 + r32, cb));
    p0 = __builtin_amdgcn_mfma_f32_32x32x16_bf16(b0, qr[d0], p0, 0, 0, 0);
    p1 = __builtin_amdgcn_mfma_f32_32x32x16_bf16(b1, qr[d0], p1, 0, 0, 0); }
}
__device__ __forceinline__ int v_st(int k, int c) { const int kk = (k & ~0xC) | ((k & 4) << 1) | ((k & 8) >> 1); return ((kk >> 3) * 4 + (c >> 5)) * 512 + ((kk & 7) * 32 + (c & 31)) * 2; }
__device__ __forceinline__ int v_rd_base(int lane) { return ((lane & 3) << 3) | (((lane >> 2) & 3) << 6) | (((lane >> 4) & 1) << 5) | (((lane >> 5) & 1) << 8); }
constexpr int v_rd_off(int d0, int ks, int half) { return d0 * 512 + ks * 4096 + half * 2048; }
template <int OFF> __device__ __forceinline__ s16x4 tr_read(int vb) {
  s16x4 r; asm volatile("ds_read_b64_tr_b16 %0, %1 offset:%2" : "=&v"(r) : "v"(vb), "i"(OFF) : "memory"); return r;
}
template <int D0> __device__ __forceinline__ void pv_one(f32x16& od, int vb, bf16x8 pa0, bf16x8 pa1, bf16x8 pa2, bf16x8 pa3) {
  const s16x4 l0 = tr_read<v_rd_off(D0, 0, 0)>(vb), h0 = tr_read<v_rd_off(D0, 0, 1)>(vb), l1 = tr_read<v_rd_off(D0, 1, 0)>(vb), h1 = tr_read<v_rd_off(D0, 1, 1)>(vb);
  const s16x4 l2 = tr_read<v_rd_off(D0, 2, 0)>(vb), h2 = tr_read<v_rd_off(D0, 2, 1)>(vb), l3 = tr_read<v_rd_off(D0, 3, 0)>(vb), h3 = tr_read<v_rd_off(D0, 3, 1)>(vb);
  asm volatile("s_waitcnt lgkmcnt(0)" ::: "memory"); ASBAR();
#define APK(L, H) (bf16x8){L[0], L[1], L[2], L[3], H[0], H[1], H[2], H[3]}
  od = __builtin_amdgcn_mfma_f32_32x32x16_bf16(pa0, APK(l0, h0), od, 0, 0, 0);
  od = __builtin_amdgcn_mfma_f32_32x32x16_bf16(pa1, APK(l1, h1), od, 0, 0, 0);
  od = __builtin_amdgcn_mfma_f32_32x32x16_bf16(pa2, APK(l2, h2), od, 0, 0, 0);
  od = __builtin_amdgcn_mfma_f32_32x32x16_bf16(pa3, APK(l3, h3), od, 0, 0, 0);
#undef APK
}
__device__ __forceinline__ void pv_d0(f32x16* o, int vb, bf16x8 pa0, bf16x8 pa1, bf16x8 pa2, bf16x8 pa3) {
  pv_one<0>(o[0], vb, pa0, pa1, pa2, pa3); pv_one<1>(o[1], vb, pa0, pa1, pa2, pa3); pv_one<2>(o[2], vb, pa0, pa1, pa2, pa3); pv_one<3>(o[3], vb, pa0, pa1, pa2, pa3);
}

__device__ __forceinline__ void attn_pass(const bf16_t* __restrict__ Qb, const bf16_t* __restrict__ Kh, const bf16_t* __restrict__ Vh, char* lds, f32x16 (&o)[4]) {
  int tid = threadIdx.x; asm volatile("" : "+v"(tid));
  const int wid = tid >> 6, lane = tid & 63, r32 = lane & 31, hi = lane >> 5;
  char* V_lds = lds + OFF_V; char* K_lds = lds + OFF_K;
  float* ws = (float*)(lds + OFF_WS) + wid * 64; float* li_l = ws; float* al_l = ws + 32;
  float m_reg = -1e30f, l_reg = 0; bf16x8 qr[4];
#pragma unroll
  for (int d = 0; d < 4; ++d) o[d] = f32x16{};
  const bf16_t* Qw = Qb + (long)(wid * QBLK + r32) * LD + hi * 8;
#pragma unroll
  for (int d0 = 0; d0 < 4; ++d0) qr[d0] = *reinterpret_cast<const bf16x8*>(Qw + d0 * 16);
  const int sr = tid >> 4, sc = (tid & 15) * 8, vst0 = v_st(sr, sc), vst1 = v_st(32 + sr, sc);
  const int kr = tid >> 3, kc = (tid & 7) * 8, kst = AKSW(kr, kc * 2);
  const int vb0 = (int)(uintptr_t)V_lds + v_rd_base(lane);
  bf16x8 vsA0, vsA1, ksA, vsB0, vsB1, ksB;
#define ASLOAD(S, k0) do { vs##S##0 = *reinterpret_cast<const bf16x8*>(&Vh[(long)((k0) + sr) * LD + sc]); vs##S##1 = *reinterpret_cast<const bf16x8*>(&Vh[(long)((k0) + 32 + sr) * LD + sc]); \
    ks##S = *reinterpret_cast<const bf16x8*>(&Kh[(long)((k0) + kr) * LD + kc]); } while (0)
#define ASWRITE(b, S) do { *(bf16x8*)(V_lds + (b) * SHM_V + vst0) = vs##S##0; *(bf16x8*)(V_lds + (b) * SHM_V + vst1) = vs##S##1; *(bf16x8*)(K_lds + (b) * SHM_K + kst) = ks##S; } while (0)
#define ASWAIT() asm volatile("s_waitcnt vmcnt(3)" ::: "memory")
#define ARESC(a) do { if (__any((a) < 1.f)) { if (hi == 0) al_l[r32] = (a); asm volatile("s_waitcnt lgkmcnt(0)" ::: "memory"); \
    _Pragma("unroll") for (int d = 0; d < 4; ++d) _Pragma("unroll") for (int r = 0; r < 16; ++r) o[d][r] *= al_l[crow(r, hi)]; } } while (0)
  f32x16 pA0, pA1, pB0, pB1; float mnA, mnB, alA, alB; bf16x8 pa0, pa1, pa2, pa3; constexpr int NT = SEQ / KVBLK;
  ASLOAD(A, 0); asm volatile("s_waitcnt vmcnt(0)" ::: "memory"); ASWRITE(0, A); __syncthreads();
  qkt(pA0, pA1, K_lds, qr, r32, hi); partialSM(pA0, pA1, m_reg, mnA, alA);
  ASLOAD(B, KVBLK); ASLOAD(A, 2 * KVBLK);
  ASWAIT(); ASWRITE(1, B); __syncthreads();
  for (int j = 1; j + 1 < NT; j += 2) {
    ASBAR(); qkt(pB0, pB1, K_lds + SHM_K, qr, r32, hi);
    finishSM(pA0, pA1, alA, l_reg, pa0, pa1, pa2, pa3); ASBAR();
    ASLOAD(B, (j + 2) * KVBLK); ASBAR();
    pv_d0(o, vb0, pa0, pa1, pa2, pa3); partialSM(pB0, pB1, m_reg, mnB, alB);
    __syncthreads(); ASWAIT(); ASWRITE(0, A);
    ARESC(alB); __syncthreads();
    ASBAR(); qkt(pA0, pA1, K_lds, qr, r32, hi);
    finishSM(pB0, pB1, alB, l_reg, pa0, pa1, pa2, pa3); ASBAR();
    if (j + 3 < NT) ASLOAD(A, (j + 3) * KVBLK); ASBAR();
    pv_d0(o, vb0 + SHM_V, pa0, pa1, pa2, pa3); partialSM(pA0, pA1, m_reg, mnA, alA);
    __syncthreads(); ASWAIT(); ASWRITE(1, B);
    ARESC(alA); __syncthreads();
  }
  ASBAR(); qkt(pB0, pB1, K_lds + SHM_K, qr, r32, hi);
  finishSM(pA0, pA1, alA, l_reg, pa0, pa1, pa2, pa3); ASBAR();
  pv_d0(o, vb0, pa0, pa1, pa2, pa3); partialSM(pB0, pB1, m_reg, mnB, alB);
  __syncthreads(); ARESC(alB);
  finishSM(pB0, pB1, alB, l_reg, pa0, pa1, pa2, pa3); ASBAR();
  pv_d0(o, vb0 + SHM_V, pa0, pa1, pa2, pa3);
  if (hi == 0) li_l[r32] = l_reg; asm volatile("s_waitcnt lgkmcnt(0)" ::: "memory");
#pragma unroll
  for (int r = 0; r < 16; ++r) { const float rl = __builtin_amdgcn_rcpf(li_l[crow(r, hi)]);
#pragma unroll
    for (int d = 0; d < 4; ++d) o[d][r] *= rl; }
  __syncthreads();
#undef ASLOAD
#undef ASWRITE
#undef ASWAIT
#undef ARESC
}

__device__ __forceinline__ void attn_unit(int b, int h, int qb, const bf16_t* Q, const bf16_t* K, const bf16_t* V, bf16_t* O, float* stash,
                                          float lam, const float* subg, float osc, char* lds) {
  const long rowbase = (long)b * SEQ, q0 = (long)qb * 256;
  const bf16_t* Qb = Q + (rowbase + q0) * LD + h * 128; const bf16_t* Kh = K + rowbase * LD + h * 128; const bf16_t* Vh = V + rowbase * LD + h * 128;
#pragma unroll 1
  for (int c = 0; c < 2; ++c) {
    f32x16 o[4];
    attn_pass(Qb + c * 64, Kh + c * 64, Vh, lds, o);
    int zz = 0; asm volatile("" : "+v"(zz));
    const int tid = (int)threadIdx.x + zz, wid = tid >> 6, lane = tid & 63, r32 = lane & 31, hi = lane >> 5;
    f32x4a* st = (f32x4a*)(stash + ((size_t)blockIdx.x * 512 + tid) * 64);
    if (c == 0) {
#pragma unroll
      for (int d = 0; d < 4; ++d)
#pragma unroll
        for (int q = 0; q < 4; ++q) st[d * 4 + q] = (f32x4a){o[d][4 * q], o[d][4 * q + 1], o[d][4 * q + 2], o[d][4 * q + 3]};
    } else {
      float g4[4];
#pragma unroll
      for (int d = 0; d < 4; ++d) g4[d] = subg[32 * d + r32] * osc;
      bf16_t* Ow = O + (rowbase + q0 + wid * QBLK) * LD + h * 128 + r32;
#pragma unroll
      for (int q = 0; q < 4; ++q) {
        f32x4a s4[4];
#pragma unroll
        for (int d = 0; d < 4; ++d) s4[d] = st[d * 4 + q];
#pragma unroll
        for (int j = 0; j < 4; ++j) { const int r = 4 * q + j;
          float e[4];
#pragma unroll
          for (int d = 0; d < 4; ++d) e[d] = s4[d][j] - lam * o[d][r];
          float ss = (e[0] * e[0] + e[1] * e[1]) + (e[2] * e[2] + e[3] * e[3]);
          ss += __shfl_xor(ss, 1); ss += __shfl_xor(ss, 2); ss += __shfl_xor(ss, 4); ss += __shfl_xor(ss, 8); ss += __shfl_xor(ss, 16);
          const float rs = __builtin_amdgcn_rsqf(ss * (1.0f / 128.0f) + 1e-5f);
          const int orow = crow(r, hi);
#pragma unroll
          for (int d = 0; d < 4; ++d) Ow[(long)orow * LD + d * 32] = (bf16_t)(cvtpk(e[d] * rs * g4[d], 0.f) & 0xffffu);
        }
      }
    }
  }
}
#undef AKSW
#undef ASBAR
}

namespace cg = cooperative_groups;
#define LAS __attribute__((address_space(3)))
typedef unsigned short bf16;
typedef unsigned v4u __attribute__((ext_vector_type(4)));
typedef float f32x4 __attribute__((ext_vector_type(4)));
typedef short bf16x8 __attribute__((ext_vector_type(8)));
constexpr int NWAVES = 8, NTHR = 512;
constexpr int BATCH = 32, SEQ = 2048, D = 1024, M = BATCH * SEQ, FF = 2816, FF2 = 2 * FF, NH = 8;
constexpr int MH = M / 2;
constexpr size_t MiB = 1u << 20;
constexpr size_t WS_WQKV = 0, WS_WO = 6 * MiB, WS_WIN = 8 * MiB, WS_WOUT = 14 * MiB, WS_WUP0 = 16 * MiB, WS_WUP1 = 27 * MiB, WS_WDN0 = 38 * MiB, WS_WDN1 = 44 * MiB;
constexpr size_t WS_COS = 64 * MiB, WS_SIN = 72 * MiB;
constexpr size_t WS_SSQ = 80 * MiB, SSQ_BYTES = 4 * MiB;
constexpr size_t WS_XB = 104 * MiB;
constexpr size_t WS_R = 232 * MiB;
constexpr size_t WS_Q = WS_R, WS_K = WS_R + 128 * MiB, WS_V = WS_R + 256 * MiB, WS_O = WS_R + 384 * MiB;
constexpr size_t WS_G = WS_R, WS_U = WS_R + 352 * MiB;
constexpr size_t WS_STASH = 936 * MiB;
constexpr size_t WS_END = 1000 * MiB;
constexpr int LDS_BYTES = 147456;
static_assert(att::SHM_TOTAL <= 131072, "attention LDS");

__device__ __forceinline__ unsigned f2bf(float f) { unsigned u = __builtin_bit_cast(unsigned, f); return (u + 0x7fffu + ((u >> 16) & 1u)) >> 16; }
__device__ __forceinline__ unsigned pk2(float lo, float hi) { return f2bf(lo) | (f2bf(hi) << 16); }
__device__ __forceinline__ float bflo(unsigned w) { return __builtin_bit_cast(float, w << 16); }
__device__ __forceinline__ float bfhi(unsigned w) { return __builtin_bit_cast(float, w & 0xffff0000u); }
__device__ __forceinline__ float wave_sum(float v) {
#pragma unroll
    for (int o = 1; o < 64; o <<= 1) v += __shfl_xor(v, o);
    return v;
}
__device__ __forceinline__ int dest_row(int mode, int n) {
    if (mode == 1 && n < 2048) { const int d = n & 63, dd = d & 31; return (n & ~63) + 8 * (dd >> 2) + (dd & 3) + ((d >> 5) << 2); }
    return n;
}
__device__ __forceinline__ void transpose_item(const float* W, int K, int N, bf16* WT, const float* gk, int mode, LAS float* scr, int item, int lane) {
    const int nblk = N / 32, kb = item / nblk, nb = item % nblk, k0 = 64 * kb, n0 = 32 * nb;
#pragma unroll 8
    for (int i = 0; i < 32; ++i) { const int kk = 2 * i + (lane >> 5); const float g = gk ? gk[k0 + kk] : 1.f; scr[kk * 33 + (lane & 31)] = W[(size_t)(k0 + kk) * N + n0 + (lane & 31)] * g; }
    asm volatile("s_waitcnt lgkmcnt(0)" ::: "memory");
    const int c = lane & 7;
#pragma unroll
    for (int j = 0; j < 4; ++j) { const int n = (lane >> 3) + 8 * j; const LAS float* s = scr + (8 * c) * 33 + n;
        v4u o; o.x = pk2(s[0 * 33], s[1 * 33]); o.y = pk2(s[2 * 33], s[3 * 33]); o.z = pk2(s[4 * 33], s[5 * 33]); o.w = pk2(s[6 * 33], s[7 * 33]);
        *(v4u*)(WT + (size_t)dest_row(mode, n0 + n) * K + k0 + 8 * c) = o; }
    asm volatile("s_waitcnt lgkmcnt(0)" ::: "memory");
}
__device__ __forceinline__ void sincos_cw(float a, float& s, float& c) {
    const float kf = rintf(a * 0.63661977236758134f); const int k = (int)kf;
    float r = fmaf(kf, -1.5703125f, a); r = fmaf(kf, -4.837512969970703125e-4f, r); r = fmaf(kf, -7.54978995489188216e-8f, r);
    const float z = r * r;
    const float sp = fmaf(r * z, fmaf(z, fmaf(z, -1.9515295891e-4f, 8.3321608736e-3f), -1.6666654611e-1f), r);
    const float cp = fmaf(z * z, fmaf(z, fmaf(z, 2.443315711809948e-5f, -1.388731625493765e-3f), 4.166664568298827e-2f), fmaf(z, -0.5f, 1.0f));
    const float ss = (k & 1) ? cp : sp, cc = (k & 1) ? sp : cp;
    s = (k & 2) ? -ss : ss; c = ((k + 1) & 2) ? -cc : cc;
}

struct Args {
    const float* x; const int* pos;
    const float *attn_g, *w_qkv, *lq1, *lk1, *lq2, *lk2, *subg, *w_o, *conv_g, *w_in, *conv_w, *w_out, *ffn_g, *w_up, *ffn_cw, *ffn_cb, *w_dn, *fin_g;
    float* out; unsigned char* ws;
};

__device__ __forceinline__ void ffn_ew_phase(const bf16* U, bf16* G, const float* cw, const float* cb, int gtid, int nthreads) {
    constexpr int TC = 32, NFC = FF / 8, NITEM = (MH / TC) * NFC;
    for (int it = gtid; it < NITEM; it += nthreads) {
        const int fc = it % NFC, tc = it / NFC, t0 = tc * TC, f0 = fc * 8;
        float wg[3][8], wv[3][8], bg[8], bv[8];
#pragma unroll
        for (int j = 0; j < 3; ++j)
#pragma unroll
            for (int h = 0; h < 2; ++h) { const f32x4 a = *(const f32x4*)(cw + (size_t)j * FF2 + f0 + 4 * h), b = *(const f32x4*)(cw + (size_t)j * FF2 + FF + f0 + 4 * h);
#pragma unroll
                for (int e = 0; e < 4; ++e) { wg[j][4 * h + e] = a[e]; wv[j][4 * h + e] = b[e]; } }
#pragma unroll
        for (int h = 0; h < 2; ++h) { const f32x4 a = *(const f32x4*)(cb + f0 + 4 * h), b = *(const f32x4*)(cb + FF + f0 + 4 * h);
#pragma unroll
            for (int e = 0; e < 4; ++e) { bg[4 * h + e] = a[e]; bv[4 * h + e] = b[e]; } }
        const bf16* up = U + (size_t)t0 * FF2 + f0;
        const v4u zero = {0u, 0u, 0u, 0u};
        v4u pg, pv, cg_, cv, ng, nv;
        if (t0 % SEQ == 0) { pg = zero; pv = zero; } else { pg = *(const v4u*)(up - FF2); pv = *(const v4u*)(up - FF2 + FF); }
        cg_ = *(const v4u*)(up); cv = *(const v4u*)(up + FF);
#pragma unroll 4
        for (int i = 0; i < TC; ++i) {
            if (i == TC - 1 && (t0 + TC) % SEQ == 0) { ng = zero; nv = zero; } else { ng = *(const v4u*)(up + (size_t)(i + 1) * FF2); nv = *(const v4u*)(up + (size_t)(i + 1) * FF2 + FF); }
            v4u o;
#pragma unroll
            for (int q = 0; q < 4; ++q) {
                const float g0 = fmaf(wg[0][2 * q], bflo(pg[q]), fmaf(wg[1][2 * q], bflo(cg_[q]), fmaf(wg[2][2 * q], bflo(ng[q]), bg[2 * q])));
                const float g1 = fmaf(wg[0][2 * q + 1], bfhi(pg[q]), fmaf(wg[1][2 * q + 1], bfhi(cg_[q]), fmaf(wg[2][2 * q + 1], bfhi(ng[q]), bg[2 * q + 1])));
                const float v0 = fmaf(wv[0][2 * q], bflo(pv[q]), fmaf(wv[1][2 * q], bflo(cv[q]), fmaf(wv[2][2 * q], bflo(nv[q]), bv[2 * q])));
                const float v1 = fmaf(wv[0][2 * q + 1], bfhi(pv[q]), fmaf(wv[1][2 * q + 1], bfhi(cv[q]), fmaf(wv[2][2 * q + 1], bfhi(nv[q]), bv[2 * q + 1])));
                const float s0 = g0 * __builtin_amdgcn_rcpf(1.f + __builtin_amdgcn_exp2f(-1.4426950408889634f * g0));
                const float s1 = g1 * __builtin_amdgcn_rcpf(1.f + __builtin_amdgcn_exp2f(-1.4426950408889634f * g1));
                o[q] = pk2(s0 * v0, s1 * v1);
            }
            *(v4u*)(G + (size_t)(t0 + i) * FF + f0) = o;
            pg = cg_; pv = cv; cg_ = ng; cv = nv;
        }
    }
}
__device__ __forceinline__ void mixer_ew_phase(const bf16* R, bf16* Y, const float* cw, int gtid, int nthreads) {
    constexpr int TC = 32, NFC = D / 8, NITEM = (M / TC) * NFC;
    for (int it = gtid; it < NITEM; it += nthreads) {
        const int fc = it % NFC, tc = it / NFC, t0 = tc * TC, f0 = fc * 8;
        float w[3][8];
#pragma unroll
        for (int j = 0; j < 3; ++j)
#pragma unroll
            for (int h = 0; h < 2; ++h) { const f32x4 a = *(const f32x4*)(cw + (size_t)j * D + f0 + 4 * h);
#pragma unroll
                for (int e = 0; e < 4; ++e) w[j][4 * h + e] = a[e]; }
        const bf16* rp = R + (size_t)t0 * (3 * D) + f0;
        float p[8], c[8], n[8];
#define MIX_CU(dst, ptr) do { const v4u c_ = *(const v4u*)((ptr) + D), u_ = *(const v4u*)((ptr) + 2 * D); \
        _Pragma("unroll") for (int q = 0; q < 4; ++q) { dst[2 * q] = bflo(c_[q]) * bflo(u_[q]); dst[2 * q + 1] = bfhi(c_[q]) * bfhi(u_[q]); } } while (0)
        if (t0 % SEQ == 0) {
#pragma unroll
            for (int e = 0; e < 8; ++e) p[e] = 0.f;
        } else MIX_CU(p, rp - 3 * D);
        MIX_CU(c, rp);
#pragma unroll 4
        for (int i = 0; i < TC; ++i) {
            if (i == TC - 1 && (t0 + TC) % SEQ == 0) {
#pragma unroll
                for (int e = 0; e < 8; ++e) n[e] = 0.f;
            } else MIX_CU(n, rp + (size_t)(i + 1) * (3 * D));
            const v4u b_ = *(const v4u*)(rp + (size_t)i * (3 * D));
            v4u o;
#pragma unroll
            for (int q = 0; q < 4; ++q) {
                const float y0 = bflo(b_[q]) * fmaf(w[0][2 * q], p[2 * q], fmaf(w[1][2 * q], c[2 * q], w[2][2 * q] * n[2 * q]));
                const float y1 = bfhi(b_[q]) * fmaf(w[0][2 * q + 1], p[2 * q + 1], fmaf(w[1][2 * q + 1], c[2 * q + 1], w[2][2 * q + 1] * n[2 * q + 1]));
                o[q] = pk2(y0, y1);
            }
            *(v4u*)(Y + (size_t)(t0 + i) * D + f0) = o;
#pragma unroll
            for (int e = 0; e < 8; ++e) { p[e] = c[e]; c[e] = n[e]; }
        }
#undef MIX_CU
    }
}

typedef const __attribute__((address_space(4))) Args* CArgs;
__device__ __forceinline__ CArgs get_args() { CArgs p = (CArgs)__builtin_amdgcn_kernarg_segment_ptr(); asm volatile("" : "+s"(p)); return p; }
#define WSP(off) (a->ws + (off))
#define WUP_T(l) ((bf16*)WSP(WS_WUP0 + (size_t)(l) * (WS_WUP1 - WS_WUP0)))
#define WDN_T(l) ((bf16*)WSP(WS_WDN0 + (size_t)(l) * (WS_WDN1 - WS_WDN0)))
#define SSQ(i) ((float*)WSP(WS_SSQ + (size_t)(i) * SSQ_BYTES))
#define GEO() int tid = threadIdx.x; asm volatile("" : "+v"(tid)); const int lane = tid & 63, wave = __builtin_amdgcn_readfirstlane(tid >> 6); const int G = gridDim.x, bx = blockIdx.x; \
    const int vcu = (G % 8 == 0) ? (bx % 8) * (G / 8) + bx / 8 : bx; const int gw = vcu * NWAVES + wave, NGW = G * NWAVES, gtid = bx * NTHR + tid, NT = G * NTHR; \
    (void)lane; (void)gw; (void)NGW; (void)gtid; (void)NT; (void)vcu

__global__ void __launch_bounds__(NTHR, 2) mega_fwd(Args a_unused) {
    extern __shared__ __attribute__((aligned(16))) unsigned char lds[];
    cg::grid_group grid = cg::this_grid();
    LAS unsigned char* ldsl = (LAS unsigned char*)lds;

    {
        CArgs a = get_args(); GEO();
        bf16* Wqkv_t = (bf16*)WSP(WS_WQKV); bf16* Wo_t = (bf16*)WSP(WS_WO); bf16* Win_t = (bf16*)WSP(WS_WIN); bf16* Wout_t = (bf16*)WSP(WS_WOUT);
        float* tcos = (float*)WSP(WS_COS); float* tsin = (float*)WSP(WS_SIN); bf16* XB = (bf16*)WSP(WS_XB);
        LAS float* scr = (LAS float*)(ldsl + wave * 16384);
        constexpr int I_QKV = (D / 64) * (3 * D / 32), I_O = (D / 64) * (D / 32), I_UP = (D / 64) * (FF2 / 32), I_DN = (FF / 64) * (D / 32);
        constexpr int NITEMS = 2 * I_QKV + 2 * I_O + 2 * I_UP + 2 * I_DN;
        for (int it = gw; it < NITEMS; it += NGW) {
            int r = it;
            if (r < I_QKV) { transpose_item(a->w_qkv, D, 3 * D, Wqkv_t, a->attn_g, 1, scr, r, lane); continue; } r -= I_QKV;
            if (r < I_QKV) { transpose_item(a->w_in, D, 3 * D, Win_t, a->conv_g, 0, scr, r, lane); continue; } r -= I_QKV;
            if (r < I_O) { transpose_item(a->w_o, D, D, Wo_t, nullptr, 0, scr, r, lane); continue; } r -= I_O;
            if (r < I_O) { transpose_item(a->w_out, D, D, Wout_t, nullptr, 0, scr, r, lane); continue; } r -= I_O;
            if (r < I_UP) { transpose_item(a->w_up, D, FF2, WUP_T(0), a->ffn_g, 0, scr, r, lane); continue; } r -= I_UP;
            if (r < I_UP) { transpose_item(a->w_up + (size_t)D * FF2, D, FF2, WUP_T(1), a->ffn_g + D, 0, scr, r, lane); continue; } r -= I_UP;
            if (r < I_DN) { transpose_item(a->w_dn, FF, D, WDN_T(0), nullptr, 0, scr, r, lane); continue; } r -= I_DN;
            transpose_item(a->w_dn + (size_t)FF * D, FF, D, WDN_T(1), nullptr, 0, scr, r, lane);
        }
        const int* pos = a->pos;
        for (int i = gtid; i < M * 32; i += NT) {
            const int d = i & 31; const float inv = __builtin_amdgcn_exp2f(-(float)d * (13.287712379549449f / 32.0f));
            float s, c; sincos_cw((float)pos[i >> 5] * inv, s, c); tcos[i] = c; tsin[i] = s;
        }
        const float* x = a->x; float* ssq0 = SSQ(0);
        for (int m = gw; m < M; m += NGW) {
            const f32x4* xr = (const f32x4*)(x + (size_t)m * D) + lane; float s = 0.f;
            unsigned long long* o8 = (unsigned long long*)(XB + (size_t)m * D) + lane;
#pragma unroll
            for (int j = 0; j < 4; ++j) { const f32x4 v = xr[64 * j]; s += (v.x * v.x + v.y * v.y) + (v.z * v.z + v.w * v.w);
                o8[64 * j] = (unsigned long long)pk2(v.x, v.y) | ((unsigned long long)pk2(v.z, v.w) << 32); }
            s = wave_sum(s);
            if (lane < 16) ssq0[(size_t)m * 16 + lane] = lane == 0 ? s : 0.f;
        }
    }
    grid.sync();

    {
        CArgs a = get_args();
        pg8::Gemm g{(bf16*)WSP(WS_XB), (bf16*)WSP(WS_WQKV), M, 3 * D, D}; pg8::StaticOrder S; S.init(M, 3 * D, gridDim.x, blockIdx.x);
        pg8::EpiRope E{(bf16*)WSP(WS_Q), (bf16*)WSP(WS_K), (bf16*)WSP(WS_V), SSQ(0), (float*)WSP(WS_COS), (float*)WSP(WS_SIN), 0.125f * 1.4426950408889634f};
        pg8::gemm_phase<pg8::EpiRope, pg8::StaticOrder, true, true>(ldsl, g, S, E);
    }
    grid.sync();
    {
        CArgs a = get_args(); GEO();
        const float lambda_init = 0.8f - 0.6f * 1.0f;
        const float s1 = wave_sum(a->lq1[lane] * a->lk1[lane]), s2 = wave_sum(a->lq2[lane] * a->lk2[lane]);
        const float lam = __expf(s1) - __expf(s2) + lambda_init;
        const bf16* Qb = (const bf16*)WSP(WS_Q); const bf16* Kb = (const bf16*)WSP(WS_K); const bf16* Vb = (const bf16*)WSP(WS_V); bf16* Ob = (bf16*)WSP(WS_O);
        float* stash = (float*)WSP(WS_STASH); const float* subg = a->subg;
#pragma unroll 1
        for (int i = 0;; ++i) {
            const int id = i * G + vcu; if (id >= BATCH * NH * (SEQ / 256)) break;
            const int bh = id >> 3, qb = id & 7;
            att::attn_unit(bh >> 3, bh & 7, qb, Qb, Kb, Vb, Ob, stash, lam, subg, 1.0f - lambda_init, (char*)lds);
        }
    }
    grid.sync();
    {
        CArgs a = get_args();
        pg8::Gemm g{(bf16*)WSP(WS_O), (bf16*)WSP(WS_WO), M, D, D}; pg8::StaticOrder S; S.init(M, D, gridDim.x, blockIdx.x);
        pg8::EpiRes E{a->x, a->out, (bf16*)WSP(WS_XB), SSQ(1)};
        pg8::gemm_phase<pg8::EpiRes, pg8::StaticOrder, true, true>(ldsl, g, S, E);
    }
    grid.sync();
#pragma unroll 1
    for (int layer = 0; layer < 2; ++layer) {
        if (layer == 1) {
            {   CArgs a = get_args();
                pg8::Gemm g{(bf16*)WSP(WS_XB), (bf16*)WSP(WS_WIN), M, 3 * D, D}; pg8::StaticOrder S; S.init(M, 3 * D, gridDim.x, blockIdx.x);
                pg8::EpiScale E{(bf16*)WSP(WS_Q), 3 * D, SSQ(2), 0};
                pg8::gemm_phase<pg8::EpiScale, pg8::StaticOrder, true, true>(ldsl, g, S, E); }
            grid.sync();
            {   CArgs a = get_args(); GEO();
                mixer_ew_phase((const bf16*)WSP(WS_Q), (bf16*)WSP(WS_O), a->conv_w, gtid, NT); }
            grid.sync();
            {   CArgs a = get_args();
                pg8::Gemm g{(bf16*)WSP(WS_O), (bf16*)WSP(WS_WOUT), M, D, D}; pg8::StaticOrder S; S.init(M, D, gridDim.x, blockIdx.x);
                pg8::EpiRes E{a->out, a->out, (bf16*)WSP(WS_XB), SSQ(3)};
                pg8::gemm_phase<pg8::EpiRes, pg8::StaticOrder, true, true>(ldsl, g, S, E); }
            grid.sync();
        }
#pragma unroll 1
        for (int hf = 0; hf < 2; ++hf) {
            {   CArgs a = get_args();
                pg8::Gemm g{(bf16*)WSP(WS_XB) + (size_t)hf * MH * D, WUP_T(layer), MH, FF2, D}; pg8::StaticOrder S; S.init(MH, FF2, gridDim.x, blockIdx.x);
                pg8::EpiScale E{(bf16*)WSP(WS_U), FF2, SSQ(layer == 0 ? 1 : 3), hf * MH};
                pg8::gemm_phase<pg8::EpiScale, pg8::StaticOrder, true, true>(ldsl, g, S, E); }
            grid.sync();
            {   CArgs a = get_args(); GEO();
                ffn_ew_phase((const bf16*)WSP(WS_U), (bf16*)WSP(WS_G) + (size_t)hf * MH * FF, a->ffn_cw + (size_t)layer * 3 * FF2, a->ffn_cb + (size_t)layer * FF2, gtid, NT); }
            grid.sync();
        }
        {   CArgs a = get_args();
            pg8::Gemm g{(bf16*)WSP(WS_G), WDN_T(layer), M, D, FF}; pg8::StaticOrder S; S.init(M, D, gridDim.x, blockIdx.x);
            pg8::EpiRes E{a->out, a->out, layer == 0 ? (bf16*)WSP(WS_XB) : (bf16*)nullptr, SSQ(layer == 0 ? 2 : 4)};
            pg8::gemm_phase<pg8::EpiRes, pg8::StaticOrder, true, true>(ldsl, g, S, E); }
        grid.sync();
    }
    {   CArgs a = get_args(); GEO();
        float* out = a->out; const float* fg = a->fin_g; const float* ssq4 = SSQ(4);
        for (int m = gw; m < M; m += NGW) {
            const float rs = pg8::row_rstd(ssq4, m);
            f32x4* xr = (f32x4*)(out + (size_t)m * D) + lane; const f32x4* gr = (const f32x4*)fg + lane;
#pragma unroll
            for (int j = 0; j < 4; ++j) { const f32x4 v = xr[64 * j], g = gr[64 * j]; xr[64 * j] = v * rs * g; }
        }
    }
}

extern "C" void kernel_launch(void* const* d_in, const int* in_sizes, int n_in, void* d_out, int out_size, void* d_ws, size_t ws_size, hipStream_t stream) {
    static int grid = 0;
    if (grid == 0) {
        if (n_in != 20 || in_sizes[0] != M * D || out_size != M * D || ws_size < WS_END) { fprintf(stderr, "kernel_launch: shape mismatch n_in %d in0 %d out %d ws %zu\n", n_in, n_in > 0 ? in_sizes[0] : -1, out_size, ws_size); grid = -1; return; }
        int dev = 0, cus = 0, per_cu = 0;
        if (hipGetDevice(&dev) != hipSuccess || hipDeviceGetAttribute(&cus, hipDeviceAttributeMultiprocessorCount, dev) != hipSuccess) { grid = -1; return; }
        if (hipFuncSetAttribute((const void*)mega_fwd, hipFuncAttributeMaxDynamicSharedMemorySize, LDS_BYTES) != hipSuccess) { fprintf(stderr, "kernel_launch: hipFuncSetAttribute failed\n"); grid = -1; return; }
        if (hipOccupancyMaxActiveBlocksPerMultiprocessor(&per_cu, (const void*)mega_fwd, NTHR, LDS_BYTES) != hipSuccess || per_cu < 1) { fprintf(stderr, "kernel_launch: occupancy query says %d\n", per_cu); per_cu = 1; }
        (void)hipGetLastError();
        grid = cus;
    }
    if (grid < 0) return;
    Args a{};
    a.x = (const float*)d_in[0]; a.pos = (const int*)d_in[1];
    a.attn_g = (const float*)d_in[2]; a.w_qkv = (const float*)d_in[3]; a.lq1 = (const float*)d_in[4]; a.lk1 = (const float*)d_in[5]; a.lq2 = (const float*)d_in[6]; a.lk2 = (const float*)d_in[7];
    a.subg = (const float*)d_in[8]; a.w_o = (const float*)d_in[9]; a.conv_g = (const float*)d_in[10]; a.w_in = (const float*)d_in[11]; a.conv_w = (const float*)d_in[12]; a.w_out = (const float*)d_in[13];
    a.ffn_g = (const float*)d_in[14]; a.w_up = (const float*)d_in[15]; a.ffn_cw = (const float*)d_in[16]; a.ffn_cb = (const float*)d_in[17]; a.w_dn = (const float*)d_in[18]; a.fin_g = (const float*)d_in[19];
    a.out = (float*)d_out; a.ws = (unsigned char*)d_ws;
    void* args[] = {&a};
    const hipError_t e = hipLaunchCooperativeKernel((const void*)mega_fwd, dim3(grid), dim3(NTHR), args, LDS_BYTES, stream);
    if (e != hipSuccess) fprintf(stderr, "kernel_launch: cooperative launch failed: %s (grid %d)\n", hipGetErrorString(e), grid);
}
```

```cpp
#include <hip/hip_runtime.h>
#include <hip/hip_cooperative_groups.h>
#include <cstdio>
#include <cstdint>
namespace pg8 {
#define PG8_LAS __attribute__((address_space(3)))
typedef unsigned short bf16_t;
typedef short bf16x8 __attribute__((ext_vector_type(8)));
typedef float f32x4 __attribute__((ext_vector_type(4)));
typedef unsigned u32x4 __attribute__((ext_vector_type(4)));
constexpr int BM = 256, BK = 64, HALF = 128, HTB = HALF * BK * 2  , STAGE_BYTES = 8 * HTB, NXCD = 8, WGM = 8;

__host__ __device__ __forceinline__ int lds_byte(int r, int c) { const int st = (r >> 4) * 2 + (c >> 5), rr = r & 15, cc = c & 31, ob = rr * 64 + cc * 2; return st * 1024 + (ob ^ (((ob >> 9) & 1) << 5)); }
__host__ __device__ __forceinline__ void stage_rc(int b, int& R, int& C) { const int st = b / 1024, sb = b % 1024, swz = sb ^ (((sb >> 9) & 1) << 5); R = (st >> 1) * 16 + swz / 64; C = (st & 1) * 32 + (swz % 64) / 2; }
__host__ __device__ __forceinline__ int perm32(int rho) { const int n = rho >> 4, i = rho & 15; return 8 * (i >> 2) + 4 * n + (i & 3); }

struct Unit { int pm, pn; };
struct Gemm { const bf16_t* A; const bf16_t* Bt; int M, N, K; };

struct StaticOrder {
    int nM, nN, nwg, G, c;
    __host__ __device__ void init(int M, int N, int G_, int c_) { nM = M / BM; nN = N / BM; nwg = nM * nN; G = G_; c = c_; }
    __host__ __device__ bool next(int i, Unit& u) const {
        const long L = (long)i * G + c; if (L >= nwg) return false;
        int wgid = (int)L; { const int q = nwg / NXCD, r = nwg % NXCD, xcd = wgid % NXCD, off = wgid / NXCD; wgid = (xcd < r ? xcd * (q + 1) : r * (q + 1) + (xcd - r) * q) + off; }
        const int nig = WGM * nN, gid = wgid / nig, fm = gid * WGM, gsz = (nM - fm) < WGM ? (nM - fm) : WGM;
        u.pm = fm + ((wgid % nig) % gsz); u.pn = (wgid % nig) / gsz; return true;
    }
    __device__ __forceinline__ void a_ready(const Unit&) const {}
    __device__ __forceinline__ void done(const Unit&) const {}
};

__device__ __forceinline__ unsigned cvt_pk_bf16(float lo, float hi) { unsigned r; asm volatile("v_cvt_pk_bf16_f32 %0, %1, %2" : "=v"(r) : "v"(lo), "v"(hi)); return r; }
typedef float f32x2 __attribute__((ext_vector_type(2)));

__device__ __forceinline__ float row_rstd(const float* ssq, int row) {
    const f32x4* p = (const f32x4*)(ssq + (size_t)row * 16);
    const f32x4 a = p[0], b = p[1], c = p[2], d = p[3];
    const float s = (((a[0] + a[1]) + (a[2] + a[3])) + ((b[0] + b[1]) + (b[2] + b[3]))) + (((c[0] + c[1]) + (c[2] + c[3])) + ((d[0] + d[1]) + (d[2] + d[3])));
    return __builtin_amdgcn_rsqf(s * (1.0f / 1024.0f) + 1e-5f);
}
__device__ __forceinline__ void rows_rstd(const float* ssq, int row0, int fq, float (&rs)[2][4]) {
    f32x4 p[2][4];
#pragma unroll
    for (int ai = 0; ai < 2; ++ai)
#pragma unroll
        for (int m = 0; m < 4; ++m) p[ai][m] = *(const f32x4*)(ssq + (size_t)(row0 + ai * HALF + m * 16) * 16 + 4 * fq);
#pragma unroll
    for (int ai = 0; ai < 2; ++ai)
#pragma unroll
        for (int m = 0; m < 4; ++m) { float s = (p[ai][m][0] + p[ai][m][1]) + (p[ai][m][2] + p[ai][m][3]); s += __shfl_xor(s, 16); s += __shfl_xor(s, 32);
            rs[ai][m] = __builtin_amdgcn_rsqf(s * (1.0f / 1024.0f) + 1e-5f); }
}
struct EpiRope {
    static constexpr bool PERM = true, AFTER_DRAIN = false;
    bf16_t* Q; bf16_t* K; bf16_t* V; const float* ssq; const float* tcos; const float* tsin; float qscale;
    __device__ __forceinline__ void operator()(const f32x4 (&acc)[2][2][4][2], const Unit& u, int wr, int wc, int fr, int fq) const {
        const int t = u.pn >> 2;
        const int colt = (u.pn & 3) * BM + wc * 32 + 8 * fq;
        const int row0 = u.pm * BM + wr * 64 + fr;
        const int fi = 4 * ((wc & 1) * 4 + fq);
        float rs[2][4]; rows_rstd(ssq, row0, fq, rs);
        if (t < 2) {
            bf16_t* base = (t == 0) ? Q : K; const float sc = (t == 0) ? qscale : 1.f;
#pragma unroll
            for (int ai = 0; ai < 2; ++ai) {
                f32x4 c4[4], s4[4];
#pragma unroll
                for (int m = 0; m < 4; ++m) { const int row = row0 + ai * HALF + m * 16; c4[m] = *(const f32x4*)(tcos + (size_t)row * 32 + fi); s4[m] = *(const f32x4*)(tsin + (size_t)row * 32 + fi); }
#pragma unroll
                for (int m = 0; m < 4; ++m) {
                    const int row = row0 + ai * HALF + m * 16;
                    const float k = rs[ai][m] * sc;
                    bf16_t* rowp = base + (size_t)row * 1024 + colt;
#pragma unroll
                    for (int bj = 0; bj < 2; ++bj) {
                        const f32x4 x1 = acc[ai][bj][m][0] * k, x2 = acc[ai][bj][m][1] * k;
                        const f32x4 y1 = x1 * c4[m] - x2 * s4[m], y2 = x2 * c4[m] + x1 * s4[m];
                        u32x4 w; w.x = cvt_pk_bf16(y1[0], y1[1]); w.y = cvt_pk_bf16(y1[2], y1[3]); w.z = cvt_pk_bf16(y2[0], y2[1]); w.w = cvt_pk_bf16(y2[2], y2[3]);
                        *(u32x4*)(rowp + bj * HALF) = w;
                    }
                }
            }
        } else {
#pragma unroll
            for (int ai = 0; ai < 2; ++ai)
#pragma unroll
                for (int m = 0; m < 4; ++m) {
                    const int row = row0 + ai * HALF + m * 16;
                    const float k = rs[ai][m];
                    bf16_t* rowp = V + (size_t)row * 1024 + colt;
#pragma unroll
                    for (int bj = 0; bj < 2; ++bj) {
                        const f32x4 v0 = acc[ai][bj][m][0] * k, v1 = acc[ai][bj][m][1] * k;
                        u32x4 w; w.x = cvt_pk_bf16(v0[0], v0[1]); w.y = cvt_pk_bf16(v0[2], v0[3]); w.z = cvt_pk_bf16(v1[0], v1[1]); w.w = cvt_pk_bf16(v1[2], v1[3]);
                        *(u32x4*)(rowp + bj * HALF) = w;
                    }
                }
        }
    }
};
struct EpiScale {
    static constexpr bool PERM = true, AFTER_DRAIN = false;
    bf16_t* O; int ldc; const float* ssq; int row_off;
    __device__ __forceinline__ void operator()(const f32x4 (&acc)[2][2][4][2], const Unit& u, int wr, int wc, int fr, int fq) const {
        const int row0 = u.pm * BM + wr * 64 + fr, col0 = u.pn * BM + wc * 32 + 8 * fq;
        float rs[2][4]; rows_rstd(ssq, row_off + row0, fq, rs);
#pragma unroll
        for (int ai = 0; ai < 2; ++ai)
#pragma unroll
            for (int m = 0; m < 4; ++m) {
                const int row = row0 + ai * HALF + m * 16;
                const float k = rs[ai][m];
                bf16_t* rowp = O + (size_t)row * ldc + col0;
#pragma unroll
                for (int bj = 0; bj < 2; ++bj) {
                    const f32x4 v0 = acc[ai][bj][m][0] * k, v1 = acc[ai][bj][m][1] * k;
                    u32x4 w; w.x = cvt_pk_bf16(v0[0], v0[1]); w.y = cvt_pk_bf16(v0[2], v0[3]); w.z = cvt_pk_bf16(v1[0], v1[1]); w.w = cvt_pk_bf16(v1[2], v1[3]);
                    *(u32x4*)(rowp + bj * HALF) = w;
                }
            }
    }
};
template <bool BASE_F32> struct EpiRes {
    static constexpr bool PERM = true, AFTER_DRAIN = false;
    const float* basef; bf16_t* xb; float* ssq_out;
    __device__ __forceinline__ void operator()(const f32x4 (&acc)[2][2][4][2], const Unit& u, int wr, int wc, int fr, int fq) const {
        const int row0 = u.pm * BM + wr * 64 + fr, col0 = u.pn * BM + wc * 32 + 8 * fq;
#pragma unroll
        for (int ai = 0; ai < 2; ++ai) {
            f32x4 bf[BASE_F32 ? 4 : 1][2][2]; u32x4 bb[BASE_F32 ? 1 : 4][2];
#pragma unroll
            for (int m = 0; m < 4; ++m) { const size_t off = (size_t)(row0 + ai * HALF + m * 16) * 1024 + col0;
#pragma unroll
                for (int bj = 0; bj < 2; ++bj) {
                    if constexpr (BASE_F32) { bf[m][bj][0] = *(const f32x4*)(basef + off + bj * HALF); bf[m][bj][1] = *(const f32x4*)(basef + off + bj * HALF + 4); }
                    else bb[m][bj] = *(const u32x4*)(xb + off + bj * HALF); } }
#pragma unroll
            for (int m = 0; m < 4; ++m) {
                const int row = row0 + ai * HALF + m * 16; const size_t off = (size_t)row * 1024 + col0; float ss = 0.f;
#pragma unroll
                for (int bj = 0; bj < 2; ++bj) {
                    f32x4 b0, b1;
                    if constexpr (BASE_F32) { b0 = bf[m][bj][0]; b1 = bf[m][bj][1]; }
                    else { const u32x4 w = bb[m][bj];
                        b0 = (f32x4){__builtin_bit_cast(float, w.x << 16), __builtin_bit_cast(float, w.x & 0xffff0000u), __builtin_bit_cast(float, w.y << 16), __builtin_bit_cast(float, w.y & 0xffff0000u)};
                        b1 = (f32x4){__builtin_bit_cast(float, w.z << 16), __builtin_bit_cast(float, w.z & 0xffff0000u), __builtin_bit_cast(float, w.w << 16), __builtin_bit_cast(float, w.w & 0xffff0000u)}; }
                    const f32x4 o0 = b0 + acc[ai][bj][m][0], o1 = b1 + acc[ai][bj][m][1];
                    ss += ((o0[0] * o0[0] + o0[1] * o0[1]) + (o0[2] * o0[2] + o0[3] * o0[3])) + ((o1[0] * o1[0] + o1[1] * o1[1]) + (o1[2] * o1[2] + o1[3] * o1[3]));
                    u32x4 w; w.x = cvt_pk_bf16(o0[0], o0[1]); w.y = cvt_pk_bf16(o0[2], o0[3]); w.z = cvt_pk_bf16(o1[0], o1[1]); w.w = cvt_pk_bf16(o1[2], o1[3]);
                    *(u32x4*)(xb + off + bj * HALF) = w;
                }
                ss += __shfl_xor(ss, 16); ss += __shfl_xor(ss, 32);
                if (fq == 0) ssq_out[(size_t)row * 16 + u.pn * 4 + wc] = ss;
            }
        }
    }
};
struct EpiNull {
    static constexpr bool PERM = true, AFTER_DRAIN = false;
    float* sink;
    __device__ __forceinline__ void operator()(const f32x4 (&acc)[2][2][4][2], const Unit& u, int wr, int wc, int fr, int fq) const {
        float s = 0.f;
#pragma unroll
        for (int ai = 0; ai < 2; ++ai)
#pragma unroll
            for (int bj = 0; bj < 2; ++bj)
#pragma unroll
                for (int m = 0; m < 4; ++m)
#pragma unroll
                    for (int n = 0; n < 2; ++n) s += (acc[ai][bj][m][n][0] + acc[ai][bj][m][n][1]) + (acc[ai][bj][m][n][2] + acc[ai][bj][m][n][3]);
        if (s == 1.2345678e30f) sink[0] = s;
    }
};
template <class Epi, class Sched, bool ALIGN_EPI = false, bool SP2 = false>
__device__ __forceinline__ void gemm_phase(PG8_LAS unsigned char* lds, const Gemm g, const Sched& S, const Epi& E) {
    int tid = threadIdx.x; asm volatile("" : "+v"(tid));
    const int wid = __builtin_amdgcn_readfirstlane(tid >> 6), lane = tid & 63, wr = wid >> 2, wc = wid & 3, fr = lane & 15, fq = lane >> 4;
    const int K = g.K, nt = K / BK;
    unsigned voffA[2], voffB[2];
#pragma unroll
    for (int i = 0; i < 2; ++i) { int R, C; stage_rc(tid * 16 + i * 8192, R, C); const int Rb = Epi::PERM ? ((R & ~31) + perm32(R & 31)) : R;
        voffA[i] = (unsigned)(R * K + C) * 2u; voffB[i] = (unsigned)(Rb * K + C) * 2u; }
    const size_t kstep = (size_t)(BK * 2);
    const size_t hstep = (size_t)HALF * K * 2;
    const size_t tstep = 2 * hstep;
    const unsigned ldsw = (unsigned)wid * 1024u;
    const int aoff = lds_byte(wr * 64 + fr, fq * 8), boff = lds_byte(wc * 32 + fr, fq * 8);
#define PG8_SA(b, h) (((b) * 2 + (h)) * HTB)
#define PG8_SB(b, h) ((4 + (b) * 2 + (h)) * HTB)
#define PG8_STAGE(bufoff, gbase, voff) do { _Pragma("unroll") for (int _i = 0; _i < 2; ++_i) \
        __builtin_amdgcn_global_load_lds((const unsigned*)((const char*)(gbase) + (voff)[_i]), (PG8_LAS unsigned*)(lds + (bufoff) + ldsw + _i * 8192), 16, 0, 0); } while (0)
#define PG8_LDA(dst, b, h) do { _Pragma("unroll") for (int m = 0; m < 4; ++m) _Pragma("unroll") for (int k = 0; k < 2; ++k) dst[m][k] = *(const PG8_LAS bf16x8*)(lds + PG8_SA(b, h) + aoff + m * 2048 + k * 1024); } while (0)
#define PG8_LDB(dst, b, h) do { _Pragma("unroll") for (int n = 0; n < 2; ++n) _Pragma("unroll") for (int k = 0; k < 2; ++k) dst[n][k] = *(const PG8_LAS bf16x8*)(lds + PG8_SB(b, h) + boff + n * 2048 + k * 1024); } while (0)
#define PG8_MMA(ai, bj, At, Bt) do { __builtin_amdgcn_s_setprio(1); _Pragma("unroll") for (int m = 0; m < 4; ++m) _Pragma("unroll") for (int n = 0; n < 2; ++n) _Pragma("unroll") for (int k = 0; k < 2; ++k) \
        acc[ai][bj][m][n] = __builtin_amdgcn_mfma_f32_16x16x32_bf16(Bt[n][k], At[m][k], acc[ai][bj][m][n], 0, 0, 0); __builtin_amdgcn_s_setprio(0); } while (0)
#define PG8_WAIT_V(n) asm volatile("s_waitcnt vmcnt(" #n ")" ::: "memory")
#define PG8_WAIT_L(n) asm volatile("s_waitcnt lgkmcnt(" #n ")" ::: "memory")
#define PG8_BAR __builtin_amdgcn_s_barrier()
#define PG8_SCHED __builtin_amdgcn_sched_barrier(0)
    Unit cur, nxt; int ui = 0;
    if (!S.next(0, cur)) return;
    f32x4 acc[2][2][4][2];
#pragma unroll
    for (int a = 0; a < 2; ++a)
#pragma unroll
        for (int b = 0; b < 2; ++b)
#pragma unroll
            for (int m = 0; m < 4; ++m)
#pragma unroll
                for (int n = 0; n < 2; ++n) acc[a][b][m][n] = (f32x4){0.f, 0.f, 0.f, 0.f};
    bf16x8 At[4][2], B0[2][2], B1[2][2];
    const char* cA = (const char*)g.A + (size_t)cur.pm * tstep; const char* cB = (const char*)g.Bt + (size_t)cur.pn * tstep;
    S.a_ready(cur);
    if constexpr (SP2) {
        PG8_STAGE(PG8_SB(0, 0), cB, voffB); PG8_STAGE(PG8_SB(0, 1), cB + hstep, voffB); PG8_STAGE(PG8_SA(0, 0), cA, voffA); PG8_STAGE(PG8_SA(0, 1), cA + hstep, voffA);
        if (wr == 1) PG8_BAR;
        PG8_WAIT_V(2); PG8_BAR;
        PG8_STAGE(PG8_SB(1, 0), cB + kstep, voffB); PG8_STAGE(PG8_SA(1, 0), cA + kstep, voffA); PG8_STAGE(PG8_SB(1, 1), cB + hstep + kstep, voffB);
        PG8_WAIT_V(6); PG8_BAR;
    } else {
        PG8_STAGE(PG8_SB(0, 0), cB, voffB); PG8_STAGE(PG8_SA(0, 0), cA, voffA); PG8_STAGE(PG8_SB(0, 1), cB + hstep, voffB); PG8_STAGE(PG8_SA(0, 1), cA + hstep, voffA);
        if (wr == 1) PG8_BAR;
        PG8_WAIT_V(4); PG8_BAR;
        PG8_STAGE(PG8_SB(1, 0), cB + kstep, voffB); PG8_STAGE(PG8_SA(1, 0), cA + kstep, voffA); PG8_STAGE(PG8_SB(1, 1), cB + hstep + kstep, voffB);
        PG8_WAIT_V(6); PG8_BAR;
    }
    for (;;) {
        const bool has_next = S.next(ui + 1, nxt);
        const char* nA = has_next ? (const char*)g.A + (size_t)nxt.pm * tstep : cA; const char* nB = has_next ? (const char*)g.Bt + (size_t)nxt.pn * tstep : cB;
        for (int t = 0; t < nt; t += 2) {
            const bool last = (t == nt - 2);
            const char* a1 = cA + (size_t)(t + 1) * kstep;
            const char* a2 = last ? nA : cA + (size_t)(t + 2) * kstep; const char* b2 = last ? nB : cB + (size_t)(t + 2) * kstep;
            const char* a3 = a2 + kstep; const char* b3 = b2 + kstep;
            if (last && has_next) S.a_ready(nxt);
            if constexpr (SP2) {
            PG8_LDB(B0, 0, 0); PG8_LDB(B1, 0, 1); PG8_SCHED; PG8_LDA(At, 0, 0); PG8_STAGE(PG8_SA(1, 1), a1 + hstep, voffA);
            PG8_WAIT_V(8); PG8_WAIT_L(0); PG8_BAR; PG8_MMA(0, 0, At, B0); PG8_MMA(0, 1, At, B1); PG8_BAR; PG8_SCHED;
            PG8_LDA(At, 0, 1); PG8_STAGE(PG8_SB(0, 0), b2, voffB); PG8_STAGE(PG8_SB(0, 1), b2 + hstep, voffB); PG8_STAGE(PG8_SA(0, 0), a2, voffA);
            PG8_WAIT_V(8); PG8_WAIT_L(0); PG8_BAR; PG8_MMA(1, 0, At, B0); PG8_MMA(1, 1, At, B1); PG8_BAR; PG8_SCHED;
            PG8_LDB(B0, 1, 0); PG8_LDB(B1, 1, 1); PG8_SCHED; PG8_LDA(At, 1, 0); PG8_STAGE(PG8_SA(0, 1), a2 + hstep, voffA);
            PG8_WAIT_V(8); PG8_WAIT_L(0); PG8_BAR; PG8_MMA(0, 0, At, B0); PG8_MMA(0, 1, At, B1); PG8_BAR; PG8_SCHED;
            PG8_LDA(At, 1, 1); PG8_STAGE(PG8_SB(1, 0), b3, voffB); PG8_STAGE(PG8_SB(1, 1), b3 + hstep, voffB); PG8_STAGE(PG8_SA(1, 0), a3, voffA);
            PG8_WAIT_V(8); PG8_WAIT_L(0); PG8_BAR; PG8_MMA(1, 0, At, B0); PG8_MMA(1, 1, At, B1); PG8_BAR; PG8_SCHED;
            } else {
            PG8_LDB(B0, 0, 0); PG8_SCHED; PG8_LDA(At, 0, 0); PG8_STAGE(PG8_SA(1, 1), a1 + hstep, voffA);
            PG8_WAIT_L(8); PG8_BAR; PG8_WAIT_L(0); PG8_MMA(0, 0, At, B0); PG8_BAR; PG8_SCHED;
            PG8_LDB(B1, 0, 1); PG8_STAGE(PG8_SB(0, 0), b2, voffB);
            PG8_BAR; PG8_WAIT_L(0); PG8_MMA(0, 1, At, B1); PG8_BAR;
            PG8_LDA(At, 0, 1); PG8_STAGE(PG8_SA(0, 0), a2, voffA);
            PG8_BAR; PG8_WAIT_L(0); PG8_MMA(1, 0, At, B0); PG8_BAR; PG8_SCHED;
            PG8_STAGE(PG8_SB(0, 1), b2 + hstep, voffB);
            PG8_WAIT_V(6); PG8_BAR; PG8_MMA(1, 1, At, B1); PG8_BAR;
            PG8_LDB(B0, 1, 0); PG8_SCHED; PG8_LDA(At, 1, 0); PG8_STAGE(PG8_SA(0, 1), a2 + hstep, voffA);
            PG8_WAIT_L(8); PG8_BAR; PG8_WAIT_L(0); PG8_MMA(0, 0, At, B0); PG8_BAR; PG8_SCHED;
            PG8_LDB(B1, 1, 1); PG8_STAGE(PG8_SB(1, 0), b3, voffB);
            PG8_BAR; PG8_WAIT_L(0); PG8_MMA(0, 1, At, B1); PG8_BAR;
            PG8_LDA(At, 1, 1); PG8_STAGE(PG8_SA(1, 0), a3, voffA);
            PG8_BAR; PG8_WAIT_L(0); PG8_MMA(1, 0, At, B0); PG8_BAR; PG8_SCHED;
            PG8_STAGE(PG8_SB(1, 1), b3 + hstep, voffB);
            PG8_WAIT_V(6); PG8_BAR; PG8_MMA(1, 1, At, B1); PG8_BAR;
            }
        }
        if constexpr (ALIGN_EPI) { if (wr == 0) PG8_BAR; }
        if constexpr (!Epi::AFTER_DRAIN) { E(acc, cur, wr, wc, fr, fq); S.done(cur); }
        if (!has_next) break;
#pragma unroll
        for (int a = 0; a < 2; ++a)
#pragma unroll
            for (int b = 0; b < 2; ++b)
#pragma unroll
                for (int m = 0; m < 4; ++m)
#pragma unroll
                    for (int n = 0; n < 2; ++n) acc[a][b][m][n] = (f32x4){0.f, 0.f, 0.f, 0.f};
        cur = nxt; cA = nA; cB = nB; ++ui;
        if constexpr (ALIGN_EPI) { if (wr == 1) PG8_BAR; }
    }
    PG8_WAIT_V(0);
    if constexpr (!ALIGN_EPI) { if (wr == 0) PG8_BAR; }
    PG8_BAR;
    if constexpr (Epi::AFTER_DRAIN) { E.fused(acc, cur, wr, wc, fr, fq, lds, wid, lane); S.done(cur); }
#undef PG8_SA
#undef PG8_SB
#undef PG8_STAGE
#undef PG8_LDA
#undef PG8_LDB
#undef PG8_MMA
#undef PG8_WAIT_V
#undef PG8_WAIT_L
#undef PG8_BAR
#undef PG8_SCHED
}
}

namespace att {
typedef unsigned short bf16_t;
using bf16x8 = __attribute__((ext_vector_type(8))) short;
using s16x4  = __attribute__((ext_vector_type(4))) short;
using f32x16 = __attribute__((ext_vector_type(16))) float;
using u32x4  = __attribute__((ext_vector_type(4))) unsigned;
using f32x4a = __attribute__((ext_vector_type(4))) float;
constexpr int DV = 128, DQK = 64, NW = 8, QBLK = 32, KVBLK = 64, LD = 1024, SEQ = 2048;
constexpr int SHM_V = KVBLK * DV * 2, SHM_K = KVBLK * DQK * 2, OFF_V = 0, OFF_K = 2 * SHM_V, OFF_WS = OFF_K + 2 * SHM_K, SHM_TOTAL = OFF_WS + NW * 64 * 4;
constexpr float THR2 = 11.5f;
#define AKSW(row, colB) ((row) * 128 + ((colB) ^ ((((row) >> 1) & 7) << 4)))
#define ASBAR() __builtin_amdgcn_sched_barrier(0)
__device__ __forceinline__ int crow(int r, int hi) { return (r & 3) + 8 * (r >> 2) + 4 * hi; }
__device__ __forceinline__ unsigned cvtpk(float lo, float hi) { unsigned r; asm volatile("v_cvt_pk_bf16_f32 %0, %1, %2" : "=v"(r) : "v"(lo), "v"(hi)); return r; }

__device__ __forceinline__ void partialSM(f32x16& p0, f32x16& p1, float& m_reg, float& mn, float& alpha) {
  float pmax = p0[0];
#pragma unroll
  for (int r = 1; r < 16; ++r) pmax = fmaxf(pmax, p0[r]);
#pragma unroll
  for (int r = 0; r < 16; ++r) pmax = fmaxf(pmax, p1[r]);
  { auto rr = __builtin_amdgcn_permlane32_swap(__float_as_uint(pmax), __float_as_uint(pmax), false, false);
    pmax = fmaxf(__uint_as_float(rr[0]), __uint_as_float(rr[1])); }
  if (__builtin_expect(__all(pmax - m_reg <= THR2), 1)) { mn = m_reg; alpha = 1.f; }
  else { mn = fmaxf(m_reg, pmax); alpha = __builtin_amdgcn_exp2f(m_reg - mn); m_reg = mn; }
#pragma unroll
  for (int r = 0; r < 16; ++r) p0[r] = p0[r] - mn;
#pragma unroll
  for (int r = 0; r < 16; ++r) p1[r] = p1[r] - mn;
#pragma unroll
  for (int r = 0; r < 16; ++r) p0[r] = __builtin_amdgcn_exp2f(p0[r]);
}
__device__ __forceinline__ void finishSM(f32x16& p0, f32x16& p1, float alpha, float& l_reg, bf16x8& pa0, bf16x8& pa1, bf16x8& pa2, bf16x8& pa3) {
#pragma unroll
  for (int r = 0; r < 16; ++r) p1[r] = __builtin_amdgcn_exp2f(p1[r]);
  float ps = 0;
#pragma unroll
  for (int r = 0; r < 16; ++r) ps += p0[r];
#pragma unroll
  for (int r = 0; r < 16; ++r) ps += p1[r];
  { auto rr = __builtin_amdgcn_permlane32_swap(__float_as_uint(ps), __float_as_uint(ps), false, false);
    ps = __uint_as_float(rr[0]) + __uint_as_float(rr[1]); }
  l_reg = l_reg * alpha + ps;
#define APK4(P, BASE, OUT) do { unsigned a0 = cvtpk(P[BASE + 0], P[BASE + 1]), a1 = cvtpk(P[BASE + 2], P[BASE + 3]);   \
    unsigned b0 = cvtpk(P[BASE + 4], P[BASE + 5]), b1 = cvtpk(P[BASE + 6], P[BASE + 7]);                              \
    auto r0 = __builtin_amdgcn_permlane32_swap(a0, b0, false, false); auto r1 = __builtin_amdgcn_permlane32_swap(a1, b1, false, false); \
    u32x4 w = {r0[0], r1[0], r0[1], r1[1]}; OUT = *reinterpret_cast<bf16x8*>(&w); } while (0)
  APK4(p0, 0, pa0); APK4(p0, 8, pa1); APK4(p1, 0, pa2); APK4(p1, 8, pa3);
#undef APK4
}
__device__ __forceinline__ void qkt(f32x16& p0, f32x16& p1, const char* Ks, const bf16x8* qr, int r32, int hi) {
  p0 = f32x16{}; p1 = f32x16{};
#pragma unroll
  for (int d0 = 0; d0 < 4; ++d0) { const int cb = d0 * 32 + hi * 16;
    const bf16x8 b0 = *reinterpret_cast<const bf16x8*>(Ks + AKSW(r32, cb));
    const bf16x8 b1 = *reinterpret_cast<const bf16x8*>(Ks + AKSW(32 + r32, cb));
    p0 = __builtin_amdgcn_mfma_f32_32x32x16_bf16(b0, qr[d0], p0, 0, 0, 0);
    p1 = __builtin_amdgcn_mfma_f32_32x32x16_bf16(b1, qr[d0], p1, 0, 0, 0); }
}
__device__ __forceinline__ int v_st(int k, int c) { const int kk = (k & ~0xC) | ((k & 4) << 1) | ((k & 8) >> 1); return ((kk >> 3) * 4 + (c >> 5)) * 512 + ((kk & 7) * 32 + (c & 31)) * 2; }
__device__ __forceinline__ int v_rd_base(int lane) { return ((lane & 3) << 3) | (((lane >> 2) & 3) << 6) | (((lane >> 4) & 1) << 5) | (((lane >> 5) & 1) << 8); }
constexpr int v_rd_off(int d0, int ks, int half) { return d0 * 512 + ks * 4096 + half * 2048; }
template <int OFF> __device__ __forceinline__ s16x4 tr_read(int vb) {
  s16x4 r; asm volatile("ds_read_b64_tr_b16 %0, %1 offset:%2" : "=&v"(r) : "v"(vb), "i"(OFF) : "memory"); return r;
}
template <int D0> __device__ __forceinline__ void pv_one(f32x16& od, int vb, bf16x8 pa0, bf16x8 pa1, bf16x8 pa2, bf16x8 pa3) {
  const s16x4 l0 = tr_read<v_rd_off(D0, 0, 0)>(vb), h0 = tr_read<v_rd_off(D0, 0, 1)>(vb), l1 = tr_read<v_rd_off(D0, 1, 0)>(vb), h1 = tr_read<v_rd_off(D0, 1, 1)>(vb);
  const s16x4 l2 = tr_read<v_rd_off(D0, 2, 0)>(vb), h2 = tr_read<v_rd_off(D0, 2, 1)>(vb), l3 = tr_read<v_rd_off(D0, 3, 0)>(vb), h3 = tr_read<v_rd_off(D0, 3, 1)>(vb);
  asm volatile("s_waitcnt lgkmcnt(0)" ::: "memory"); ASBAR();
#define APK(L, H) (bf16x8){L[0], L[1], L[2], L[3], H[0], H[1], H[2], H[3]}
  od = __builtin_amdgcn_mfma_f32_32x32x16_bf16(pa0, APK(l0, h0), od, 0, 0, 0);
  od = __builtin_amdgcn_mfma_f32_32x32x16_bf16(pa1, APK(l1, h1), od, 0, 0, 0);
  od = __builtin_amdgcn_mfma_f32_32x32x16_bf16(pa2, APK(l2, h2), od, 0, 0, 0);
  od = __builtin_amdgcn_mfma_f32_32x32x16_bf16(pa3, APK(l3, h3), od, 0, 0, 0);
#undef APK
}
__device__ __forceinline__ void pv_d0(f32x16* o, int vb, bf16x8 pa0, bf16x8 pa1, bf16x8 pa2, bf16x8 pa3) {
  pv_one<0>(o[0], vb, pa0, pa1, pa2, pa3); pv_one<1>(o[1], vb, pa0, pa1, pa2, pa3); pv_one<2>(o[2], vb, pa0, pa1, pa2, pa3); pv_one<3>(o[3], vb, pa0, pa1, pa2, pa3);
}

__device__ __forceinline__ void attn_pass(const bf16_t* __restrict__ Qb, const bf16_t* __restrict__ Kh, const bf16_t* __restrict__ Vh, char* lds, f32x16 (&o)[4]) {
  int tid = threadIdx.x; asm volatile("" : "+v"(tid));
  const int wid = tid >> 6, lane = tid & 63, r32 = lane & 31, hi = lane >> 5;
  char* V_lds = lds + OFF_V; char* K_lds = lds + OFF_K;
  float* ws = (float*)(lds + OFF_WS) + wid * 64; float* li_l = ws; float* al_l = ws + 32;
  float m_reg = -1e30f, l_reg = 0; bf16x8 qr[4];
#pragma unroll
  for (int d = 0; d < 4; ++d) o[d] = f32x16{};
  const bf16_t* Qw = Qb + (long)(wid * QBLK + r32) * LD + hi * 8;
#pragma unroll
  for (int d0 = 0; d0 < 4; ++d0) qr[d0] = *reinterpret_cast<const bf16x8*>(Qw + d0 * 16);
  const int sr = tid >> 4, sc = (tid & 15) * 8, vst0 = v_st(sr, sc), vst1 = v_st(32 + sr, sc);
  const int kr = tid >> 3, kc = (tid & 7) * 8, kst = AKSW(kr, kc * 2);
  const int vb0 = (int)(uintptr_t)V_lds + v_rd_base(lane);
  bf16x8 vsA0, vsA1, ksA, vsB0, vsB1, ksB;
#define ASLOAD(S, k0) do { vs##S##0 = *reinterpret_cast<const bf16x8*>(&Vh[(long)((k0) + sr) * LD + sc]); vs##S##1 = *reinterpret_cast<const bf16x8*>(&Vh[(long)((k0) + 32 + sr) * LD + sc]); \
    ks##S = *reinterpret_cast<const bf16x8*>(&Kh[(long)((k0) + kr) * LD + kc]); } while (0)
#define ASWRITE(b, S) do { *(bf16x8*)(V_lds + (b) * SHM_V + vst0) = vs##S##0; *(bf16x8*)(V_lds + (b) * SHM_V + vst1) = vs##S##1; *(bf16x8*)(K_lds + (b) * SHM_K + kst) = ks##S; } while (0)
#define ASWAIT() asm volatile("s_waitcnt vmcnt(3)" ::: "memory")
#define ARESC(a) do { if (__any((a) < 1.f)) { if (hi == 0) al_l[r32] = (a); asm volatile("s_waitcnt lgkmcnt(0)" ::: "memory"); \
    _Pragma("unroll") for (int d = 0; d < 4; ++d) _Pragma("unroll") for (int r = 0; r < 16; ++r) o[d][r] *= al_l[crow(r, hi)]; } } while (0)
  f32x16 pA0, pA1, pB0, pB1; float mnA, mnB, alA, alB; bf16x8 pa0, pa1, pa2, pa3; constexpr int NT = SEQ / KVBLK;
  ASLOAD(A, 0); asm volatile("s_waitcnt vmcnt(0)" ::: "memory"); ASWRITE(0, A); __syncthreads();
  qkt(pA0, pA1, K_lds, qr, r32, hi); partialSM(pA0, pA1, m_reg, mnA, alA);
  ASLOAD(B, KVBLK); ASLOAD(A, 2 * KVBLK);
  ASWAIT(); ASWRITE(1, B); __syncthreads();
  for (int j = 1; j + 1 < NT; j += 2) {
    ASBAR(); qkt(pB0, pB1, K_lds + SHM_K, qr, r32, hi);
    finishSM(pA0, pA1, alA, l_reg, pa0, pa1, pa2, pa3); ASBAR();
    ASLOAD(B, (j + 2) * KVBLK); ASBAR();
    pv_d0(o, vb0, pa0, pa1, pa2, pa3); partialSM(pB0, pB1, m_reg, mnB, alB);
    __syncthreads(); ASWAIT(); ASWRITE(0, A);
    ARESC(alB); __syncthreads();
    ASBAR(); qkt(pA0, pA1, K_lds, qr, r32, hi);
    finishSM(pB0, pB1, alB, l_reg, pa0, pa1, pa2, pa3); ASBAR();
    if (j + 3 < NT) ASLOAD(A, (j + 3) * KVBLK); ASBAR();
    pv_d0(o, vb0 + SHM_V, pa0, pa1, pa2, pa3); partialSM(pA0, pA1, m_reg, mnA, alA);
    __syncthreads(); ASWAIT(); ASWRITE(1, B);
    ARESC(alA); __syncthreads();
  }
  ASBAR(); qkt(pB0, pB1, K_lds + SHM_K, qr, r32, hi);
  finishSM(pA0, pA1, alA, l_reg, pa0, pa1, pa2, pa3); ASBAR();
  pv_d0(o, vb0, pa0, pa1, pa2, pa3); partialSM(pB0, pB1, m_reg, mnB, alB);
  __syncthreads(); ARESC(alB);
  finishSM(pB0, pB1, alB, l_reg, pa0, pa1, pa2, pa3); ASBAR();
  pv_d0(o, vb0 + SHM_V, pa0, pa1, pa2, pa3);
  if (hi == 0) li_l[r32] = l_reg; asm volatile("s_waitcnt lgkmcnt(0)" ::: "memory");
#pragma unroll
  for (int r = 0; r < 16; ++r) { const float rl = __builtin_amdgcn_rcpf(li_l[crow(r, hi)]);
#pragma unroll
    for (int d = 0; d < 4; ++d) o[d][r] *= rl; }
  __syncthreads();
#undef ASLOAD
#undef ASWRITE
#undef ASWAIT
#undef ARESC
}

__device__ __forceinline__ void attn_unit(int b, int h, int qb, const bf16_t* Q, const bf16_t* K, const bf16_t* V, bf16_t* O, float* stash,
                                          float lam, const float* subg, float osc, char* lds) {
  const long rowbase = (long)b * SEQ, q0 = (long)qb * 256;
  const bf16_t* Qb = Q + (rowbase + q0) * LD + h * 128; const bf16_t* Kh = K + rowbase * LD + h * 128; const bf16_t* Vh = V + rowbase * LD + h * 128;
#pragma unroll 1
  for (int c = 0; c < 2; ++c) {
    f32x16 o[4];
    attn_pass(Qb + c * 64, Kh + c * 64, Vh, lds, o);
    int zz = 0; asm volatile("" : "+v"(zz));
    const int tid = (int)threadIdx.x + zz, wid = tid >> 6, lane = tid & 63, r32 = lane & 31, hi = lane >> 5;
    f32x4a* st = (f32x4a*)(stash + ((size_t)blockIdx.x * 512 + tid) * 64);
    if (c == 0) {
#pragma unroll
      for (int d = 0; d < 4; ++d)
#pragma unroll
        for (int q = 0; q < 4; ++q) st[d * 4 + q] = (f32x4a){o[d][4 * q], o[d][4 * q + 1], o[d][4 * q + 2], o[d][4 * q + 3]};
    } else {
      float g4[4];
#pragma unroll
      for (int d = 0; d < 4; ++d) g4[d] = subg[32 * d + r32] * osc;
      bf16_t* Ow = O + (rowbase + q0 + wid * QBLK) * LD + h * 128 + r32;
#pragma unroll
      for (int q = 0; q < 4; ++q) {
        f32x4a s4[4];
#pragma unroll
        for (int d = 0; d < 4; ++d) s4[d] = st[d * 4 + q];
#pragma unroll
        for (int j = 0; j < 4; ++j) { const int r = 4 * q + j;
          float e[4];
#pragma unroll
          for (int d = 0; d < 4; ++d) e[d] = s4[d][j] - lam * o[d][r];
          float ss = (e[0] * e[0] + e[1] * e[1]) + (e[2] * e[2] + e[3] * e[3]);
          ss += __shfl_xor(ss, 1); ss += __shfl_xor(ss, 2); ss += __shfl_xor(ss, 4); ss += __shfl_xor(ss, 8); ss += __shfl_xor(ss, 16);
          const float rs = __builtin_amdgcn_rsqf(ss * (1.0f / 128.0f) + 1e-5f);
          const int orow = crow(r, hi);
#pragma unroll
          for (int d = 0; d < 4; ++d) Ow[(long)orow * LD + d * 32] = (bf16_t)(cvtpk(e[d] * rs * g4[d], 0.f) & 0xffffu);
        }
      }
    }
  }
}
#undef AKSW
#undef ASBAR
}

namespace cg = cooperative_groups;
#define LAS __attribute__((address_space(3)))
typedef unsigned short bf16;
typedef unsigned v4u __attribute__((ext_vector_type(4)));
typedef float f32x4 __attribute__((ext_vector_type(4)));
typedef short bf16x8 __attribute__((ext_vector_type(8)));
constexpr int NWAVES = 8, NTHR = 512;
constexpr int BATCH = 32, SEQ = 2048, D = 1024, M = BATCH * SEQ, FF = 2816, FF2 = 2 * FF, NH = 8;
constexpr int MH = M / 2;
constexpr size_t MiB = 1u << 20;
constexpr size_t WS_WQKV = 0, WS_WO = 6 * MiB, WS_WIN = 8 * MiB, WS_WOUT = 14 * MiB, WS_WUP0 = 16 * MiB, WS_WUP1 = 27 * MiB, WS_WDN0 = 38 * MiB, WS_WDN1 = 44 * MiB;
constexpr size_t WS_COS = 64 * MiB, WS_SIN = 72 * MiB;
constexpr size_t WS_SSQ = 80 * MiB, SSQ_BYTES = 4 * MiB;
constexpr size_t WS_XB = 104 * MiB;
constexpr size_t WS_R = 232 * MiB;
constexpr size_t WS_Q = WS_R, WS_K = WS_R + 128 * MiB, WS_V = WS_R + 256 * MiB, WS_O = WS_R + 384 * MiB;
constexpr size_t WS_G = WS_R, WS_U = WS_R + 352 * MiB;
constexpr size_t WS_STASH = 936 * MiB;
constexpr size_t WS_END = 1000 * MiB;
constexpr int LDS_BYTES = 147456;
static_assert(att::SHM_TOTAL <= 131072, "attention LDS");

__device__ __forceinline__ unsigned f2bf(float f) { unsigned u = __builtin_bit_cast(unsigned, f); return (u + 0x7fffu + ((u >> 16) & 1u)) >> 16; }
__device__ __forceinline__ unsigned pk2(float lo, float hi) { return f2bf(lo) | (f2bf(hi) << 16); }
__device__ __forceinline__ float bflo(unsigned w) { return __builtin_bit_cast(float, w << 16); }
__device__ __forceinline__ float bfhi(unsigned w) { return __builtin_bit_cast(float, w & 0xffff0000u); }
__device__ __forceinline__ float wave_sum(float v) {
#pragma unroll
    for (int o = 1; o < 64; o <<= 1) v += __shfl_xor(v, o);
    return v;
}
__device__ __forceinline__ int dest_row(int mode, int n) {
    if (mode == 1 && n < 2048) { const int d = n & 63, dd = d & 31; return (n & ~63) + 8 * (dd >> 2) + (dd & 3) + ((d >> 5) << 2); }
    return n;
}
__device__ __forceinline__ void transpose_item(const float* W, int K, int N, bf16* WT, const float* gk, int mode, LAS float* scr, int item, int lane) {
    const int nblk = N / 32, kb = item / nblk, nb = item % nblk, k0 = 64 * kb, n0 = 32 * nb;
#pragma unroll 8
    for (int i = 0; i < 32; ++i) { const int kk = 2 * i + (lane >> 5); const float g = gk ? gk[k0 + kk] : 1.f; scr[kk * 33 + (lane & 31)] = W[(size_t)(k0 + kk) * N + n0 + (lane & 31)] * g; }
    asm volatile("s_waitcnt lgkmcnt(0)" ::: "memory");
    const int c = lane & 7;
#pragma unroll
    for (int j = 0; j < 4; ++j) { const int n = (lane >> 3) + 8 * j; const LAS float* s = scr + (8 * c) * 33 + n;
        v4u o; o.x = pk2(s[0 * 33], s[1 * 33]); o.y = pk2(s[2 * 33], s[3 * 33]); o.z = pk2(s[4 * 33], s[5 * 33]); o.w = pk2(s[6 * 33], s[7 * 33]);
        *(v4u*)(WT + (size_t)dest_row(mode, n0 + n) * K + k0 + 8 * c) = o; }
    asm volatile("s_waitcnt lgkmcnt(0)" ::: "memory");
}
__device__ __forceinline__ void sincos_cw(float a, float& s, float& c) {
    const float kf = rintf(a * 0.63661977236758134f); const int k = (int)kf;
    float r = fmaf(kf, -1.5703125f, a); r = fmaf(kf, -4.837512969970703125e-4f, r); r = fmaf(kf, -7.54978995489188216e-8f, r);
    const float z = r * r;
    const float sp = fmaf(r * z, fmaf(z, fmaf(z, -1.9515295891e-4f, 8.3321608736e-3f), -1.6666654611e-1f), r);
    const float cp = fmaf(z * z, fmaf(z, fmaf(z, 2.443315711809948e-5f, -1.388731625493765e-3f), 4.166664568298827e-2f), fmaf(z, -0.5f, 1.0f));
    const float ss = (k & 1) ? cp : sp, cc = (k & 1) ? sp : cp;
    s = (k & 2) ? -ss : ss; c = ((k + 1) & 2) ? -cc : cc;
}

struct Args {
    const float* x; const int* pos;
    const float *attn_g, *w_qkv, *lq1, *lk1, *lq2, *lk2, *subg, *w_o, *conv_g, *w_in, *conv_w, *w_out, *ffn_g, *w_up, *ffn_cw, *ffn_cb, *w_dn, *fin_g;
    float* out; unsigned char* ws;
};

__device__ __forceinline__ void ffn_ew_phase(const bf16* U, bf16* G, const float* cw, const float* cb, int gtid, int nthreads) {
    constexpr int TC = 32, NFC = FF / 8, NITEM = (MH / TC) * NFC;
    for (int it = gtid; it < NITEM; it += nthreads) {
        const int fc = it % NFC, tc = it / NFC, t0 = tc * TC, f0 = fc * 8;
        float wg[3][8], wv[3][8], bg[8], bv[8];
#pragma unroll
        for (int j = 0; j < 3; ++j)
#pragma unroll
            for (int h = 0; h < 2; ++h) { const f32x4 a = *(const f32x4*)(cw + (size_t)j * FF2 + f0 + 4 * h), b = *(const f32x4*)(cw + (size_t)j * FF2 + FF + f0 + 4 * h);
#pragma unroll
                for (int e = 0; e < 4; ++e) { wg[j][4 * h + e] = a[e]; wv[j][4 * h + e] = b[e]; } }
#pragma unroll
        for (int h = 0; h < 2; ++h) { const f32x4 a = *(const f32x4*)(cb + f0 + 4 * h), b = *(const f32x4*)(cb + FF + f0 + 4 * h);
#pragma unroll
            for (int e = 0; e < 4; ++e) { bg[4 * h + e] = a[e]; bv[4 * h + e] = b[e]; } }
        const bf16* up = U + (size_t)t0 * FF2 + f0;
        const v4u zero = {0u, 0u, 0u, 0u};
        v4u pg, pv, cg_, cv, ng, nv;
        if (t0 % SEQ == 0) { pg = zero; pv = zero; } else { pg = *(const v4u*)(up - FF2); pv = *(const v4u*)(up - FF2 + FF); }
        cg_ = *(const v4u*)(up); cv = *(const v4u*)(up + FF);
#pragma unroll 4
        for (int i = 0; i < TC; ++i) {
            if (i == TC - 1 && (t0 + TC) % SEQ == 0) { ng = zero; nv = zero; } else { ng = *(const v4u*)(up + (size_t)(i + 1) * FF2); nv = *(const v4u*)(up + (size_t)(i + 1) * FF2 + FF); }
            v4u o;
#pragma unroll
            for (int q = 0; q < 4; ++q) {
                const float g0 = fmaf(wg[0][2 * q], bflo(pg[q]), fmaf(wg[1][2 * q], bflo(cg_[q]), fmaf(wg[2][2 * q], bflo(ng[q]), bg[2 * q])));
                const float g1 = fmaf(wg[0][2 * q + 1], bfhi(pg[q]), fmaf(wg[1][2 * q + 1], bfhi(cg_[q]), fmaf(wg[2][2 * q + 1], bfhi(ng[q]), bg[2 * q + 1])));
                const float v0 = fmaf(wv[0][2 * q], bflo(pv[q]), fmaf(wv[1][2 * q], bflo(cv[q]), fmaf(wv[2][2 * q], bflo(nv[q]), bv[2 * q])));
                const float v1 = fmaf(wv[0][2 * q + 1], bfhi(pv[q]), fmaf(wv[1][2 * q + 1], bfhi(cv[q]), fmaf(wv[2][2 * q + 1], bfhi(nv[q]), bv[2 * q + 1])));
                const float s0 = g0 * __builtin_amdgcn_rcpf(1.f + __builtin_amdgcn_exp2f(-1.4426950408889634f * g0));
                const float s1 = g1 * __builtin_amdgcn_rcpf(1.f + __builtin_amdgcn_exp2f(-1.4426950408889634f * g1));
                o[q] = pk2(s0 * v0, s1 * v1);
            }
            *(v4u*)(G + (size_t)(t0 + i) * FF + f0) = o;
            pg = cg_; pv = cv; cg_ = ng; cv = nv;
        }
    }
}
__device__ __forceinline__ void mixer_ew_phase(const bf16* R, bf16* Y, const float* cw, int gtid, int nthreads) {
    constexpr int TC = 32, NFC = D / 8, NITEM = (M / TC) * NFC;
    for (int it = gtid; it < NITEM; it += nthreads) {
        const int fc = it % NFC, tc = it / NFC, t0 = tc * TC, f0 = fc * 8;
        float w[3][8];
#pragma unroll
        for (int j = 0; j < 3; ++j)
#pragma unroll
            for (int h = 0; h < 2; ++h) { const f32x4 a = *(const f32x4*)(cw + (size_t)j * D + f0 + 4 * h);
#pragma unroll
                for (int e = 0; e < 4; ++e) w[j][4 * h + e] = a[e]; }
        const bf16* rp = R + (size_t)t0 * (3 * D) + f0;
        float p[8], c[8], n[8];
#define MIX_CU(dst, ptr) do { const v4u c_ = *(const v4u*)((ptr) + D), u_ = *(const v4u*)((ptr) + 2 * D); \
        _Pragma("unroll") for (int q = 0; q < 4; ++q) { dst[2 * q] = bflo(c_[q]) * bflo(u_[q]); dst[2 * q + 1] = bfhi(c_[q]) * bfhi(u_[q]); } } while (0)
        if (t0 % SEQ == 0) {
#pragma unroll
            for (int e = 0; e < 8; ++e) p[e] = 0.f;
        } else MIX_CU(p, rp - 3 * D);
        MIX_CU(c, rp);
#pragma unroll 4
        for (int i = 0; i < TC; ++i) {
            if (i == TC - 1 && (t0 + TC) % SEQ == 0) {
#pragma unroll
                for (int e = 0; e < 8; ++e) n[e] = 0.f;
            } else MIX_CU(n, rp + (size_t)(i + 1) * (3 * D));
            const v4u b_ = *(const v4u*)(rp + (size_t)i * (3 * D));
            v4u o;
#pragma unroll
            for (int q = 0; q < 4; ++q) {
                const float y0 = bflo(b_[q]) * fmaf(w[0][2 * q], p[2 * q], fmaf(w[1][2 * q], c[2 * q], w[2][2 * q] * n[2 * q]));
                const float y1 = bfhi(b_[q]) * fmaf(w[0][2 * q + 1], p[2 * q + 1], fmaf(w[1][2 * q + 1], c[2 * q + 1], w[2][2 * q + 1] * n[2 * q + 1]));
                o[q] = pk2(y0, y1);
            }
            *(v4u*)(Y + (size_t)(t0 + i) * D + f0) = o;
#pragma unroll
            for (int e = 0; e < 8; ++e) { p[e] = c[e]; c[e] = n[e]; }
        }
#undef MIX_CU
    }
}

#ifndef PROBE_ATTN
#define PROBE_ATTN 1
#endif
#ifndef PROBE_EW
#define PROBE_EW 1
#endif
#ifndef PROBE_QKV
#define PROBE_QKV 1
#endif
typedef const __attribute__((address_space(4))) Args* CArgs;
__device__ __forceinline__ CArgs get_args() { CArgs p = (CArgs)__builtin_amdgcn_kernarg_segment_ptr(); asm volatile("" : "+s"(p)); return p; }
#define WSP(off) (a->ws + (off))
#define WUP_T(l) ((bf16*)WSP(WS_WUP0 + (size_t)(l) * (WS_WUP1 - WS_WUP0)))
#define WDN_T(l) ((bf16*)WSP(WS_WDN0 + (size_t)(l) * (WS_WDN1 - WS_WDN0)))
#define SSQ(i) ((float*)WSP(WS_SSQ + (size_t)(i) * SSQ_BYTES))
#define GEO() int tid = threadIdx.x; asm volatile("" : "+v"(tid)); const int lane = tid & 63, wave = __builtin_amdgcn_readfirstlane(tid >> 6); const int G = gridDim.x, bx = blockIdx.x; \
    const int vcu = (G % 8 == 0) ? (bx % 8) * (G / 8) + bx / 8 : bx; const int gw = vcu * NWAVES + wave, NGW = G * NWAVES, gtid = bx * NTHR + tid, NT = G * NTHR; \
    (void)lane; (void)gw; (void)NGW; (void)gtid; (void)NT; (void)vcu

__global__ void __launch_bounds__(NTHR, 2) mega_fwd(Args a_unused) {
    extern __shared__ __attribute__((aligned(16))) unsigned char lds[];
    cg::grid_group grid = cg::this_grid();
    LAS unsigned char* ldsl = (LAS unsigned char*)lds;

    {
        CArgs a = get_args(); GEO();
        bf16* Wqkv_t = (bf16*)WSP(WS_WQKV); bf16* Wo_t = (bf16*)WSP(WS_WO); bf16* Win_t = (bf16*)WSP(WS_WIN); bf16* Wout_t = (bf16*)WSP(WS_WOUT);
        float* tcos = (float*)WSP(WS_COS); float* tsin = (float*)WSP(WS_SIN); bf16* XB = (bf16*)WSP(WS_XB);
        LAS float* scr = (LAS float*)(ldsl + wave * 16384);
        constexpr int I_QKV = (D / 64) * (3 * D / 32), I_O = (D / 64) * (D / 32), I_UP = (D / 64) * (FF2 / 32), I_DN = (FF / 64) * (D / 32);
        constexpr int NITEMS = 2 * I_QKV + 2 * I_O + 2 * I_UP + 2 * I_DN;
        for (int it = gw; it < NITEMS; it += NGW) {
            int r = it;
            if (r < I_QKV) { transpose_item(a->w_qkv, D, 3 * D, Wqkv_t, a->attn_g, 1, scr, r, lane); continue; } r -= I_QKV;
            if (r < I_QKV) { transpose_item(a->w_in, D, 3 * D, Win_t, a->conv_g, 0, scr, r, lane); continue; } r -= I_QKV;
            if (r < I_O) { transpose_item(a->w_o, D, D, Wo_t, nullptr, 0, scr, r, lane); continue; } r -= I_O;
            if (r < I_O) { transpose_item(a->w_out, D, D, Wout_t, nullptr, 0, scr, r, lane); continue; } r -= I_O;
            if (r < I_UP) { transpose_item(a->w_up, D, FF2, WUP_T(0), a->ffn_g, 0, scr, r, lane); continue; } r -= I_UP;
            if (r < I_UP) { transpose_item(a->w_up + (size_t)D * FF2, D, FF2, WUP_T(1), a->ffn_g + D, 0, scr, r, lane); continue; } r -= I_UP;
            if (r < I_DN) { transpose_item(a->w_dn, FF, D, WDN_T(0), nullptr, 0, scr, r, lane); continue; } r -= I_DN;
            transpose_item(a->w_dn + (size_t)FF * D, FF, D, WDN_T(1), nullptr, 0, scr, r, lane);
        }
        const int* pos = a->pos;
        for (int i = gtid; i < M * 32; i += NT) {
            const int d = i & 31; const float inv = __builtin_amdgcn_exp2f(-(float)d * (13.287712379549449f / 32.0f));
            float s, c; sincos_cw((float)pos[i >> 5] * inv, s, c); tcos[i] = c; tsin[i] = s;
        }
        const float* x = a->x; float* ssq0 = SSQ(0);
        for (int m = gw; m < M; m += NGW) {
            const f32x4* xr = (const f32x4*)(x + (size_t)m * D) + lane; float s = 0.f;
            unsigned long long* o8 = (unsigned long long*)(XB + (size_t)m * D) + lane;
#pragma unroll
            for (int j = 0; j < 4; ++j) { const f32x4 v = xr[64 * j]; s += (v.x * v.x + v.y * v.y) + (v.z * v.z + v.w * v.w);
                o8[64 * j] = (unsigned long long)pk2(v.x, v.y) | ((unsigned long long)pk2(v.z, v.w) << 32); }
            s = wave_sum(s);
            if (lane < 16) ssq0[(size_t)m * 16 + lane] = lane == 0 ? s : 0.f;
        }
    }
    grid.sync();

    {
        CArgs a = get_args();
        pg8::Gemm g{(bf16*)WSP(WS_XB), (bf16*)WSP(WS_WQKV), M, 3 * D, D}; pg8::StaticOrder S; S.init(M, 3 * D, gridDim.x, blockIdx.x);
        pg8::EpiRope E{(bf16*)WSP(WS_Q), (bf16*)WSP(WS_K), (bf16*)WSP(WS_V), SSQ(0), (float*)WSP(WS_COS), (float*)WSP(WS_SIN), 0.125f * 1.4426950408889634f};
        for (int rep = 0; rep < PROBE_QKV; ++rep) pg8::gemm_phase<pg8::EpiRope, pg8::StaticOrder, true, true>(ldsl, g, S, E);
#ifdef PROBE_KLOOP
        { pg8::EpiNull EN{(float*)WSP(WS_STASH)}; pg8::gemm_phase<pg8::EpiNull, pg8::StaticOrder, true, true>(ldsl, g, S, EN); }
#endif
    }
    grid.sync();
    {
        CArgs a = get_args(); GEO();
        const float lambda_init = 0.8f - 0.6f * 1.0f;
        const float s1 = wave_sum(a->lq1[lane] * a->lk1[lane]), s2 = wave_sum(a->lq2[lane] * a->lk2[lane]);
        const float lam = __expf(s1) - __expf(s2) + lambda_init;
        const bf16* Qb = (const bf16*)WSP(WS_Q); const bf16* Kb = (const bf16*)WSP(WS_K); const bf16* Vb = (const bf16*)WSP(WS_V); bf16* Ob = (bf16*)WSP(WS_O);
        float* stash = (float*)WSP(WS_STASH); const float* subg = a->subg;
#pragma unroll 1
        for (int rep = 0; rep < PROBE_ATTN; ++rep)
#pragma unroll 1
        for (int i = 0;; ++i) {
            const int id = i * G + vcu; if (id >= BATCH * NH * (SEQ / 256)) break;
            const int bh = id >> 3, qb = id & 7;
            att::attn_unit(bh >> 3, bh & 7, qb, Qb, Kb, Vb, Ob, stash, lam, subg, 1.0f - lambda_init, (char*)lds);
        }
    }
    grid.sync();
    {
        CArgs a = get_args();
        pg8::Gemm g{(bf16*)WSP(WS_O), (bf16*)WSP(WS_WO), M, D, D}; pg8::StaticOrder S; S.init(M, D, gridDim.x, blockIdx.x);
        pg8::EpiRes<true> E{a->x, (bf16*)WSP(WS_XB), SSQ(1)};
        pg8::gemm_phase<pg8::EpiRes<true>, pg8::StaticOrder, true, true>(ldsl, g, S, E);
    }
    grid.sync();
#pragma unroll 1
    for (int layer = 0; layer < 2; ++layer) {
        if (layer == 1) {
            {   CArgs a = get_args();
                pg8::Gemm g{(bf16*)WSP(WS_XB), (bf16*)WSP(WS_WIN), M, 3 * D, D}; pg8::StaticOrder S; S.init(M, 3 * D, gridDim.x, blockIdx.x);
                pg8::EpiScale E{(bf16*)WSP(WS_Q), 3 * D, SSQ(2), 0};
                pg8::gemm_phase<pg8::EpiScale, pg8::StaticOrder, true, true>(ldsl, g, S, E); }
            grid.sync();
            {   CArgs a = get_args(); GEO();
                mixer_ew_phase((const bf16*)WSP(WS_Q), (bf16*)WSP(WS_O), a->conv_w, gtid, NT); }
            grid.sync();
            {   CArgs a = get_args();
                pg8::Gemm g{(bf16*)WSP(WS_O), (bf16*)WSP(WS_WOUT), M, D, D}; pg8::StaticOrder S; S.init(M, D, gridDim.x, blockIdx.x);
                pg8::EpiRes<false> E{nullptr, (bf16*)WSP(WS_XB), SSQ(3)};
                pg8::gemm_phase<pg8::EpiRes<false>, pg8::StaticOrder, true, true>(ldsl, g, S, E); }
            grid.sync();
        }
#pragma unroll 1
        for (int hf = 0; hf < 2; ++hf) {
            {   CArgs a = get_args();
                pg8::Gemm g{(bf16*)WSP(WS_XB) + (size_t)hf * MH * D, WUP_T(layer), MH, FF2, D}; pg8::StaticOrder S; S.init(MH, FF2, gridDim.x, blockIdx.x);
                pg8::EpiScale E{(bf16*)WSP(WS_U), FF2, SSQ(layer == 0 ? 1 : 3), hf * MH};
                pg8::gemm_phase<pg8::EpiScale, pg8::StaticOrder, true, true>(ldsl, g, S, E); }
            grid.sync();
            {   CArgs a = get_args(); GEO();
                for (int rep = 0; rep < PROBE_EW; ++rep) ffn_ew_phase((const bf16*)WSP(WS_U), (bf16*)WSP(WS_G) + (size_t)hf * MH * FF, a->ffn_cw + (size_t)layer * 3 * FF2, a->ffn_cb + (size_t)layer * FF2, gtid, NT); }
            grid.sync();
        }
        {   CArgs a = get_args();
            pg8::Gemm g{(bf16*)WSP(WS_G), WDN_T(layer), M, D, FF}; pg8::StaticOrder S; S.init(M, D, gridDim.x, blockIdx.x);
            pg8::EpiRes<false> E{nullptr, (bf16*)WSP(WS_XB), SSQ(layer == 0 ? 2 : 4)};
            pg8::gemm_phase<pg8::EpiRes<false>, pg8::StaticOrder, true, true>(ldsl, g, S, E); }
        grid.sync();
    }
    {   CArgs a = get_args(); GEO();
        float* out = a->out; const float* fg = a->fin_g; const float* ssq4 = SSQ(4); const bf16* XB = (const bf16*)WSP(WS_XB);
        for (int m = gw; m < M; m += NGW) {
            const float rs = pg8::row_rstd(ssq4, m);
            const v4u* xr = (const v4u*)(XB + (size_t)m * D) + lane; f32x4* orow = (f32x4*)(out + (size_t)m * D) + 2 * lane; const f32x4* gr = (const f32x4*)fg + 2 * lane;
#pragma unroll
            for (int j = 0; j < 2; ++j) { const v4u w = xr[64 * j]; const f32x4 g0 = gr[128 * j], g1 = gr[128 * j + 1];
                orow[128 * j] = (f32x4){bflo(w.x), bfhi(w.x), bflo(w.y), bfhi(w.y)} * rs * g0; orow[128 * j + 1] = (f32x4){bflo(w.z), bfhi(w.z), bflo(w.w), bfhi(w.w)} * rs * g1; }
        }
    }
}

extern "C" void kernel_launch(void* const* d_in, const int* in_sizes, int n_in, void* d_out, int out_size, void* d_ws, size_t ws_size, hipStream_t stream) {
    static int grid = 0;
    if (grid == 0) {
        if (n_in != 20 || in_sizes[0] != M * D || out_size != M * D || ws_size < WS_END) { fprintf(stderr, "kernel_launch: shape mismatch n_in %d in0 %d out %d ws %zu\n", n_in, n_in > 0 ? in_sizes[0] : -1, out_size, ws_size); grid = -1; return; }
        int dev = 0, cus = 0, per_cu = 0;
        if (hipGetDevice(&dev) != hipSuccess || hipDeviceGetAttribute(&cus, hipDeviceAttributeMultiprocessorCount, dev) != hipSuccess) { grid = -1; return; }
        if (hipFuncSetAttribute((const void*)mega_fwd, hipFuncAttributeMaxDynamicSharedMemorySize, LDS_BYTES) != hipSuccess) { fprintf(stderr, "kernel_launch: hipFuncSetAttribute failed\n"); grid = -1; return; }
        if (hipOccupancyMaxActiveBlocksPerMultiprocessor(&per_cu, (const void*)mega_fwd, NTHR, LDS_BYTES) != hipSuccess || per_cu < 1) { fprintf(stderr, "kernel_launch: occupancy query says %d\n", per_cu); per_cu = 1; }
        (void)hipGetLastError();
        grid = cus;
    }
    if (grid < 0) return;
    Args a{};
    a.x = (const float*)d_in[0]; a.pos = (const int*)d_in[1];
    a.attn_g = (const float*)d_in[2]; a.w_qkv = (const float*)d_in[3]; a.lq1 = (const float*)d_in[4]; a.lk1 = (const float*)d_in[5]; a.lq2 = (const float*)d_in[6]; a.lk2 = (const float*)d_in[7];
    a.subg = (const float*)d_in[8]; a.w_o = (const float*)d_in[9]; a.conv_g = (const float*)d_in[10]; a.w_in = (const float*)d_in[11]; a.conv_w = (const float*)d_in[12]; a.w_out = (const float*)d_in[13];
    a.ffn_g = (const float*)d_in[14]; a.w_up = (const float*)d_in[15]; a.ffn_cw = (const float*)d_in[16]; a.ffn_cb = (const float*)d_in[17]; a.w_dn = (const float*)d_in[18]; a.fin_g = (const float*)d_in[19];
    a.out = (float*)d_out; a.ws = (unsigned char*)d_ws;
    void* args[] = {&a};
    const hipError_t e = hipLaunchCooperativeKernel((const void*)mega_fwd, dim3(grid), dim3(NTHR), args, LDS_BYTES, stream);
    if (e != hipSuccess) fprintf(stderr, "kernel_launch: cooperative launch failed: %s (grid %d)\n", hipGetErrorString(e), grid);
}
```

```cpp
#include <hip/hip_runtime.h>
#include <hip/hip_cooperative_groups.h>
#include <cstdio>
#include <cstdint>

template <int MASK> __device__ __forceinline__ float lane_xor_add(float x) {
    if constexpr (MASK == 32) {
        int l = (int)__builtin_amdgcn_mbcnt_hi(~0u, __builtin_amdgcn_mbcnt_lo(~0u, 0u)); asm volatile("" : "+v"(l));
        return x + __builtin_bit_cast(float, __builtin_amdgcn_ds_bpermute((l ^ 32) << 2, __builtin_bit_cast(int, x))); }
    else return x + __builtin_bit_cast(float, __builtin_amdgcn_ds_swizzle(__builtin_bit_cast(int, x), (MASK << 10) | 0x1F));
}
#ifndef DPP_PREV
#define DPP_PREV 0x121
#define DPP_NEXT 0x12F
#endif
namespace pg8 {
#define PG8_LAS __attribute__((address_space(3)))
typedef unsigned short bf16_t;
typedef short bf16x8 __attribute__((ext_vector_type(8)));
typedef float f32x4 __attribute__((ext_vector_type(4)));
typedef unsigned u32x4 __attribute__((ext_vector_type(4)));
constexpr int BM = 256, BK = 64, HALF = 128, HTB = HALF * BK * 2  , STAGE_BYTES = 8 * HTB, NXCD = 8, WGM = 8;

__host__ __device__ __forceinline__ int lds_byte(int r, int c) { const int st = (r >> 4) * 2 + (c >> 5), rr = r & 15, cc = c & 31, ob = rr * 64 + cc * 2; return st * 1024 + (ob ^ (((ob >> 9) & 1) << 5)); }
__host__ __device__ __forceinline__ void stage_rc(int b, int& R, int& C) { const int st = b / 1024, sb = b % 1024, swz = sb ^ (((sb >> 9) & 1) << 5); R = (st >> 1) * 16 + swz / 64; C = (st & 1) * 32 + (swz % 64) / 2; }
__host__ __device__ __forceinline__ int perm32(int rho) { const int n = rho >> 4, i = rho & 15; return 8 * (i >> 2) + 4 * n + (i & 3); }

struct Unit { int pm, pn; };
struct Gemm { const bf16_t* A; const bf16_t* Bt; int M, N, K; };

struct StaticOrder {
    int nM, nN, nwg, G, c;
    __host__ __device__ void init(int M, int N, int G_, int c_) { nM = M / BM; nN = N / BM; nwg = nM * nN; G = G_; c = c_; }
    __host__ __device__ bool next(int i, Unit& u) const {
        const long L = (long)i * G + c; if (L >= nwg) return false;
        int wgid = (int)L; { const int q = nwg / NXCD, r = nwg % NXCD, xcd = wgid % NXCD, off = wgid / NXCD; wgid = (xcd < r ? xcd * (q + 1) : r * (q + 1) + (xcd - r) * q) + off; }
        const int nig = WGM * nN, gid = wgid / nig, fm = gid * WGM, gsz = (nM - fm) < WGM ? (nM - fm) : WGM;
        u.pm = fm + ((wgid % nig) % gsz); u.pn = (wgid % nig) / gsz; return true;
    }
    __device__ __forceinline__ void a_ready(const Unit&) const {}
    __device__ __forceinline__ void done(const Unit&) const {}
};

__device__ __forceinline__ unsigned cvt_pk_bf16(float lo, float hi) { unsigned r; asm volatile("v_cvt_pk_bf16_f32 %0, %1, %2" : "=v"(r) : "v"(lo), "v"(hi)); return r; }
typedef float f32x2 __attribute__((ext_vector_type(2)));

__device__ __forceinline__ float row_rstd(const float* ssq, int row) {
    const f32x4* p = (const f32x4*)(ssq + (size_t)row * 16);
    const f32x4 a = p[0], b = p[1], c = p[2], d = p[3];
    const float s = (((a[0] + a[1]) + (a[2] + a[3])) + ((b[0] + b[1]) + (b[2] + b[3]))) + (((c[0] + c[1]) + (c[2] + c[3])) + ((d[0] + d[1]) + (d[2] + d[3])));
    return __builtin_amdgcn_rsqf(s * (1.0f / 1024.0f) + 1e-5f);
}
__device__ __forceinline__ void rows_rstd(const float* ssq, int row0, int fq, float (&rs)[2][4]) {
    f32x4 p[2][4];
#pragma unroll
    for (int ai = 0; ai < 2; ++ai)
#pragma unroll
        for (int m = 0; m < 4; ++m) p[ai][m] = *(const f32x4*)(ssq + (size_t)(row0 + ai * HALF + m * 16) * 16 + 4 * fq);
#pragma unroll
    for (int ai = 0; ai < 2; ++ai)
#pragma unroll
        for (int m = 0; m < 4; ++m) { float s = (p[ai][m][0] + p[ai][m][1]) + (p[ai][m][2] + p[ai][m][3]); s = lane_xor_add<16>(s); s = lane_xor_add<32>(s);
            rs[ai][m] = __builtin_amdgcn_rsqf(s * (1.0f / 1024.0f) + 1e-5f); }
}
struct EpiRope {
    static constexpr bool PERM = true, AFTER_DRAIN = false;
    bf16_t* Q; bf16_t* K; bf16_t* V; const float* ssq; const float* tcos; const float* tsin; float qscale;
    __device__ __forceinline__ void operator()(const f32x4 (&acc)[2][2][4][2], const Unit& u, int wr, int wc, int fr, int fq) const {
        const int t = u.pn >> 2;
        const int colt = (u.pn & 3) * BM + wc * 32 + 8 * fq;
        const int row0 = u.pm * BM + wr * 64 + fr;
        const int fi = 4 * ((wc & 1) * 4 + fq);
        float rs[2][4]; rows_rstd(ssq, row0, fq, rs);
        if (t < 2) {
            bf16_t* base = (t == 0) ? Q : K; const float sc = (t == 0) ? qscale : 1.f;
#pragma unroll
            for (int ai = 0; ai < 2; ++ai)
#pragma unroll
                for (int mh = 0; mh < 2; ++mh) {
                    f32x4 c4[2], s4[2];
#pragma unroll
                    for (int mm = 0; mm < 2; ++mm) { const int row = row0 + ai * HALF + (2 * mh + mm) * 16; c4[mm] = *(const f32x4*)(tcos + (size_t)row * 32 + fi); s4[mm] = *(const f32x4*)(tsin + (size_t)row * 32 + fi); }
#pragma unroll
                    for (int mm = 0; mm < 2; ++mm) {
                        const int m = 2 * mh + mm, row = row0 + ai * HALF + m * 16;
                        const float k = rs[ai][m] * sc;
                        bf16_t* rowp = base + (size_t)row * 1024 + colt;
#pragma unroll
                        for (int bj = 0; bj < 2; ++bj) {
                            const f32x4 x1 = acc[ai][bj][m][0] * k, x2 = acc[ai][bj][m][1] * k;
                            const f32x4 y1 = x1 * c4[mm] - x2 * s4[mm], y2 = x2 * c4[mm] + x1 * s4[mm];
                            u32x4 w; w.x = cvt_pk_bf16(y1[0], y1[1]); w.y = cvt_pk_bf16(y1[2], y1[3]); w.z = cvt_pk_bf16(y2[0], y2[1]); w.w = cvt_pk_bf16(y2[2], y2[3]);
                            *(u32x4*)(rowp + bj * HALF) = w;
                        }
                    }
                    __builtin_amdgcn_sched_barrier(0);
                }
        } else {
#pragma unroll
            for (int ai = 0; ai < 2; ++ai)
#pragma unroll
                for (int m = 0; m < 4; ++m) {
                    const int row = row0 + ai * HALF + m * 16;
                    const float k = rs[ai][m];
                    bf16_t* rowp = V + (size_t)row * 1024 + colt;
#pragma unroll
                    for (int bj = 0; bj < 2; ++bj) {
                        const f32x4 v0 = acc[ai][bj][m][0] * k, v1 = acc[ai][bj][m][1] * k;
                        u32x4 w; w.x = cvt_pk_bf16(v0[0], v0[1]); w.y = cvt_pk_bf16(v0[2], v0[3]); w.z = cvt_pk_bf16(v1[0], v1[1]); w.w = cvt_pk_bf16(v1[2], v1[3]);
                        *(u32x4*)(rowp + bj * HALF) = w;
                    }
                }
        }
    }
};
struct EpiScale {
    static constexpr bool PERM = true, AFTER_DRAIN = false;
    bf16_t* O; int ldc; const float* ssq; int row_off;
    __device__ __forceinline__ void operator()(const f32x4 (&acc)[2][2][4][2], const Unit& u, int wr, int wc, int fr, int fq) const {
        const int row0 = u.pm * BM + wr * 64 + fr, col0 = u.pn * BM + wc * 32 + 8 * fq;
        float rs[2][4]; rows_rstd(ssq, row_off + row0, fq, rs);
#pragma unroll
        for (int ai = 0; ai < 2; ++ai)
#pragma unroll
            for (int m = 0; m < 4; ++m) {
                const int row = row0 + ai * HALF + m * 16;
                const float k = rs[ai][m];
                bf16_t* rowp = O + (size_t)row * ldc + col0;
#pragma unroll
                for (int bj = 0; bj < 2; ++bj) {
                    const f32x4 v0 = acc[ai][bj][m][0] * k, v1 = acc[ai][bj][m][1] * k;
                    u32x4 w; w.x = cvt_pk_bf16(v0[0], v0[1]); w.y = cvt_pk_bf16(v0[2], v0[3]); w.z = cvt_pk_bf16(v1[0], v1[1]); w.w = cvt_pk_bf16(v1[2], v1[3]);
                    *(u32x4*)(rowp + bj * HALF) = w;
                }
            }
    }
};
template <bool BASE_F32> struct EpiRes {
    static constexpr bool PERM = true, AFTER_DRAIN = false;
    const float* basef; bf16_t* xb; float* ssq_out;
    __device__ __forceinline__ void operator()(const f32x4 (&acc)[2][2][4][2], const Unit& u, int wr, int wc, int fr, int fq) const {
        const int row0 = u.pm * BM + wr * 64 + fr, col0 = u.pn * BM + wc * 32 + 8 * fq;
#pragma unroll
        for (int ai = 0; ai < 2; ++ai) {
            f32x4 bf[BASE_F32 ? 4 : 1][2][2]; u32x4 bb[BASE_F32 ? 1 : 4][2];
#pragma unroll
            for (int m = 0; m < 4; ++m) { const size_t off = (size_t)(row0 + ai * HALF + m * 16) * 1024 + col0;
#pragma unroll
                for (int bj = 0; bj < 2; ++bj) {
                    if constexpr (BASE_F32) { bf[m][bj][0] = *(const f32x4*)(basef + off + bj * HALF); bf[m][bj][1] = *(const f32x4*)(basef + off + bj * HALF + 4); }
                    else bb[m][bj] = *(const u32x4*)(xb + off + bj * HALF); } }
#pragma unroll
            for (int m = 0; m < 4; ++m) {
                const int row = row0 + ai * HALF + m * 16; const size_t off = (size_t)row * 1024 + col0; float ss = 0.f;
#pragma unroll
                for (int bj = 0; bj < 2; ++bj) {
                    f32x4 b0, b1;
                    if constexpr (BASE_F32) { b0 = bf[m][bj][0]; b1 = bf[m][bj][1]; }
                    else { const u32x4 w = bb[m][bj];
                        b0 = (f32x4){__builtin_bit_cast(float, w.x << 16), __builtin_bit_cast(float, w.x & 0xffff0000u), __builtin_bit_cast(float, w.y << 16), __builtin_bit_cast(float, w.y & 0xffff0000u)};
                        b1 = (f32x4){__builtin_bit_cast(float, w.z << 16), __builtin_bit_cast(float, w.z & 0xffff0000u), __builtin_bit_cast(float, w.w << 16), __builtin_bit_cast(float, w.w & 0xffff0000u)}; }
                    const f32x4 o0 = b0 + acc[ai][bj][m][0], o1 = b1 + acc[ai][bj][m][1];
                    ss += ((o0[0] * o0[0] + o0[1] * o0[1]) + (o0[2] * o0[2] + o0[3] * o0[3])) + ((o1[0] * o1[0] + o1[1] * o1[1]) + (o1[2] * o1[2] + o1[3] * o1[3]));
                    u32x4 w; w.x = cvt_pk_bf16(o0[0], o0[1]); w.y = cvt_pk_bf16(o0[2], o0[3]); w.z = cvt_pk_bf16(o1[0], o1[1]); w.w = cvt_pk_bf16(o1[2], o1[3]);
                    *(u32x4*)(xb + off + bj * HALF) = w;
                }
                ss = lane_xor_add<16>(ss); ss = lane_xor_add<32>(ss);
                if (fq == 0) ssq_out[(size_t)row * 16 + u.pn * 4 + wc] = ss;
            }
        }
    }
};
__device__ __forceinline__ float dpp_ror1_f(float x) { return __builtin_bit_cast(float, __builtin_amdgcn_update_dpp(0, __builtin_bit_cast(int, x), DPP_PREV, 0xF, 0xF, false)); }
__device__ __forceinline__ float dpp_ror15_f(float x) { return __builtin_bit_cast(float, __builtin_amdgcn_update_dpp(0, __builtin_bit_cast(int, x), DPP_NEXT, 0xF, 0xF, false)); }
__device__ __forceinline__ f32x4 dpp_ror1(f32x4 v) { f32x4 r; r.x = dpp_ror1_f(v.x); r.y = dpp_ror1_f(v.y); r.z = dpp_ror1_f(v.z); r.w = dpp_ror1_f(v.w); return r; }
__device__ __forceinline__ f32x4 dpp_ror15(f32x4 v) { f32x4 r; r.x = dpp_ror15_f(v.x); r.y = dpp_ror15_f(v.y); r.z = dpp_ror15_f(v.z); r.w = dpp_ror15_f(v.w); return r; }
__device__ __forceinline__ f32x4 sel4(bool c, f32x4 a, f32x4 b) { return (f32x4){c ? a[0] : b[0], c ? a[1] : b[1], c ? a[2] : b[2], c ? a[3] : b[3]}; }
__device__ __forceinline__ float silu_f(float g) { return g * __builtin_amdgcn_rcpf(1.f + __builtin_amdgcn_exp2f(-1.4426950408889634f * g)); }
struct EpiFfn {
    static constexpr bool PERM = true, AFTER_DRAIN = false;
    bf16_t* G; const float* ssq; const float* cw; const float* cb; float* HU; float* HP; PG8_LAS unsigned char* ex;
    __device__ __forceinline__ void operator()(f32x4 (&acc)[2][2][4][2], const Unit& u, int wr, int wc, int fr_in, int fq_in) const {
        typedef unsigned u32x2e __attribute__((ext_vector_type(2)));
        int t_ = threadIdx.x; asm volatile("" : "+v"(t_)); const int fr = t_ & 15, fq = (t_ >> 4) & 3; (void)fr_in; (void)fq_in;
        constexpr int FFc = 2816, FF2c = 5632;
        const int row0 = u.pm * BM + wr * 64 + fr;
        const bool is_first = (fr == 0), is_last = (fr == 15);
#pragma unroll
        for (int ai = 0; ai < 2; ++ai) {
            f32x4 p[4];
#pragma unroll
            for (int m = 0; m < 4; ++m) p[m] = *(const f32x4*)(ssq + (size_t)(row0 + ai * HALF + m * 16) * 16 + 4 * fq);
#pragma unroll
            for (int m = 0; m < 4; ++m) { float s = (p[m][0] + p[m][1]) + (p[m][2] + p[m][3]); s = lane_xor_add<16>(s); s = lane_xor_add<32>(s);
                const float r = __builtin_amdgcn_rsqf(s * (1.0f / 1024.0f) + 1e-5f);
#pragma unroll
                for (int bj = 0; bj < 2; ++bj)
#pragma unroll
                    for (int n = 0; n < 2; ++n) acc[ai][bj][m][n] = acc[ai][bj][m][n] * r; }
        }
        PG8_LAS float* EX = (PG8_LAS float*)ex;
        const int cj = wc * 32 + 8 * fq;
#pragma unroll
        for (int ai = 0; ai < 2; ++ai)
#pragma unroll
            for (int bj = 0; bj < 2; ++bj)
#pragma unroll
                for (int n = 0; n < 2; ++n) {
                    if (is_first) *(PG8_LAS f32x4*)(EX + ((ai * 2 + wr) * 2 + 0) * 256 + bj * 128 + cj + 4 * n) = acc[ai][bj][0][n];
                    if (is_last)  *(PG8_LAS f32x4*)(EX + ((ai * 2 + wr) * 2 + 1) * 256 + bj * 128 + cj + 4 * n) = acc[ai][bj][3][n];
                }
        asm volatile("s_waitcnt lgkmcnt(0)" ::: "memory"); __builtin_amdgcn_s_barrier(); asm volatile("" ::: "memory");
        const int f0 = u.pn * 128 + wc * 32 + 8 * fq;
        const f32x4 zero4 = {0.f, 0.f, 0.f, 0.f};
#pragma unroll
        for (int ai = 0; ai < 2; ++ai) {
            const int g = ai * 2 + wr;
#pragma unroll
            for (int bj = 0; bj < 2; ++bj) {
#pragma unroll
                for (int n = 0; n < 2; ++n) {
                    f32x4 wgt[4];
#pragma unroll
                    for (int j = 0; j < 3; ++j) wgt[j] = *(const f32x4*)(cw + (size_t)j * FF2c + n * FFc + f0 + 4 * bj);
                    wgt[3] = *(const f32x4*)(cb + n * FFc + f0 + 4 * bj);
                    const f32x4 hp = (g == 0) ? zero4 : *(const PG8_LAS f32x4*)(EX + ((g - 1) * 2 + 1) * 256 + bj * 128 + cj + 4 * n);
                    const f32x4 hn = (g == 3) ? zero4 : *(const PG8_LAS f32x4*)(EX + ((g + 1) * 2 + 0) * 256 + bj * 128 + cj + 4 * n);
                    f32x4 r1p = hp, r15c = dpp_ror15(acc[ai][bj][0][n]);
#pragma unroll
                    for (int m = 0; m < 4; ++m) {
                        const f32x4 X = acc[ai][bj][m][n];
                        const f32x4 r1m = dpp_ror1(X);
                        const f32x4 prev = sel4(is_first, r1p, r1m); r1p = r1m;
                        const f32x4 r15n = (m < 3) ? dpp_ror15(acc[ai][bj][m < 3 ? m + 1 : 3][n]) : hn;
                        const f32x4 next = sel4(is_last, r15n, r15c); r15c = r15n;
                        const f32x4 Y = wgt[0] * prev + (wgt[1] * X + (wgt[2] * next + wgt[3]));
                        if (m == 0) { if (g == 0 && is_first) { int co = cj; asm volatile("" : "+v"(co)); const size_t hb = ((size_t)u.pm * 2 + 0) * FF2c + u.pn * 256 + bj * 128 + co + 4 * n; *(f32x4*)(HU + hb) = X; *(f32x4*)(HP + hb) = Y; } }
                        if (m == 3) { if (g == 3 && is_last) { int co = cj; asm volatile("" : "+v"(co)); const size_t hb = ((size_t)u.pm * 2 + 1) * FF2c + u.pn * 256 + bj * 128 + co + 4 * n; *(f32x4*)(HU + hb) = X; *(f32x4*)(HP + hb) = Y; } }
                        if (n == 0) acc[ai][bj][m][0] = (f32x4){silu_f(Y[0]), silu_f(Y[1]), silu_f(Y[2]), silu_f(Y[3])};
                        else { const f32x4 o = acc[ai][bj][m][0] * Y; u32x2e w; w.x = cvt_pk_bf16(o[0], o[1]); w.y = cvt_pk_bf16(o[2], o[3]);
                            *(u32x2e*)(G + (size_t)(row0 + ai * HALF + m * 16) * FFc + f0 + 4 * bj) = w; }
                    }
                    __builtin_amdgcn_sched_barrier(0);
                }
            }
        }
    }
};
struct EpiNull {
    static constexpr bool PERM = true, AFTER_DRAIN = false;
    float* sink;
    __device__ __forceinline__ void operator()(const f32x4 (&acc)[2][2][4][2], const Unit& u, int wr, int wc, int fr, int fq) const {
        float s = 0.f;
#pragma unroll
        for (int ai = 0; ai < 2; ++ai)
#pragma unroll
            for (int bj = 0; bj < 2; ++bj)
#pragma unroll
                for (int m = 0; m < 4; ++m)
#pragma unroll
                    for (int n = 0; n < 2; ++n) s += (acc[ai][bj][m][n][0] + acc[ai][bj][m][n][1]) + (acc[ai][bj][m][n][2] + acc[ai][bj][m][n][3]);
        if (s == 1.2345678e30f) sink[0] = s;
    }
};
template <class Epi, class Sched, bool ALIGN_EPI = false, bool SP2 = false>
__device__ __forceinline__ void gemm_phase(PG8_LAS unsigned char* lds, const Gemm g, const Sched& S, const Epi& E) {
    int tid = threadIdx.x; asm volatile("" : "+v"(tid));
    const int wid = __builtin_amdgcn_readfirstlane(tid >> 6), lane = tid & 63, wr = wid >> 2, wc = wid & 3, fr = lane & 15, fq = lane >> 4;
    const int K = g.K, nt = K / BK;
    unsigned voffA[2], voffB[2];
#pragma unroll
    for (int i = 0; i < 2; ++i) { int R, C; stage_rc(tid * 16 + i * 8192, R, C); const int Rb = Epi::PERM ? ((R & ~31) + perm32(R & 31)) : R;
        voffA[i] = (unsigned)(R * K + C) * 2u; voffB[i] = (unsigned)(Rb * K + C) * 2u; }
    const size_t kstep = (size_t)(BK * 2);
    const size_t hstep = (size_t)HALF * K * 2;
    const size_t tstep = 2 * hstep;
    const unsigned ldsw = (unsigned)wid * 1024u;
    const int aoff = lds_byte(wr * 64 + fr, fq * 8), boff = lds_byte(wc * 32 + fr, fq * 8);
#define PG8_SA(b, h) (((b) * 2 + (h)) * HTB)
#define PG8_SB(b, h) ((4 + (b) * 2 + (h)) * HTB)
#define PG8_STAGE(bufoff, gbase, voff) do { _Pragma("unroll") for (int _i = 0; _i < 2; ++_i) \
        __builtin_amdgcn_global_load_lds((const unsigned*)((const char*)(gbase) + (voff)[_i]), (PG8_LAS unsigned*)(lds + (bufoff) + ldsw + _i * 8192), 16, 0, 0); } while (0)
#define PG8_LDA(dst, b, h) do { _Pragma("unroll") for (int m = 0; m < 4; ++m) _Pragma("unroll") for (int k = 0; k < 2; ++k) dst[m][k] = *(const PG8_LAS bf16x8*)(lds + PG8_SA(b, h) + aoff + m * 2048 + k * 1024); } while (0)
#define PG8_LDB(dst, b, h) do { _Pragma("unroll") for (int n = 0; n < 2; ++n) _Pragma("unroll") for (int k = 0; k < 2; ++k) dst[n][k] = *(const PG8_LAS bf16x8*)(lds + PG8_SB(b, h) + boff + n * 2048 + k * 1024); } while (0)
#define PG8_MMA(ai, bj, At, Bt) do { __builtin_amdgcn_s_setprio(1); _Pragma("unroll") for (int m = 0; m < 4; ++m) _Pragma("unroll") for (int n = 0; n < 2; ++n) _Pragma("unroll") for (int k = 0; k < 2; ++k) \
        acc[ai][bj][m][n] = __builtin_amdgcn_mfma_f32_16x16x32_bf16(Bt[n][k], At[m][k], acc[ai][bj][m][n], 0, 0, 0); __builtin_amdgcn_s_setprio(0); } while (0)
#define PG8_WAIT_V(n) asm volatile("s_waitcnt vmcnt(" #n ")" ::: "memory")
#define PG8_WAIT_L(n) asm volatile("s_waitcnt lgkmcnt(" #n ")" ::: "memory")
#define PG8_BAR __builtin_amdgcn_s_barrier()
#define PG8_SCHED __builtin_amdgcn_sched_barrier(0)
    Unit cur, nxt; int ui = 0;
    if (!S.next(0, cur)) return;
    f32x4 acc[2][2][4][2];
#pragma unroll
    for (int a = 0; a < 2; ++a)
#pragma unroll
        for (int b = 0; b < 2; ++b)
#pragma unroll
            for (int m = 0; m < 4; ++m)
#pragma unroll
                for (int n = 0; n < 2; ++n) acc[a][b][m][n] = (f32x4){0.f, 0.f, 0.f, 0.f};
    bf16x8 At[4][2], B0[2][2], B1[2][2];
    const char* cA = (const char*)g.A + (size_t)cur.pm * tstep; const char* cB = (const char*)g.Bt + (size_t)cur.pn * tstep;
    S.a_ready(cur);
    if constexpr (SP2) {
        PG8_STAGE(PG8_SB(0, 0), cB, voffB); PG8_STAGE(PG8_SB(0, 1), cB + hstep, voffB); PG8_STAGE(PG8_SA(0, 0), cA, voffA); PG8_STAGE(PG8_SA(0, 1), cA + hstep, voffA);
        if (wr == 1) PG8_BAR;
        PG8_WAIT_V(2); PG8_BAR;
        PG8_STAGE(PG8_SB(1, 0), cB + kstep, voffB); PG8_STAGE(PG8_SA(1, 0), cA + kstep, voffA); PG8_STAGE(PG8_SB(1, 1), cB + hstep + kstep, voffB);
        PG8_WAIT_V(6); PG8_BAR;
    } else {
        PG8_STAGE(PG8_SB(0, 0), cB, voffB); PG8_STAGE(PG8_SA(0, 0), cA, voffA); PG8_STAGE(PG8_SB(0, 1), cB + hstep, voffB); PG8_STAGE(PG8_SA(0, 1), cA + hstep, voffA);
        if (wr == 1) PG8_BAR;
        PG8_WAIT_V(4); PG8_BAR;
        PG8_STAGE(PG8_SB(1, 0), cB + kstep, voffB); PG8_STAGE(PG8_SA(1, 0), cA + kstep, voffA); PG8_STAGE(PG8_SB(1, 1), cB + hstep + kstep, voffB);
        PG8_WAIT_V(6); PG8_BAR;
    }
    for (;;) {
        const bool has_next = S.next(ui + 1, nxt);
        const char* nA = has_next ? (const char*)g.A + (size_t)nxt.pm * tstep : cA; const char* nB = has_next ? (const char*)g.Bt + (size_t)nxt.pn * tstep : cB;
        for (int t = 0; t < nt; t += 2) {
            const bool last = (t == nt - 2);
            const char* a1 = cA + (size_t)(t + 1) * kstep;
            const char* a2 = last ? nA : cA + (size_t)(t + 2) * kstep; const char* b2 = last ? nB : cB + (size_t)(t + 2) * kstep;
            const char* a3 = a2 + kstep; const char* b3 = b2 + kstep;
            if (last && has_next) S.a_ready(nxt);
            if constexpr (SP2) {
            PG8_LDB(B0, 0, 0); PG8_LDB(B1, 0, 1); PG8_SCHED; PG8_LDA(At, 0, 0); PG8_STAGE(PG8_SA(1, 1), a1 + hstep, voffA);
            PG8_WAIT_V(8); PG8_WAIT_L(0); PG8_BAR; PG8_MMA(0, 0, At, B0); PG8_MMA(0, 1, At, B1); PG8_BAR; PG8_SCHED;
            PG8_LDA(At, 0, 1); PG8_STAGE(PG8_SB(0, 0), b2, voffB); PG8_STAGE(PG8_SB(0, 1), b2 + hstep, voffB); PG8_STAGE(PG8_SA(0, 0), a2, voffA);
            PG8_WAIT_V(8); PG8_WAIT_L(0); PG8_BAR; PG8_MMA(1, 0, At, B0); PG8_MMA(1, 1, At, B1); PG8_BAR; PG8_SCHED;
            PG8_LDB(B0, 1, 0); PG8_LDB(B1, 1, 1); PG8_SCHED; PG8_LDA(At, 1, 0); PG8_STAGE(PG8_SA(0, 1), a2 + hstep, voffA);
            PG8_WAIT_V(8); PG8_WAIT_L(0); PG8_BAR; PG8_MMA(0, 0, At, B0); PG8_MMA(0, 1, At, B1); PG8_BAR; PG8_SCHED;
            PG8_LDA(At, 1, 1); PG8_STAGE(PG8_SB(1, 0), b3, voffB); PG8_STAGE(PG8_SB(1, 1), b3 + hstep, voffB); PG8_STAGE(PG8_SA(1, 0), a3, voffA);
            PG8_WAIT_V(8); PG8_WAIT_L(0); PG8_BAR; PG8_MMA(1, 0, At, B0); PG8_MMA(1, 1, At, B1); PG8_BAR; PG8_SCHED;
            } else {
            PG8_LDB(B0, 0, 0); PG8_SCHED; PG8_LDA(At, 0, 0); PG8_STAGE(PG8_SA(1, 1), a1 + hstep, voffA);
            PG8_WAIT_L(8); PG8_BAR; PG8_WAIT_L(0); PG8_MMA(0, 0, At, B0); PG8_BAR; PG8_SCHED;
            PG8_LDB(B1, 0, 1); PG8_STAGE(PG8_SB(0, 0), b2, voffB);
            PG8_BAR; PG8_WAIT_L(0); PG8_MMA(0, 1, At, B1); PG8_BAR;
            PG8_LDA(At, 0, 1); PG8_STAGE(PG8_SA(0, 0), a2, voffA);
            PG8_BAR; PG8_WAIT_L(0); PG8_MMA(1, 0, At, B0); PG8_BAR; PG8_SCHED;
            PG8_STAGE(PG8_SB(0, 1), b2 + hstep, voffB);
            PG8_WAIT_V(6); PG8_BAR; PG8_MMA(1, 1, At, B1); PG8_BAR;
            PG8_LDB(B0, 1, 0); PG8_SCHED; PG8_LDA(At, 1, 0); PG8_STAGE(PG8_SA(0, 1), a2 + hstep, voffA);
            PG8_WAIT_L(8); PG8_BAR; PG8_WAIT_L(0); PG8_MMA(0, 0, At, B0); PG8_BAR; PG8_SCHED;
            PG8_LDB(B1, 1, 1); PG8_STAGE(PG8_SB(1, 0), b3, voffB);
            PG8_BAR; PG8_WAIT_L(0); PG8_MMA(0, 1, At, B1); PG8_BAR;
            PG8_LDA(At, 1, 1); PG8_STAGE(PG8_SA(1, 0), a3, voffA);
            PG8_BAR; PG8_WAIT_L(0); PG8_MMA(1, 0, At, B0); PG8_BAR; PG8_SCHED;
            PG8_STAGE(PG8_SB(1, 1), b3 + hstep, voffB);
            PG8_WAIT_V(6); PG8_BAR; PG8_MMA(1, 1, At, B1); PG8_BAR;
            }
        }
        if constexpr (ALIGN_EPI) { if (wr == 0) PG8_BAR; }
        if constexpr (!Epi::AFTER_DRAIN) { E(acc, cur, wr, wc, fr, fq); S.done(cur); }
        if (!has_next) break;
#pragma unroll
        for (int a = 0; a < 2; ++a)
#pragma unroll
            for (int b = 0; b < 2; ++b)
#pragma unroll
                for (int m = 0; m < 4; ++m)
#pragma unroll
                    for (int n = 0; n < 2; ++n) acc[a][b][m][n] = (f32x4){0.f, 0.f, 0.f, 0.f};
        cur = nxt; cA = nA; cB = nB; ++ui;
        if constexpr (ALIGN_EPI) { if (wr == 1) PG8_BAR; }
    }
    PG8_WAIT_V(0);
    if constexpr (!ALIGN_EPI) { if (wr == 0) PG8_BAR; }
    PG8_BAR;
    if constexpr (Epi::AFTER_DRAIN) { E.fused(acc, cur, wr, wc, fr, fq, lds, wid, lane); S.done(cur); }
#undef PG8_SA
#undef PG8_SB
#undef PG8_STAGE
#undef PG8_LDA
#undef PG8_LDB
#undef PG8_MMA
#undef PG8_WAIT_V
#undef PG8_WAIT_L
#undef PG8_BAR
#undef PG8_SCHED
}
}

namespace att {
typedef unsigned short bf16_t;
using bf16x8 = __attribute__((ext_vector_type(8))) short;
using s16x4  = __attribute__((ext_vector_type(4))) short;
using f32x16 = __attribute__((ext_vector_type(16))) float;
using u32x4  = __attribute__((ext_vector_type(4))) unsigned;
using f32x4a = __attribute__((ext_vector_type(4))) float;
constexpr int DV = 128, DQK = 64, NW = 8, QBLK = 32, KVBLK = 64, LD = 1024, SEQ = 2048;
constexpr int SHM_V = KVBLK * DV * 2, SHM_K = KVBLK * DQK * 2, OFF_V = 0, OFF_K = 2 * SHM_V, OFF_WS = OFF_K + 2 * SHM_K, SHM_TOTAL = OFF_WS + NW * 64 * 4;
constexpr float THR2 = 11.5f;
#define AKSW(row, colB) ((row) * 128 + ((colB) ^ ((((row) >> 1) & 7) << 4)))
#define ASBAR() __builtin_amdgcn_sched_barrier(0)
__device__ __forceinline__ int crow(int r, int hi) { return (r & 3) + 8 * (r >> 2) + 4 * hi; }
__device__ __forceinline__ unsigned cvtpk(float lo, float hi) { unsigned r; asm volatile("v_cvt_pk_bf16_f32 %0, %1, %2" : "=v"(r) : "v"(lo), "v"(hi)); return r; }

__device__ __forceinline__ void partialSM(f32x16& p0, f32x16& p1, float& m_reg, float& mn, float& alpha) {
  float pmax = p0[0];
#pragma unroll
  for (int r = 1; r < 16; ++r) pmax = fmaxf(pmax, p0[r]);
#pragma unroll
  for (int r = 0; r < 16; ++r) pmax = fmaxf(pmax, p1[r]);
  { unsigned xa = __float_as_uint(pmax), xb; asm volatile("v_mov_b32 %0, %1" : "=v"(xb) : "v"(xa)); auto rr = __builtin_amdgcn_permlane32_swap(xa, xb, false, false);
    pmax = fmaxf(__uint_as_float(rr[0]), __uint_as_float(rr[1])); }
  if (__builtin_expect(__all(pmax - m_reg <= THR2), 1)) { mn = m_reg; alpha = 1.f; }
  else { mn = fmaxf(m_reg, pmax); alpha = __builtin_amdgcn_exp2f(m_reg - mn); m_reg = mn; }
#pragma unroll
  for (int r = 0; r < 16; ++r) p0[r] = p0[r] - mn;
#pragma unroll
  for (int r = 0; r < 16; ++r) p1[r] = p1[r] - mn;
#pragma unroll
  for (int r = 0; r < 16; ++r) p0[r] = __builtin_amdgcn_exp2f(p0[r]);
}
__device__ __forceinline__ void finishSM(f32x16& p0, f32x16& p1, float alpha, float& l_reg, bf16x8& pa0, bf16x8& pa1, bf16x8& pa2, bf16x8& pa3) {
#pragma unroll
  for (int r = 0; r < 16; ++r) p1[r] = __builtin_amdgcn_exp2f(p1[r]);
  float ps = 0;
#pragma unroll
  for (int r = 0; r < 16; ++r) ps += p0[r];
#pragma unroll
  for (int r = 0; r < 16; ++r) ps += p1[r];
  ps = lane_xor_add<32>(ps);
  l_reg = l_reg * alpha + ps;
#define APK4(P, BASE, OUT) do { unsigned a0 = cvtpk(P[BASE + 0], P[BASE + 1]), a1 = cvtpk(P[BASE + 2], P[BASE + 3]);   \
    unsigned b0 = cvtpk(P[BASE + 4], P[BASE + 5]), b1 = cvtpk(P[BASE + 6], P[BASE + 7]);                              \
    auto r0 = __builtin_amdgcn_permlane32_swap(a0, b0, false, false); auto r1 = __builtin_amdgcn_permlane32_swap(a1, b1, false, false); \
    u32x4 w = {r0[0], r1[0], r0[1], r1[1]}; OUT = *reinterpret_cast<bf16x8*>(&w); } while (0)
  APK4(p0, 0, pa0); APK4(p0, 8, pa1); APK4(p1, 0, pa2); APK4(p1, 8, pa3);
#undef APK4
}
__device__ __forceinline__ void qkt(f32x16& p0, f32x16& p1, const char* Ks, const bf16x8* qr, int r32, int hi) {
  p0 = f32x16{}; p1 = f32x16{};
#pragma unroll
  for (int d0 = 0; d0 < 4; ++d0) { const int cb = d0 * 32 + hi * 16;
    const bf16x8 b0 = *reinterpret_cast<const bf16x8*>(Ks + AKSW(r32, cb));
    const bf16x8 b1 = *reinterpret_cast<const bf16x8*>(Ks + AKSW(32 + r32, cb));
    p0 = __builtin_amdgcn_mfma_f32_32x32x16_bf16(b0, qr[d0], p0, 0, 0, 0);
    p1 = __builtin_amdgcn_mfma_f32_32x32x16_bf16(b1, qr[d0], p1, 0, 0, 0); }
}
__device__ __forceinline__ int v_st(int k, int c) { const int kk = (k & ~0xC) | ((k & 4) << 1) | ((k & 8) >> 1); return ((kk >> 3) * 4 + (c >> 5)) * 512 + ((kk & 7) * 32 + (c & 31)) * 2; }
__device__ __forceinline__ int v_rd_base(int lane) { return ((lane & 3) << 3) | (((lane >> 2) & 3) << 6) | (((lane >> 4) & 1) << 5) | (((lane >> 5) & 1) << 8); }
constexpr int v_rd_off(int d0, int ks, int half) { return d0 * 512 + ks * 4096 + half * 2048; }
template <int OFF> __device__ __forceinline__ s16x4 tr_read(int vb) {
  s16x4 r; asm volatile("ds_read_b64_tr_b16 %0, %1 offset:%2" : "=&v"(r) : "v"(vb), "i"(OFF) : "memory"); return r;
}
template <int D0> __device__ __forceinline__ void pv_one(f32x16& od, int vb, bf16x8 pa0, bf16x8 pa1, bf16x8 pa2, bf16x8 pa3) {
  const s16x4 l0 = tr_read<v_rd_off(D0, 0, 0)>(vb), h0 = tr_read<v_rd_off(D0, 0, 1)>(vb), l1 = tr_read<v_rd_off(D0, 1, 0)>(vb), h1 = tr_read<v_rd_off(D0, 1, 1)>(vb);
  const s16x4 l2 = tr_read<v_rd_off(D0, 2, 0)>(vb), h2 = tr_read<v_rd_off(D0, 2, 1)>(vb), l3 = tr_read<v_rd_off(D0, 3, 0)>(vb), h3 = tr_read<v_rd_off(D0, 3, 1)>(vb);
  asm volatile("s_waitcnt lgkmcnt(0)" ::: "memory"); ASBAR();
#define APK(L, H) (bf16x8){L[0], L[1], L[2], L[3], H[0], H[1], H[2], H[3]}
  od = __builtin_amdgcn_mfma_f32_32x32x16_bf16(pa0, APK(l0, h0), od, 0, 0, 0);
  od = __builtin_amdgcn_mfma_f32_32x32x16_bf16(pa1, APK(l1, h1), od, 0, 0, 0);
  od = __builtin_amdgcn_mfma_f32_32x32x16_bf16(pa2, APK(l2, h2), od, 0, 0, 0);
  od = __builtin_amdgcn_mfma_f32_32x32x16_bf16(pa3, APK(l3, h3), od, 0, 0, 0);
#undef APK
}
__device__ __forceinline__ void pv_d0(f32x16* o, int vb, bf16x8 pa0, bf16x8 pa1, bf16x8 pa2, bf16x8 pa3) {
  pv_one<0>(o[0], vb, pa0, pa1, pa2, pa3); pv_one<1>(o[1], vb, pa0, pa1, pa2, pa3); pv_one<2>(o[2], vb, pa0, pa1, pa2, pa3); pv_one<3>(o[3], vb, pa0, pa1, pa2, pa3);
}

__device__ __forceinline__ void attn_pass(const bf16_t* __restrict__ Qb, const bf16_t* __restrict__ Kh, const bf16_t* __restrict__ Vh, char* lds, f32x16 (&o)[4]) {
  int tid = threadIdx.x; asm volatile("" : "+v"(tid));
  const int wid = tid >> 6, lane = tid & 63, r32 = lane & 31, hi = lane >> 5;
  char* V_lds = lds + OFF_V; char* K_lds = lds + OFF_K;
  float* ws = (float*)(lds + OFF_WS) + wid * 64; float* li_l = ws; float* al_l = ws + 32;
  float m_reg = -1e30f, l_reg = 0; bf16x8 qr[4];
#pragma unroll
  for (int d = 0; d < 4; ++d) o[d] = f32x16{};
  const bf16_t* Qw = Qb + (long)(wid * QBLK + r32) * LD + hi * 8;
#pragma unroll
  for (int d0 = 0; d0 < 4; ++d0) qr[d0] = *reinterpret_cast<const bf16x8*>(Qw + d0 * 16);
  const int sr = tid >> 4, sc = (tid & 15) * 8, vst0 = v_st(sr, sc), vst1 = v_st(32 + sr, sc);
  const int kr = tid >> 3, kc = (tid & 7) * 8, kst = AKSW(kr, kc * 2);
  const int vb0 = (int)(uintptr_t)V_lds + v_rd_base(lane);
  bf16x8 vsA0, vsA1, ksA, vsB0, vsB1, ksB;
#define ASLOAD(S, k0) do { vs##S##0 = *reinterpret_cast<const bf16x8*>(&Vh[(long)((k0) + sr) * LD + sc]); vs##S##1 = *reinterpret_cast<const bf16x8*>(&Vh[(long)((k0) + 32 + sr) * LD + sc]); \
    ks##S = *reinterpret_cast<const bf16x8*>(&Kh[(long)((k0) + kr) * LD + kc]); } while (0)
#define ASWRITE(b, S) do { *(bf16x8*)(V_lds + (b) * SHM_V + vst0) = vs##S##0; *(bf16x8*)(V_lds + (b) * SHM_V + vst1) = vs##S##1; *(bf16x8*)(K_lds + (b) * SHM_K + kst) = ks##S; } while (0)
#define ASWAIT() asm volatile("s_waitcnt vmcnt(3)" ::: "memory")
#define ARESC(a) do { if (__any((a) < 1.f)) { if (hi == 0) al_l[r32] = (a); asm volatile("s_waitcnt lgkmcnt(0)" ::: "memory"); \
    _Pragma("unroll") for (int d = 0; d < 4; ++d) _Pragma("unroll") for (int r = 0; r < 16; ++r) o[d][r] *= al_l[crow(r, hi)]; } } while (0)
  f32x16 pA0, pA1, pB0, pB1; float mnA, mnB, alA, alB; bf16x8 pa0, pa1, pa2, pa3; constexpr int NT = SEQ / KVBLK;
  ASLOAD(A, 0); asm volatile("s_waitcnt vmcnt(0)" ::: "memory"); ASWRITE(0, A); __syncthreads();
  qkt(pA0, pA1, K_lds, qr, r32, hi); partialSM(pA0, pA1, m_reg, mnA, alA);
  ASLOAD(B, KVBLK); ASLOAD(A, 2 * KVBLK);
  ASWAIT(); ASWRITE(1, B); __syncthreads();
  for (int j = 1; j + 1 < NT; j += 2) {
    ASBAR(); qkt(pB0, pB1, K_lds + SHM_K, qr, r32, hi);
    finishSM(pA0, pA1, alA, l_reg, pa0, pa1, pa2, pa3); ASBAR();
    ASLOAD(B, (j + 2) * KVBLK); ASBAR();
    pv_d0(o, vb0, pa0, pa1, pa2, pa3); partialSM(pB0, pB1, m_reg, mnB, alB);
    __syncthreads(); ASWAIT(); ASWRITE(0, A);
    ARESC(alB); __syncthreads();
    ASBAR(); qkt(pA0, pA1, K_lds, qr, r32, hi);
    finishSM(pB0, pB1, alB, l_reg, pa0, pa1, pa2, pa3); ASBAR();
    if (j + 3 < NT) ASLOAD(A, (j + 3) * KVBLK); ASBAR();
    pv_d0(o, vb0 + SHM_V, pa0, pa1, pa2, pa3); partialSM(pA0, pA1, m_reg, mnA, alA);
    __syncthreads(); ASWAIT(); ASWRITE(1, B);
    ARESC(alA); __syncthreads();
  }
  ASBAR(); qkt(pB0, pB1, K_lds + SHM_K, qr, r32, hi);
  finishSM(pA0, pA1, alA, l_reg, pa0, pa1, pa2, pa3); ASBAR();
  pv_d0(o, vb0, pa0, pa1, pa2, pa3); partialSM(pB0, pB1, m_reg, mnB, alB);
  __syncthreads(); ARESC(alB);
  finishSM(pB0, pB1, alB, l_reg, pa0, pa1, pa2, pa3); ASBAR();
  pv_d0(o, vb0 + SHM_V, pa0, pa1, pa2, pa3);
  if (hi == 0) li_l[r32] = l_reg; asm volatile("s_waitcnt lgkmcnt(0)" ::: "memory");
#pragma unroll
  for (int r = 0; r < 16; ++r) { const float rl = __builtin_amdgcn_rcpf(li_l[crow(r, hi)]);
#pragma unroll
    for (int d = 0; d < 4; ++d) o[d][r] *= rl; }
  __syncthreads();
#undef ASLOAD
#undef ASWRITE
#undef ASWAIT
#undef ARESC
}

__device__ __forceinline__ void attn_unit(int b, int h, int qb, const bf16_t* Q, const bf16_t* K, const bf16_t* V, bf16_t* O, float* stash,
                                          float lam, const float* subg, float osc, char* lds) {
  const long rowbase = (long)b * SEQ, q0 = (long)qb * 256;
  const bf16_t* Qb = Q + (rowbase + q0) * LD + h * 128; const bf16_t* Kh = K + rowbase * LD + h * 128; const bf16_t* Vh = V + rowbase * LD + h * 128;
#pragma unroll 1
  for (int c = 0; c < 2; ++c) {
    f32x16 o[4];
    attn_pass(Qb + c * 64, Kh + c * 64, Vh, lds, o);
    int zz = 0; asm volatile("" : "+v"(zz));
    const int tid = (int)threadIdx.x + zz, wid = tid >> 6, lane = tid & 63, r32 = lane & 31, hi = lane >> 5;
    f32x4a* st = (f32x4a*)(stash + ((size_t)blockIdx.x * 512 + tid) * 64);
    if (c == 0) {
#pragma unroll
      for (int d = 0; d < 4; ++d)
#pragma unroll
        for (int q = 0; q < 4; ++q) st[d * 4 + q] = (f32x4a){o[d][4 * q], o[d][4 * q + 1], o[d][4 * q + 2], o[d][4 * q + 3]};
    } else {
      float g4[4];
#pragma unroll
      for (int d = 0; d < 4; ++d) g4[d] = subg[32 * d + r32] * osc;
      bf16_t* Ow = O + (rowbase + q0 + wid * QBLK) * LD + h * 128 + r32;
#pragma unroll
      for (int q = 0; q < 4; ++q) {
        f32x4a s4[4];
#pragma unroll
        for (int d = 0; d < 4; ++d) s4[d] = st[d * 4 + q];
#pragma unroll
        for (int j = 0; j < 4; ++j) { const int r = 4 * q + j;
          float e[4];
#pragma unroll
          for (int d = 0; d < 4; ++d) e[d] = s4[d][j] - lam * o[d][r];
          float ss = (e[0] * e[0] + e[1] * e[1]) + (e[2] * e[2] + e[3] * e[3]);
          ss = lane_xor_add<1>(ss); ss = lane_xor_add<2>(ss); ss = lane_xor_add<4>(ss); ss = lane_xor_add<8>(ss); ss = lane_xor_add<16>(ss);
          const float rs = __builtin_amdgcn_rsqf(ss * (1.0f / 128.0f) + 1e-5f);
          const int orow = crow(r, hi);
#pragma unroll
          for (int d = 0; d < 4; ++d) Ow[(long)orow * LD + d * 32] = (bf16_t)(cvtpk(e[d] * rs * g4[d], 0.f) & 0xffffu);
        }
      }
    }
  }
}
#undef AKSW
#undef ASBAR
}

namespace cg = cooperative_groups;
#define LAS __attribute__((address_space(3)))
typedef unsigned short bf16;
typedef unsigned v4u __attribute__((ext_vector_type(4)));
typedef float f32x4 __attribute__((ext_vector_type(4)));
typedef short bf16x8 __attribute__((ext_vector_type(8)));
constexpr int NWAVES = 8, NTHR = 512;
constexpr int BATCH = 32, SEQ = 2048, D = 1024, M = BATCH * SEQ, FF = 2816, FF2 = 2 * FF, NH = 8;
constexpr int MH = M / 2;
constexpr size_t MiB = 1u << 20;
constexpr size_t WS_WQKV = 0, WS_WO = 6 * MiB, WS_WIN = 8 * MiB, WS_WOUT = 14 * MiB, WS_WUP0 = 16 * MiB, WS_WUP1 = 27 * MiB, WS_WDN0 = 38 * MiB, WS_WDN1 = 44 * MiB;
constexpr size_t WS_COS = 64 * MiB, WS_SIN = 72 * MiB;
constexpr size_t WS_SSQ = 80 * MiB, SSQ_BYTES = 4 * MiB;
constexpr size_t WS_XB = 104 * MiB;
constexpr size_t WS_R = 232 * MiB;
constexpr size_t WS_Q = WS_R, WS_K = WS_R + 128 * MiB, WS_V = WS_R + 256 * MiB, WS_O = WS_R + 384 * MiB;
constexpr size_t WS_G = WS_R, WS_U = WS_R + 352 * MiB;
constexpr size_t WS_HU = WS_R + 352 * MiB, WS_HP = WS_HU + 16 * MiB;
constexpr size_t WS_STASH = 936 * MiB;
constexpr size_t WS_END = 1000 * MiB;
constexpr int LDS_BYTES = 147456;
static_assert(att::SHM_TOTAL <= 131072, "attention LDS");

__device__ __forceinline__ unsigned f2bf(float f) { unsigned u = __builtin_bit_cast(unsigned, f); return (u + 0x7fffu + ((u >> 16) & 1u)) >> 16; }
__device__ __forceinline__ unsigned pk2(float lo, float hi) { return f2bf(lo) | (f2bf(hi) << 16); }
__device__ __forceinline__ float bflo(unsigned w) { return __builtin_bit_cast(float, w << 16); }
__device__ __forceinline__ float bfhi(unsigned w) { return __builtin_bit_cast(float, w & 0xffff0000u); }
__device__ __forceinline__ float wave_sum(float v) {
    v = lane_xor_add<1>(v); v = lane_xor_add<2>(v); v = lane_xor_add<4>(v); v = lane_xor_add<8>(v); v = lane_xor_add<16>(v); v = lane_xor_add<32>(v);
    return v;
}
__device__ __forceinline__ int dest_row(int mode, int n) {
    if (mode == 1 && n < 2048) { const int d = n & 63, dd = d & 31; return (n & ~63) + 8 * (dd >> 2) + (dd & 3) + ((d >> 5) << 2); }
    if (mode == 2) { const int isval = n >= FF ? 1 : 0, ff = n - isval * FF, fl = ff & 127; return (ff >> 7) * 256 + 128 * ((fl >> 2) & 1) + 8 * (fl >> 3) + 4 * isval + (fl & 3); }
    return n;
}
__device__ __forceinline__ void transpose_item(const float* W, int K, int N, bf16* WT, const float* gk, int mode, LAS float* scr, int item, int lane) {
    const int nblk = N / 32, kb = item / nblk, nb = item % nblk, k0 = 64 * kb, n0 = 32 * nb;
#pragma unroll 8
    for (int i = 0; i < 32; ++i) { const int kk = 2 * i + (lane >> 5); const float g = gk ? gk[k0 + kk] : 1.f; scr[kk * 33 + (lane & 31)] = W[(size_t)(k0 + kk) * N + n0 + (lane & 31)] * g; }
    asm volatile("s_waitcnt lgkmcnt(0)" ::: "memory");
    const int c = lane & 7;
#pragma unroll
    for (int j = 0; j < 4; ++j) { const int n = (lane >> 3) + 8 * j; const LAS float* s = scr + (8 * c) * 33 + n;
        v4u o; o.x = pk2(s[0 * 33], s[1 * 33]); o.y = pk2(s[2 * 33], s[3 * 33]); o.z = pk2(s[4 * 33], s[5 * 33]); o.w = pk2(s[6 * 33], s[7 * 33]);
        *(v4u*)(WT + (size_t)dest_row(mode, n0 + n) * K + k0 + 8 * c) = o; }
    asm volatile("s_waitcnt lgkmcnt(0)" ::: "memory");
}
__device__ __forceinline__ void sincos_cw(float a, float& s, float& c) {
    const float kf = rintf(a * 0.63661977236758134f); const int k = (int)kf;
    float r = fmaf(kf, -1.5703125f, a); r = fmaf(kf, -4.837512969970703125e-4f, r); r = fmaf(kf, -7.54978995489188216e-8f, r);
    const float z = r * r;
    const float sp = fmaf(r * z, fmaf(z, fmaf(z, -1.9515295891e-4f, 8.3321608736e-3f), -1.6666654611e-1f), r);
    const float cp = fmaf(z * z, fmaf(z, fmaf(z, 2.443315711809948e-5f, -1.388731625493765e-3f), 4.166664568298827e-2f), fmaf(z, -0.5f, 1.0f));
    const float ss = (k & 1) ? cp : sp, cc = (k & 1) ? sp : cp;
    s = (k & 2) ? -ss : ss; c = ((k + 1) & 2) ? -cc : cc;
}

struct Args {
    const float* x; const int* pos;
    const float *attn_g, *w_qkv, *lq1, *lk1, *lq2, *lk2, *subg, *w_o, *conv_g, *w_in, *conv_w, *w_out, *ffn_g, *w_up, *ffn_cw, *ffn_cb, *w_dn, *fin_g;
    float* out; unsigned char* ws;
};

__device__ __forceinline__ void ffn_fix_rows(int pm, bf16* Gm, const float* HU, const float* HP, const float* cw, int tid) {
    for (int it = tid; it < 2 * 22 * 32; it += NTHR) {
        const int q = it & 31, pn = (it >> 5) % 22, which = it / (32 * 22);
        if (which == 0 ? ((pm & 7) == 0) : ((pm & 7) == 7)) continue;
        const int j0 = 128 * (q & 1) + 8 * (q >> 1), f0 = 128 * pn + 4 * q, nb = which == 0 ? pm - 1 : pm + 1;
        const size_t hb = ((size_t)pm * 2 + which) * FF2 + pn * 256 + j0, nbb = ((size_t)nb * 2 + (1 - which)) * FF2 + pn * 256 + j0;
        const f32x4 pg = *(const f32x4*)(HP + hb), pv = *(const f32x4*)(HP + hb + 4), ug = *(const f32x4*)(HU + nbb), uv = *(const f32x4*)(HU + nbb + 4);
        const int jw = which == 0 ? 0 : 2;
        const f32x4 wg = *(const f32x4*)(cw + (size_t)jw * FF2 + f0), wv = *(const f32x4*)(cw + (size_t)jw * FF2 + FF + f0);
        const f32x4 yg = pg + wg * ug, yv = pv + wv * uv;
        unsigned long long o = (unsigned long long)pk2(pg8::silu_f(yg[0]) * yv[0], pg8::silu_f(yg[1]) * yv[1]) | ((unsigned long long)pk2(pg8::silu_f(yg[2]) * yv[2], pg8::silu_f(yg[3]) * yv[3]) << 32);
        *(unsigned long long*)(Gm + ((size_t)pm * 256 + (which ? 255 : 0)) * FF + f0) = o;
    }
}
__device__ __forceinline__ void mixer_ew_phase(const bf16* R, bf16* Y, const float* cw, int gtid, int nthreads) {
    constexpr int TC = 32, NFC = D / 8, NITEM = (M / TC) * NFC;
    for (int it = gtid; it < NITEM; it += nthreads) {
        const int fc = it % NFC, tc = it / NFC, t0 = tc * TC, f0 = fc * 8;
        float w[3][8];
#pragma unroll
        for (int j = 0; j < 3; ++j)
#pragma unroll
            for (int h = 0; h < 2; ++h) { const f32x4 a = *(const f32x4*)(cw + (size_t)j * D + f0 + 4 * h);
#pragma unroll
                for (int e = 0; e < 4; ++e) w[j][4 * h + e] = a[e]; }
        const bf16* rp = R + (size_t)t0 * (3 * D) + f0;
        float p[8], c[8], n[8];
#define MIX_CU(dst, ptr) do { const v4u c_ = *(const v4u*)((ptr) + D), u_ = *(const v4u*)((ptr) + 2 * D); \
        _Pragma("unroll") for (int q = 0; q < 4; ++q) { dst[2 * q] = bflo(c_[q]) * bflo(u_[q]); dst[2 * q + 1] = bfhi(c_[q]) * bfhi(u_[q]); } } while (0)
        if (t0 % SEQ == 0) {
#pragma unroll
            for (int e = 0; e < 8; ++e) p[e] = 0.f;
        } else MIX_CU(p, rp - 3 * D);
        MIX_CU(c, rp);
#pragma unroll 4
        for (int i = 0; i < TC; ++i) {
            if (i == TC - 1 && (t0 + TC) % SEQ == 0) {
#pragma unroll
                for (int e = 0; e < 8; ++e) n[e] = 0.f;
            } else MIX_CU(n, rp + (size_t)(i + 1) * (3 * D));
            const v4u b_ = *(const v4u*)(rp + (size_t)i * (3 * D));
            v4u o;
#pragma unroll
            for (int q = 0; q < 4; ++q) {
                const float y0 = bflo(b_[q]) * fmaf(w[0][2 * q], p[2 * q], fmaf(w[1][2 * q], c[2 * q], w[2][2 * q] * n[2 * q]));
                const float y1 = bfhi(b_[q]) * fmaf(w[0][2 * q + 1], p[2 * q + 1], fmaf(w[1][2 * q + 1], c[2 * q + 1], w[2][2 * q + 1] * n[2 * q + 1]));
                o[q] = pk2(y0, y1);
            }
            *(v4u*)(Y + (size_t)(t0 + i) * D + f0) = o;
#pragma unroll
            for (int e = 0; e < 8; ++e) { p[e] = c[e]; c[e] = n[e]; }
        }
#undef MIX_CU
    }
}

#ifndef PROBE_ATTN
#define PROBE_ATTN 1
#endif
#ifndef PROBE_EW
#define PROBE_EW 1
#endif
#ifndef PROBE_QKV
#define PROBE_QKV 1
#endif
__device__ __forceinline__ int opaque_bx() { int b = blockIdx.x; asm volatile("" : "+s"(b)); return b; }
typedef const __attribute__((address_space(4))) Args* CArgs;
__device__ __forceinline__ CArgs get_args() { CArgs p = (CArgs)__builtin_amdgcn_kernarg_segment_ptr(); asm volatile("" : "+s"(p)); return p; }
#define WSP(off) (a->ws + (off))
#define WUP_T(l) ((bf16*)WSP(WS_WUP0 + (size_t)(l) * (WS_WUP1 - WS_WUP0)))
#define WDN_T(l) ((bf16*)WSP(WS_WDN0 + (size_t)(l) * (WS_WDN1 - WS_WDN0)))
#define SSQ(i) ((float*)WSP(WS_SSQ + (size_t)(i) * SSQ_BYTES))
#define GEO() int tid = threadIdx.x; asm volatile("" : "+v"(tid)); const int lane = tid & 63, wave = __builtin_amdgcn_readfirstlane(tid >> 6); const int G = gridDim.x, bx = blockIdx.x; \
    const int vcu = (G % 8 == 0) ? (bx % 8) * (G / 8) + bx / 8 : bx; const int gw = vcu * NWAVES + wave, NGW = G * NWAVES, gtid = bx * NTHR + tid, NT = G * NTHR; \
    (void)lane; (void)gw; (void)NGW; (void)gtid; (void)NT; (void)vcu

__global__ void __launch_bounds__(NTHR, 2) mega_fwd(Args a_unused) {
    extern __shared__ __attribute__((aligned(16))) unsigned char lds[];
    cg::grid_group grid = cg::this_grid();
    LAS unsigned char* ldsl = (LAS unsigned char*)lds;

    {
        CArgs a = get_args(); GEO();
        bf16* Wqkv_t = (bf16*)WSP(WS_WQKV); bf16* Wo_t = (bf16*)WSP(WS_WO); bf16* Win_t = (bf16*)WSP(WS_WIN); bf16* Wout_t = (bf16*)WSP(WS_WOUT);
        float* tcos = (float*)WSP(WS_COS); float* tsin = (float*)WSP(WS_SIN); bf16* XB = (bf16*)WSP(WS_XB);
        LAS float* scr = (LAS float*)(ldsl + wave * 16384);
        constexpr int I_QKV = (D / 64) * (3 * D / 32), I_O = (D / 64) * (D / 32), I_UP = (D / 64) * (FF2 / 32), I_DN = (FF / 64) * (D / 32);
        constexpr int NITEMS = 2 * I_QKV + 2 * I_O + 2 * I_UP + 2 * I_DN;
        for (int it = gw; it < NITEMS; it += NGW) {
            int r = it;
            if (r < I_QKV) { transpose_item(a->w_qkv, D, 3 * D, Wqkv_t, a->attn_g, 1, scr, r, lane); continue; } r -= I_QKV;
            if (r < I_QKV) { transpose_item(a->w_in, D, 3 * D, Win_t, a->conv_g, 0, scr, r, lane); continue; } r -= I_QKV;
            if (r < I_O) { transpose_item(a->w_o, D, D, Wo_t, nullptr, 0, scr, r, lane); continue; } r -= I_O;
            if (r < I_O) { transpose_item(a->w_out, D, D, Wout_t, nullptr, 0, scr, r, lane); continue; } r -= I_O;
            if (r < I_UP) { transpose_item(a->w_up, D, FF2, WUP_T(0), a->ffn_g, 2, scr, r, lane); continue; } r -= I_UP;
            if (r < I_UP) { transpose_item(a->w_up + (size_t)D * FF2, D, FF2, WUP_T(1), a->ffn_g + D, 2, scr, r, lane); continue; } r -= I_UP;
            if (r < I_DN) { transpose_item(a->w_dn, FF, D, WDN_T(0), nullptr, 0, scr, r, lane); continue; } r -= I_DN;
            transpose_item(a->w_dn + (size_t)FF * D, FF, D, WDN_T(1), nullptr, 0, scr, r, lane);
        }
        const int* pos = a->pos;
        for (int i = gtid; i < M * 32; i += NT) {
            const int d = i & 31; const float inv = __builtin_amdgcn_exp2f(-(float)d * (13.287712379549449f / 32.0f));
            float s, c; sincos_cw((float)pos[i >> 5] * inv, s, c); tcos[i] = c; tsin[i] = s;
        }
        const float* x = a->x; float* ssq0 = SSQ(0);
        for (int m = gw; m < M; m += NGW) {
            const f32x4* xr = (const f32x4*)(x + (size_t)m * D) + lane; float s = 0.f;
            unsigned long long* o8 = (unsigned long long*)(XB + (size_t)m * D) + lane;
#pragma unroll
            for (int j = 0; j < 4; ++j) { const f32x4 v = xr[64 * j]; s += (v.x * v.x + v.y * v.y) + (v.z * v.z + v.w * v.w);
                o8[64 * j] = (unsigned long long)pk2(v.x, v.y) | ((unsigned long long)pk2(v.z, v.w) << 32); }
            s = wave_sum(s);
            if (lane < 16) ssq0[(size_t)m * 16 + lane] = lane == 0 ? s : 0.f;
        }
    }
    grid.sync();

    {
        CArgs a = get_args();
        pg8::Gemm g{(bf16*)WSP(WS_XB), (bf16*)WSP(WS_WQKV), M, 3 * D, D}; pg8::StaticOrder S; S.init(M, 3 * D, gridDim.x, opaque_bx());
        pg8::EpiRope E{(bf16*)WSP(WS_Q), (bf16*)WSP(WS_K), (bf16*)WSP(WS_V), SSQ(0), (float*)WSP(WS_COS), (float*)WSP(WS_SIN), 0.125f * 1.4426950408889634f};
        for (int rep = 0; rep < PROBE_QKV; ++rep) pg8::gemm_phase<pg8::EpiRope, pg8::StaticOrder, true, true>(ldsl, g, S, E);
#ifdef PROBE_KLOOP
        { pg8::EpiNull EN{(float*)WSP(WS_STASH)}; pg8::gemm_phase<pg8::EpiNull, pg8::StaticOrder, true, true>(ldsl, g, S, EN); }
#endif
    }
    grid.sync();
    {
        CArgs a = get_args(); GEO();
        const float lambda_init = 0.8f - 0.6f * 1.0f;
        const float s1 = wave_sum(a->lq1[lane] * a->lk1[lane]), s2 = wave_sum(a->lq2[lane] * a->lk2[lane]);
        const float lam = __expf(s1) - __expf(s2) + lambda_init;
        const bf16* Qb = (const bf16*)WSP(WS_Q); const bf16* Kb = (const bf16*)WSP(WS_K); const bf16* Vb = (const bf16*)WSP(WS_V); bf16* Ob = (bf16*)WSP(WS_O);
        float* stash = (float*)WSP(WS_STASH); const float* subg = a->subg;
#pragma unroll 1
        for (int rep = 0; rep < PROBE_ATTN; ++rep)
#pragma unroll 1
        for (int i = 0;; ++i) {
            const int id = i * G + vcu; if (id >= BATCH * NH * (SEQ / 256)) break;
            const int bh = id >> 3, qb = id & 7;
            att::attn_unit(bh >> 3, bh & 7, qb, Qb, Kb, Vb, Ob, stash, lam, subg, 1.0f - lambda_init, (char*)lds);
        }
    }
    grid.sync();
    {
        CArgs a = get_args();
        pg8::Gemm g{(bf16*)WSP(WS_O), (bf16*)WSP(WS_WO), M, D, D}; pg8::StaticOrder S; S.init(M, D, gridDim.x, opaque_bx());
        pg8::EpiRes<true> E{a->x, (bf16*)WSP(WS_XB), SSQ(1)};
        pg8::gemm_phase<pg8::EpiRes<true>, pg8::StaticOrder, true, true>(ldsl, g, S, E);
    }
    grid.sync();
#pragma unroll 1
    for (int layer = 0; layer < 2; ++layer) {
        if (layer == 1) {
            {   CArgs a = get_args();
                pg8::Gemm g{(bf16*)WSP(WS_XB), (bf16*)WSP(WS_WIN), M, 3 * D, D}; pg8::StaticOrder S; S.init(M, 3 * D, gridDim.x, opaque_bx());
                pg8::EpiScale E{(bf16*)WSP(WS_Q), 3 * D, SSQ(2), 0};
                pg8::gemm_phase<pg8::EpiScale, pg8::StaticOrder, true, true>(ldsl, g, S, E); }
            grid.sync();
            {   CArgs a = get_args(); GEO();
                mixer_ew_phase((const bf16*)WSP(WS_Q), (bf16*)WSP(WS_O), a->conv_w, gtid, NT); }
            grid.sync();
            {   CArgs a = get_args();
                pg8::Gemm g{(bf16*)WSP(WS_O), (bf16*)WSP(WS_WOUT), M, D, D}; pg8::StaticOrder S; S.init(M, D, gridDim.x, opaque_bx());
                pg8::EpiRes<false> E{nullptr, (bf16*)WSP(WS_XB), SSQ(3)};
                pg8::gemm_phase<pg8::EpiRes<false>, pg8::StaticOrder, true, true>(ldsl, g, S, E); }
            grid.sync();
        }
        {   CArgs a = get_args();
            pg8::Gemm g{(bf16*)WSP(WS_XB), WUP_T(layer), M, FF2, D}; pg8::StaticOrder S; S.init(M, FF2, gridDim.x, opaque_bx());
            pg8::EpiFfn E{(bf16*)WSP(WS_G), SSQ(layer == 0 ? 1 : 3), a->ffn_cw + (size_t)layer * 3 * FF2, a->ffn_cb + (size_t)layer * FF2, (float*)WSP(WS_HU), (float*)WSP(WS_HP), ldsl + 131072};
            pg8::gemm_phase<pg8::EpiFfn, pg8::StaticOrder, true, true>(ldsl, g, S, E); }
        grid.sync();
        {   CArgs a = get_args();
            pg8::Gemm g{(bf16*)WSP(WS_G), WDN_T(layer), M, D, FF}; pg8::StaticOrder S; S.init(M, D, gridDim.x, opaque_bx());
            {   int tid = threadIdx.x; asm volatile("" : "+v"(tid));
                const float* cwl = a->ffn_cw + (size_t)layer * 3 * FF2;
#pragma unroll 1
                for (int i = 0;; ++i) { pg8::Unit u; if (!S.next(i, u)) break; ffn_fix_rows(u.pm, (bf16*)WSP(WS_G), (const float*)WSP(WS_HU), (const float*)WSP(WS_HP), cwl, tid); }
                __threadfence(); __syncthreads(); }
            pg8::EpiRes<false> E{nullptr, (bf16*)WSP(WS_XB), SSQ(layer == 0 ? 2 : 4)};
            pg8::gemm_phase<pg8::EpiRes<false>, pg8::StaticOrder, true, true>(ldsl, g, S, E); }
        grid.sync();
    }
    {   CArgs a = get_args(); GEO();
        float* out = a->out; const float* fg = a->fin_g; const float* ssq4 = SSQ(4); const bf16* XB = (const bf16*)WSP(WS_XB);
        for (int m = gw; m < M; m += NGW) {
            const float rs = pg8::row_rstd(ssq4, m);
            const v4u* xr = (const v4u*)(XB + (size_t)m * D) + lane; f32x4* orow = (f32x4*)(out + (size_t)m * D) + 2 * lane; const f32x4* gr = (const f32x4*)fg + 2 * lane;
#pragma unroll
            for (int j = 0; j < 2; ++j) { const v4u w = xr[64 * j]; const f32x4 g0 = gr[128 * j], g1 = gr[128 * j + 1];
                orow[128 * j] = (f32x4){bflo(w.x), bfhi(w.x), bflo(w.y), bfhi(w.y)} * rs * g0; orow[128 * j + 1] = (f32x4){bflo(w.z), bfhi(w.z), bflo(w.w), bfhi(w.w)} * rs * g1; }
        }
    }
}

extern "C" void kernel_launch(void* const* d_in, const int* in_sizes, int n_in, void* d_out, int out_size, void* d_ws, size_t ws_size, hipStream_t stream) {
    static int grid = 0;
    if (grid == 0) {
        if (n_in != 20 || in_sizes[0] != M * D || out_size != M * D || ws_size < WS_END) { fprintf(stderr, "kernel_launch: shape mismatch n_in %d in0 %d out %d ws %zu\n", n_in, n_in > 0 ? in_sizes[0] : -1, out_size, ws_size); grid = -1; return; }
        int dev = 0, cus = 0, per_cu = 0;
        if (hipGetDevice(&dev) != hipSuccess || hipDeviceGetAttribute(&cus, hipDeviceAttributeMultiprocessorCount, dev) != hipSuccess) { grid = -1; return; }
        if (hipFuncSetAttribute((const void*)mega_fwd, hipFuncAttributeMaxDynamicSharedMemorySize, LDS_BYTES) != hipSuccess) { fprintf(stderr, "kernel_launch: hipFuncSetAttribute failed\n"); grid = -1; return; }
        if (hipOccupancyMaxActiveBlocksPerMultiprocessor(&per_cu, (const void*)mega_fwd, NTHR, LDS_BYTES) != hipSuccess || per_cu < 1) { fprintf(stderr, "kernel_launch: occupancy query says %d\n", per_cu); per_cu = 1; }
        (void)hipGetLastError();
        grid = cus;
    }
    if (grid < 0) return;
    Args a{};
    a.x = (const float*)d_in[0]; a.pos = (const int*)d_in[1];
    a.attn_g = (const float*)d_in[2]; a.w_qkv = (const float*)d_in[3]; a.lq1 = (const float*)d_in[4]; a.lk1 = (const float*)d_in[5]; a.lq2 = (const float*)d_in[6]; a.lk2 = (const float*)d_in[7];
    a.subg = (const float*)d_in[8]; a.w_o = (const float*)d_in[9]; a.conv_g = (const float*)d_in[10]; a.w_in = (const float*)d_in[11]; a.conv_w = (const float*)d_in[12]; a.w_out = (const float*)d_in[13];
    a.ffn_g = (const float*)d_in[14]; a.w_up = (const float*)d_in[15]; a.ffn_cw = (const float*)d_in[16]; a.ffn_cb = (const float*)d_in[17]; a.w_dn = (const float*)d_in[18]; a.fin_g = (const float*)d_in[19];
    a.out = (float*)d_out; a.ws = (unsigned char*)d_ws;
    void* args[] = {&a};
    const hipError_t e = hipLaunchCooperativeKernel((const void*)mega_fwd, dim3(grid), dim3(NTHR), args, LDS_BYTES, stream);
    if (e != hipSuccess) fprintf(stderr, "kernel_launch: cooperative launch failed: %s (grid %d)\n", hipGetErrorString(e), grid);
}
```

```cpp
#include <hip/hip_runtime.h>
#include <hip/hip_cooperative_groups.h>
#include <cstdio>
#include <cstdint>

template <int MASK> __device__ __forceinline__ float lane_xor_add(float x) {
    if constexpr (MASK == 32) {
        int l = (int)__builtin_amdgcn_mbcnt_hi(~0u, __builtin_amdgcn_mbcnt_lo(~0u, 0u)); asm volatile("" : "+v"(l));
        return x + __builtin_bit_cast(float, __builtin_amdgcn_ds_bpermute((l ^ 32) << 2, __builtin_bit_cast(int, x))); }
    else return x + __builtin_bit_cast(float, __builtin_amdgcn_ds_swizzle(__builtin_bit_cast(int, x), (MASK << 10) | 0x1F));
}
#ifndef DPP_PREV
#define DPP_PREV 0x121
#define DPP_NEXT 0x12F
#endif
#ifndef USE_NT
#define USE_NT 0
#endif
#if USE_NT
#define NT_STORE(v, p) __builtin_nontemporal_store((v), (p))
#else
#define NT_STORE(v, p) (*(p) = (v))
#endif
#ifndef QKV_LD
#define QKV_LD 1088
#endif
__device__ __forceinline__ size_t tiled(int row, int col, int nct) { return (((size_t)(row >> 4) * nct + (col >> 5)) << 9) + ((row & 15) << 5) + (col & 31); }
namespace pg8 {
#define PG8_LAS __attribute__((address_space(3)))
typedef unsigned short bf16_t;
typedef short bf16x8 __attribute__((ext_vector_type(8)));
typedef float f32x4 __attribute__((ext_vector_type(4)));
typedef unsigned u32x4 __attribute__((ext_vector_type(4)));
constexpr int BM = 256, BK = 64, HALF = 128, HTB = HALF * BK * 2  , STAGE_BYTES = 8 * HTB, NXCD = 8, WGM = 8;

__host__ __device__ __forceinline__ int lds_byte(int r, int c) { const int st = (r >> 4) * 2 + (c >> 5), rr = r & 15, cc = c & 31, ob = rr * 64 + cc * 2; return st * 1024 + (ob ^ (((ob >> 9) & 1) << 5)); }
__host__ __device__ __forceinline__ void stage_rc(int b, int& R, int& C) { const int st = b / 1024, sb = b % 1024, swz = sb ^ (((sb >> 9) & 1) << 5); R = (st >> 1) * 16 + swz / 64; C = (st & 1) * 32 + (swz % 64) / 2; }
__host__ __device__ __forceinline__ int perm32(int rho) { const int n = rho >> 4, i = rho & 15; return 8 * (i >> 2) + 4 * n + (i & 3); }

struct Unit { int pm, pn; };
struct Gemm { const bf16_t* A; const bf16_t* Bt; int M, N, K; };

struct StaticOrder {
    int nM, nN, nwg, G, c;
    __host__ __device__ void init(int M, int N, int G_, int c_) { nM = M / BM; nN = N / BM; nwg = nM * nN; G = G_; c = c_; }
    __host__ __device__ bool next(int i, Unit& u) const {
        const long L = (long)i * G + c; if (L >= nwg) return false;
        int wgid = (int)L; { const int q = nwg / NXCD, r = nwg % NXCD, xcd = wgid % NXCD, off = wgid / NXCD; wgid = (xcd < r ? xcd * (q + 1) : r * (q + 1) + (xcd - r) * q) + off; }
        const int nig = WGM * nN, gid = wgid / nig, fm = gid * WGM, gsz = (nM - fm) < WGM ? (nM - fm) : WGM;
        u.pm = fm + ((wgid % nig) % gsz); u.pn = (wgid % nig) / gsz; return true;
    }
    __device__ __forceinline__ void a_ready(const Unit&) const {}
    __device__ __forceinline__ void done(const Unit&) const {}
};

__device__ __forceinline__ unsigned cvt_pk_bf16(float lo, float hi) { unsigned r; asm volatile("v_cvt_pk_bf16_f32 %0, %1, %2" : "=v"(r) : "v"(lo), "v"(hi)); return r; }
typedef float f32x2 __attribute__((ext_vector_type(2)));

__device__ __forceinline__ float row_rstd(const float* ssq, int row) {
    const f32x4* p = (const f32x4*)(ssq + (size_t)row * 16);
    const f32x4 a = p[0], b = p[1], c = p[2], d = p[3];
    const float s = (((a[0] + a[1]) + (a[2] + a[3])) + ((b[0] + b[1]) + (b[2] + b[3]))) + (((c[0] + c[1]) + (c[2] + c[3])) + ((d[0] + d[1]) + (d[2] + d[3])));
    return __builtin_amdgcn_rsqf(s * (1.0f / 1024.0f) + 1e-5f);
}
__device__ __forceinline__ void rows_rstd(const float* ssq, int row0, int fq, float (&rs)[2][4]) {
    f32x4 p[2][4];
#pragma unroll
    for (int ai = 0; ai < 2; ++ai)
#pragma unroll
        for (int m = 0; m < 4; ++m) p[ai][m] = *(const f32x4*)(ssq + (size_t)(row0 + ai * HALF + m * 16) * 16 + 4 * fq);
#pragma unroll
    for (int ai = 0; ai < 2; ++ai)
#pragma unroll
        for (int m = 0; m < 4; ++m) { float s = (p[ai][m][0] + p[ai][m][1]) + (p[ai][m][2] + p[ai][m][3]); s = lane_xor_add<16>(s); s = lane_xor_add<32>(s);
            rs[ai][m] = __builtin_amdgcn_rsqf(s * (1.0f / 1024.0f) + 1e-5f); }
}
struct EpiRope {
    static constexpr bool PERM = true, AFTER_DRAIN = false;
    bf16_t* Q; bf16_t* K; bf16_t* V; const float* ssq; const float* tcos; const float* tsin; float qscale;
    __device__ __forceinline__ void operator()(const f32x4 (&acc)[2][2][4][2], const Unit& u, int wr, int wc, int fr, int fq) const {
        const int t = u.pn >> 2;
        const int colt = (u.pn & 3) * BM + wc * 32 + 8 * fq;
        const int row0 = u.pm * BM + wr * 64 + fr;
        const int fi = 4 * ((wc & 1) * 4 + fq);
        float rs[2][4]; rows_rstd(ssq, row0, fq, rs);
        if (t < 2) {
            bf16_t* base = (t == 0) ? Q : K; const float sc = (t == 0) ? qscale : 1.f;
#pragma unroll
            for (int ai = 0; ai < 2; ++ai) {
                f32x4 c4[4], s4[4];
#pragma unroll
                for (int m = 0; m < 4; ++m) { const int row = row0 + ai * HALF + m * 16; c4[m] = *(const f32x4*)(tcos + (size_t)row * 32 + fi); s4[m] = *(const f32x4*)(tsin + (size_t)row * 32 + fi); }
#pragma unroll
                for (int m = 0; m < 4; ++m) {
                    const int row = row0 + ai * HALF + m * 16;
                    const float k = rs[ai][m] * sc;
                    bf16_t* rowp = base + ((size_t)(row >> 4) * 32 + (colt >> 5)) * 512 + (row & 15) * 32 + (colt & 31);
#pragma unroll
                    for (int bj = 0; bj < 2; ++bj) {
                        const f32x4 x1 = acc[ai][bj][m][0] * k, x2 = acc[ai][bj][m][1] * k;
                        const f32x4 y1 = x1 * c4[m] - x2 * s4[m], y2 = x2 * c4[m] + x1 * s4[m];
                        u32x4 w; w.x = cvt_pk_bf16(y1[0], y1[1]); w.y = cvt_pk_bf16(y1[2], y1[3]); w.z = cvt_pk_bf16(y2[0], y2[1]); w.w = cvt_pk_bf16(y2[2], y2[3]);
                        NT_STORE(w, (u32x4*)(rowp + bj * 2048));
                    }
                }
                __builtin_amdgcn_sched_barrier(0);
            }
        } else {
#pragma unroll
            for (int ai = 0; ai < 2; ++ai)
#pragma unroll
                for (int m = 0; m < 4; ++m) {
                    const int row = row0 + ai * HALF + m * 16;
                    const float k = rs[ai][m];
                    bf16_t* rowp = V + ((size_t)(row >> 4) * 32 + (colt >> 5)) * 512 + (row & 15) * 32 + (colt & 31);
#pragma unroll
                    for (int bj = 0; bj < 2; ++bj) {
                        const f32x4 v0 = acc[ai][bj][m][0] * k, v1 = acc[ai][bj][m][1] * k;
                        u32x4 w; w.x = cvt_pk_bf16(v0[0], v0[1]); w.y = cvt_pk_bf16(v0[2], v0[3]); w.z = cvt_pk_bf16(v1[0], v1[1]); w.w = cvt_pk_bf16(v1[2], v1[3]);
                        NT_STORE(w, (u32x4*)(rowp + bj * 2048));
                    }
                }
        }
    }
};
struct EpiScale {
    static constexpr bool PERM = true, AFTER_DRAIN = false;
    bf16_t* O; int ldc; const float* ssq; int row_off;
    __device__ __forceinline__ void operator()(const f32x4 (&acc)[2][2][4][2], const Unit& u, int wr, int wc, int fr, int fq) const {
        const int row0 = u.pm * BM + wr * 64 + fr, col0 = u.pn * BM + wc * 32 + 8 * fq;
        float rs[2][4]; rows_rstd(ssq, row_off + row0, fq, rs);
#pragma unroll
        for (int ai = 0; ai < 2; ++ai)
#pragma unroll
            for (int m = 0; m < 4; ++m) {
                const int row = row0 + ai * HALF + m * 16;
                const float k = rs[ai][m];
                bf16_t* rowp = O + tiled(row, col0, ldc >> 5);
#pragma unroll
                for (int bj = 0; bj < 2; ++bj) {
                    const f32x4 v0 = acc[ai][bj][m][0] * k, v1 = acc[ai][bj][m][1] * k;
                    u32x4 w; w.x = cvt_pk_bf16(v0[0], v0[1]); w.y = cvt_pk_bf16(v0[2], v0[3]); w.z = cvt_pk_bf16(v1[0], v1[1]); w.w = cvt_pk_bf16(v1[2], v1[3]);
                    NT_STORE(w, (u32x4*)(rowp + bj * 2048));
                }
            }
    }
};
struct EpiMix {
    static constexpr bool PERM = true, AFTER_DRAIN = false;
    bf16_t* CU; bf16_t* Bq; const float* ssq;
    __device__ __forceinline__ void operator()(const f32x4 (&acc)[2][2][4][2], const Unit& u, int wr, int wc, int fr, int fq) const {
        typedef unsigned u32x2m __attribute__((ext_vector_type(2)));
        const int row0 = u.pm * BM + wr * 64 + fr;
        float rs[2][4]; rows_rstd(ssq, row0, fq, rs);
        if (u.pn < 8) {
            const int f0 = u.pn * 128 + wc * 32 + 8 * fq;
#pragma unroll
            for (int ai = 0; ai < 2; ++ai)
#pragma unroll
                for (int m = 0; m < 4; ++m) { const int row = row0 + ai * HALF + m * 16; const float r2 = rs[ai][m] * rs[ai][m];
                    const f32x4 p0 = acc[ai][0][m][0] * acc[ai][0][m][1] * r2, p1 = acc[ai][1][m][0] * acc[ai][1][m][1] * r2;
                    u32x4 w; w.x = cvt_pk_bf16(p0[0], p0[1]); w.y = cvt_pk_bf16(p0[2], p0[3]); w.z = cvt_pk_bf16(p1[0], p1[1]); w.w = cvt_pk_bf16(p1[2], p1[3]);
                    *(u32x4*)(CU + tiled(row, f0, 32)) = w; }
        } else {
            const int col0 = (u.pn - 8) * BM + wc * 32 + 8 * fq;
#pragma unroll
            for (int ai = 0; ai < 2; ++ai)
#pragma unroll
                for (int m = 0; m < 4; ++m) { const int row = row0 + ai * HALF + m * 16; const float k = rs[ai][m]; bf16_t* rowp = Bq + tiled(row, col0, 32);
#pragma unroll
                    for (int bj = 0; bj < 2; ++bj) { const f32x4 v0 = acc[ai][bj][m][0] * k, v1 = acc[ai][bj][m][1] * k;
                        u32x4 w; w.x = cvt_pk_bf16(v0[0], v0[1]); w.y = cvt_pk_bf16(v0[2], v0[3]); w.z = cvt_pk_bf16(v1[0], v1[1]); w.w = cvt_pk_bf16(v1[2], v1[3]);
                        *(u32x4*)(rowp + bj * 2048) = w; } }
        }
    }
};
template <bool BASE_F32> struct EpiRes {
    static constexpr bool PERM = true, AFTER_DRAIN = false;
    const float* basef; bf16_t* xb; float* ssq_out;
    __device__ __forceinline__ void operator()(const f32x4 (&acc)[2][2][4][2], const Unit& u, int wr, int wc, int fr, int fq) const {
        const int row0 = u.pm * BM + wr * 64 + fr, col0 = u.pn * BM + wc * 32 + 8 * fq;
#pragma unroll
        for (int ai = 0; ai < 2; ++ai) {
            f32x4 bf[BASE_F32 ? 4 : 1][2][2]; u32x4 bb[BASE_F32 ? 1 : 4][2];
#pragma unroll
            for (int m = 0; m < 4; ++m) { const size_t off = (size_t)(row0 + ai * HALF + m * 16) * 1024 + col0, toff = tiled(row0 + ai * HALF + m * 16, col0, 32);
#pragma unroll
                for (int bj = 0; bj < 2; ++bj) {
                    if constexpr (BASE_F32) { bf[m][bj][0] = *(const f32x4*)(basef + off + bj * HALF); bf[m][bj][1] = *(const f32x4*)(basef + off + bj * HALF + 4); }
                    else bb[m][bj] = *(const u32x4*)(xb + toff + bj * 2048); } }
#pragma unroll
            for (int m = 0; m < 4; ++m) {
                const int row = row0 + ai * HALF + m * 16; const size_t toff = tiled(row, col0, 32); float ss = 0.f;
#pragma unroll
                for (int bj = 0; bj < 2; ++bj) {
                    f32x4 b0, b1;
                    if constexpr (BASE_F32) { b0 = bf[m][bj][0]; b1 = bf[m][bj][1]; }
                    else { const u32x4 w = bb[m][bj];
                        b0 = (f32x4){__builtin_bit_cast(float, w.x << 16), __builtin_bit_cast(float, w.x & 0xffff0000u), __builtin_bit_cast(float, w.y << 16), __builtin_bit_cast(float, w.y & 0xffff0000u)};
                        b1 = (f32x4){__builtin_bit_cast(float, w.z << 16), __builtin_bit_cast(float, w.z & 0xffff0000u), __builtin_bit_cast(float, w.w << 16), __builtin_bit_cast(float, w.w & 0xffff0000u)}; }
                    const f32x4 o0 = b0 + acc[ai][bj][m][0], o1 = b1 + acc[ai][bj][m][1];
                    ss += ((o0[0] * o0[0] + o0[1] * o0[1]) + (o0[2] * o0[2] + o0[3] * o0[3])) + ((o1[0] * o1[0] + o1[1] * o1[1]) + (o1[2] * o1[2] + o1[3] * o1[3]));
                    u32x4 w; w.x = cvt_pk_bf16(o0[0], o0[1]); w.y = cvt_pk_bf16(o0[2], o0[3]); w.z = cvt_pk_bf16(o1[0], o1[1]); w.w = cvt_pk_bf16(o1[2], o1[3]);
                    NT_STORE(w, (u32x4*)(xb + toff + bj * 2048));
                }
                ss = lane_xor_add<16>(ss); ss = lane_xor_add<32>(ss);
                if (fq == 0) ssq_out[(size_t)row * 16 + u.pn * 4 + wc] = ss;
            }
        }
    }
};
__device__ __forceinline__ float dpp_ror1_f(float x) { return __builtin_bit_cast(float, __builtin_amdgcn_update_dpp(0, __builtin_bit_cast(int, x), DPP_PREV, 0xF, 0xF, true)); }
__device__ __forceinline__ float dpp_ror15_f(float x) { return __builtin_bit_cast(float, __builtin_amdgcn_update_dpp(0, __builtin_bit_cast(int, x), DPP_NEXT, 0xF, 0xF, true)); }
__device__ __forceinline__ f32x4 dpp_ror1(f32x4 v) { f32x4 r; r.x = dpp_ror1_f(v.x); r.y = dpp_ror1_f(v.y); r.z = dpp_ror1_f(v.z); r.w = dpp_ror1_f(v.w); return r; }
__device__ __forceinline__ f32x4 dpp_ror15(f32x4 v) { f32x4 r; r.x = dpp_ror15_f(v.x); r.y = dpp_ror15_f(v.y); r.z = dpp_ror15_f(v.z); r.w = dpp_ror15_f(v.w); return r; }
__device__ __forceinline__ f32x4 sel4(bool c, f32x4 a, f32x4 b) { return (f32x4){c ? a[0] : b[0], c ? a[1] : b[1], c ? a[2] : b[2], c ? a[3] : b[3]}; }
__device__ __forceinline__ float silu_f(float g) { return g * __builtin_amdgcn_rcpf(1.f + __builtin_amdgcn_exp2f(-1.4426950408889634f * g)); }
struct EpiFfn {
    static constexpr bool PERM = true, AFTER_DRAIN = false;
    bf16_t* G; const float* ssq; const float* cw; const float* cb; float* HU; float* HP; PG8_LAS unsigned char* ex;
    __device__ __forceinline__ void operator()(f32x4 (&acc)[2][2][4][2], const Unit& u, int wr, int wc, int fr_in, int fq_in) const {
        typedef unsigned u32x2e __attribute__((ext_vector_type(2)));
        int t_ = threadIdx.x; asm volatile("" : "+v"(t_)); const int fr = t_ & 15, fq = (t_ >> 4) & 3; (void)fr_in; (void)fq_in;
        constexpr int FFc = 2816, FF2c = 5632;
        const int row0 = u.pm * BM + wr * 64 + fr;
        const bool is_first = (fr == 0), is_last = (fr == 15);
        PG8_LAS float* RS = (PG8_LAS float*)(ex + 8192); PG8_LAS float* CWL = (PG8_LAS float*)(ex + 8192 + 1024);
        {
            const int t = t_ & 511;
            if (t < 256) {
                const f32x4* p = (const f32x4*)(ssq + (size_t)(u.pm * BM + t) * 16);
                const f32x4 a = p[0], b = p[1], c = p[2], d = p[3];
                const float s = (((a[0] + a[1]) + (a[2] + a[3])) + ((b[0] + b[1]) + (b[2] + b[3]))) + (((c[0] + c[1]) + (c[2] + c[3])) + ((d[0] + d[1]) + (d[2] + d[3])));
                RS[t] = __builtin_amdgcn_rsqf(s * (1.0f / 1024.0f) + 1e-5f);
            } else {
                const int q = t - 256, p = q >> 6, jq = q & 63, n = jq & 1, wq = (jq >> 1) & 15, bjj = jq >> 5;
                const float* src = (p < 3) ? (cw + (size_t)p * FF2c) : cb;
                *(PG8_LAS f32x4*)(CWL + p * 256 + 4 * jq) = *(const f32x4*)(src + n * FFc + u.pn * 128 + 8 * wq + 4 * bjj);
            }
        }
        asm volatile("s_waitcnt lgkmcnt(0)" ::: "memory"); __builtin_amdgcn_s_barrier(); asm volatile("" ::: "memory");
#pragma unroll
        for (int ai = 0; ai < 2; ++ai)
#pragma unroll
            for (int m = 0; m < 4; ++m) { const float r = RS[wr * 64 + fr + ai * HALF + m * 16];
#pragma unroll
                for (int bj = 0; bj < 2; ++bj)
#pragma unroll
                    for (int n = 0; n < 2; ++n) acc[ai][bj][m][n] = acc[ai][bj][m][n] * r; }
        PG8_LAS float* EX = (PG8_LAS float*)ex;
        const int cj = wc * 32 + 8 * fq;
#pragma unroll
        for (int ai = 0; ai < 2; ++ai)
#pragma unroll
            for (int bj = 0; bj < 2; ++bj)
#pragma unroll
                for (int n = 0; n < 2; ++n) {
                    if (is_first) *(PG8_LAS f32x4*)(EX + ((ai * 2 + wr) * 2 + 0) * 256 + bj * 128 + cj + 4 * n) = acc[ai][bj][0][n];
                    if (is_last)  *(PG8_LAS f32x4*)(EX + ((ai * 2 + wr) * 2 + 1) * 256 + bj * 128 + cj + 4 * n) = acc[ai][bj][3][n];
                }
        asm volatile("s_waitcnt lgkmcnt(0)" ::: "memory"); __builtin_amdgcn_s_barrier(); asm volatile("" ::: "memory");
        const int f0 = u.pn * 128 + wc * 32 + 8 * fq;
        const f32x4 zero4 = {0.f, 0.f, 0.f, 0.f};
#pragma unroll
        for (int ai = 0; ai < 2; ++ai) {
            const int g = ai * 2 + wr;
            unsigned park[4][2];
#pragma unroll
            for (int bj = 0; bj < 2; ++bj) {
#pragma unroll
                for (int n = 0; n < 2; ++n) {
                    f32x4 wgt[4];
#pragma unroll
                    for (int j = 0; j < 4; ++j) wgt[j] = *(const PG8_LAS f32x4*)(CWL + j * 256 + bj * 128 + cj + 4 * n);
                    const f32x4 hp = (g == 0) ? zero4 : *(const PG8_LAS f32x4*)(EX + ((g - 1) * 2 + 1) * 256 + bj * 128 + cj + 4 * n);
                    const f32x4 hn = (g == 3) ? zero4 : *(const PG8_LAS f32x4*)(EX + ((g + 1) * 2 + 0) * 256 + bj * 128 + cj + 4 * n);
                    f32x4 r1p = hp, r15c = dpp_ror15(acc[ai][bj][0][n]);
#pragma unroll
                    for (int m = 0; m < 4; ++m) {
                        const f32x4 X = acc[ai][bj][m][n];
                        const f32x4 r1m = dpp_ror1(X);
                        const f32x4 prev = sel4(is_first, r1p, r1m); r1p = r1m;
                        const f32x4 r15n = (m < 3) ? dpp_ror15(acc[ai][bj][m < 3 ? m + 1 : 3][n]) : hn;
                        const f32x4 next = sel4(is_last, r15n, r15c); r15c = r15n;
                        const f32x4 Y = wgt[0] * prev + (wgt[1] * X + (wgt[2] * next + wgt[3]));
                        if (m == 0) { if (g == 0 && is_first) { int co = cj; asm volatile("" : "+v"(co)); const size_t hb = ((size_t)u.pm * 2 + 0) * FF2c + u.pn * 256 + bj * 128 + co + 4 * n; *(f32x4*)(HU + hb) = X; *(f32x4*)(HP + hb) = Y; } }
                        if (m == 3) { if (g == 3 && is_last) { int co = cj; asm volatile("" : "+v"(co)); const size_t hb = ((size_t)u.pm * 2 + 1) * FF2c + u.pn * 256 + bj * 128 + co + 4 * n; *(f32x4*)(HU + hb) = X; *(f32x4*)(HP + hb) = Y; } }
                        if (n == 0) acc[ai][bj][m][0] = (f32x4){silu_f(Y[0]), silu_f(Y[1]), silu_f(Y[2]), silu_f(Y[3])};
                        else { const f32x4 o = acc[ai][bj][m][0] * Y; const unsigned wl = cvt_pk_bf16(o[0], o[1]), wh = cvt_pk_bf16(o[2], o[3]);
                            if (bj == 0) { park[m][0] = wl; park[m][1] = wh; }
                            else { u32x4 w; w.x = park[m][0]; w.y = park[m][1]; w.z = wl; w.w = wh; NT_STORE(w, (u32x4*)(G + tiled(row0 + ai * HALF + m * 16, f0, FFc >> 5))); } }
                    }
                    __builtin_amdgcn_sched_barrier(0);
                }
            }
        }
    }
};
struct EpiNull {
    static constexpr bool PERM = true, AFTER_DRAIN = false;
    float* sink;
    __device__ __forceinline__ void operator()(const f32x4 (&acc)[2][2][4][2], const Unit& u, int wr, int wc, int fr, int fq) const {
        float s = 0.f;
#pragma unroll
        for (int ai = 0; ai < 2; ++ai)
#pragma unroll
            for (int bj = 0; bj < 2; ++bj)
#pragma unroll
                for (int m = 0; m < 4; ++m)
#pragma unroll
                    for (int n = 0; n < 2; ++n) s += (acc[ai][bj][m][n][0] + acc[ai][bj][m][n][1]) + (acc[ai][bj][m][n][2] + acc[ai][bj][m][n][3]);
        if (s == 1.2345678e30f) sink[0] = s;
    }
};

struct EpiStoreOnly {
    static constexpr bool PERM = true, AFTER_DRAIN = false;
    bf16_t* O; int ldc; int pn_lim;
    __device__ __forceinline__ void operator()(const f32x4 (&acc)[2][2][4][2], const Unit& u, int wr, int wc, int fr, int fq) const {
        if (u.pn >= pn_lim) return;
        const int row0 = u.pm * BM + wr * 64 + fr, col0 = u.pn * BM + wc * 32 + 8 * fq;
#pragma unroll
        for (int ai = 0; ai < 2; ++ai)
#pragma unroll
            for (int m = 0; m < 4; ++m) {
                bf16_t* rowp = O + (size_t)(row0 + ai * HALF + m * 16) * ldc + col0;
#pragma unroll
                for (int bj = 0; bj < 2; ++bj) {
                    const f32x4 v0 = acc[ai][bj][m][0], v1 = acc[ai][bj][m][1];
                    u32x4 w; w.x = cvt_pk_bf16(v0[0], v0[1]); w.y = cvt_pk_bf16(v0[2], v0[3]); w.z = cvt_pk_bf16(v1[0], v1[1]); w.w = cvt_pk_bf16(v1[2], v1[3]);
                    *(u32x4*)(rowp + bj * HALF) = w;
                }
            }
    }
};
struct EpiLoadOnly {
    static constexpr bool PERM = true, AFTER_DRAIN = false;
    float* sink; const float* ssq; const float* tcos; const float* tsin;
    __device__ __forceinline__ void operator()(const f32x4 (&acc)[2][2][4][2], const Unit& u, int wr, int wc, int fr, int fq) const {
        const int row0 = u.pm * BM + wr * 64 + fr; const int fi = 4 * ((wc & 1) * 4 + fq);
        float rs[2][4]; rows_rstd(ssq, row0, fq, rs); float s = 0.f;
#pragma unroll
        for (int ai = 0; ai < 2; ++ai)
#pragma unroll
            for (int m = 0; m < 4; ++m) { const int row = row0 + ai * HALF + m * 16; const f32x4 c4 = *(const f32x4*)(tcos + (size_t)row * 32 + fi), s4 = *(const f32x4*)(tsin + (size_t)row * 32 + fi);
#pragma unroll
                for (int bj = 0; bj < 2; ++bj) { const f32x4 x1 = acc[ai][bj][m][0] * rs[ai][m], x2 = acc[ai][bj][m][1] * rs[ai][m]; const f32x4 y1 = x1 * c4 - x2 * s4, y2 = x2 * c4 + x1 * s4;
                    s += (y1[0] + y1[1]) + (y1[2] + y1[3]) + (y2[0] + y2[1]) + (y2[2] + y2[3]); } }
        if (s == 1.2345678e30f) sink[0] = s;
    }
};
template <class Epi, class Sched, bool ALIGN_EPI = false, bool SP2 = false>
__device__ __forceinline__ void gemm_phase(PG8_LAS unsigned char* lds, const Gemm g, const Sched& S, const Epi& E) {
    int tid = threadIdx.x; asm volatile("" : "+v"(tid));
    const int wid = __builtin_amdgcn_readfirstlane(tid >> 6), lane = tid & 63, wr = wid >> 2, wc = wid & 3, fr = lane & 15, fq = lane >> 4;
    const int K = g.K, nt = K / BK;
    unsigned voffA[2], voffB[2];
#pragma unroll
    for (int i = 0; i < 2; ++i) { int R, C; stage_rc(tid * 16 + i * 8192, R, C); const int Rb = Epi::PERM ? ((R & ~31) + perm32(R & 31)) : R;
        voffA[i] = (unsigned)((R >> 4) * 16 * K + (C >> 5) * 512 + (R & 15) * 32 + (C & 31)) * 2u;     voffB[i] = (unsigned)(Rb * K + C) * 2u; }
    const size_t kstep = (size_t)(BK * 2);
    const size_t kstepA = 2048;
    const size_t hstep = (size_t)HALF * K * 2;
    const size_t tstep = 2 * hstep;
    const unsigned ldsw = (unsigned)wid * 1024u;
    const int aoff = lds_byte(wr * 64 + fr, fq * 8), boff = lds_byte(wc * 32 + fr, fq * 8);
#define PG8_SA(b, h) (((b) * 2 + (h)) * HTB)
#define PG8_SB(b, h) ((4 + (b) * 2 + (h)) * HTB)
#define PG8_STAGE(bufoff, gbase, voff) do { _Pragma("unroll") for (int _i = 0; _i < 2; ++_i) \
        __builtin_amdgcn_global_load_lds((const unsigned*)((const char*)(gbase) + (voff)[_i]), (PG8_LAS unsigned*)(lds + (bufoff) + ldsw + _i * 8192), 16, 0, 0); } while (0)
#define PG8_LDA(dst, b, h) do { _Pragma("unroll") for (int m = 0; m < 4; ++m) _Pragma("unroll") for (int k = 0; k < 2; ++k) dst[m][k] = *(const PG8_LAS bf16x8*)(lds + PG8_SA(b, h) + aoff + m * 2048 + k * 1024); } while (0)
#define PG8_LDB(dst, b, h) do { _Pragma("unroll") for (int n = 0; n < 2; ++n) _Pragma("unroll") for (int k = 0; k < 2; ++k) dst[n][k] = *(const PG8_LAS bf16x8*)(lds + PG8_SB(b, h) + boff + n * 2048 + k * 1024); } while (0)
#define PG8_MMA(ai, bj, At, Bt) do { __builtin_amdgcn_s_setprio(1); _Pragma("unroll") for (int m = 0; m < 4; ++m) _Pragma("unroll") for (int n = 0; n < 2; ++n) _Pragma("unroll") for (int k = 0; k < 2; ++k) \
        acc[ai][bj][m][n] = __builtin_amdgcn_mfma_f32_16x16x32_bf16(Bt[n][k], At[m][k], acc[ai][bj][m][n], 0, 0, 0); __builtin_amdgcn_s_setprio(0); } while (0)
#define PG8_WAIT_V(n) asm volatile("s_waitcnt vmcnt(" #n ")" ::: "memory")
#define PG8_WAIT_L(n) asm volatile("s_waitcnt lgkmcnt(" #n ")" ::: "memory")
#define PG8_BAR __builtin_amdgcn_s_barrier()
#define PG8_SCHED __builtin_amdgcn_sched_barrier(0)
    Unit cur, nxt; int ui = 0;
    if (!S.next(0, cur)) return;
    f32x4 acc[2][2][4][2];
#pragma unroll
    for (int a = 0; a < 2; ++a)
#pragma unroll
        for (int b = 0; b < 2; ++b)
#pragma unroll
            for (int m = 0; m < 4; ++m)
#pragma unroll
                for (int n = 0; n < 2; ++n) acc[a][b][m][n] = (f32x4){0.f, 0.f, 0.f, 0.f};
    bf16x8 At[4][2], B0[2][2], B1[2][2];
    const char* cA = (const char*)g.A + (size_t)cur.pm * tstep; const char* cB = (const char*)g.Bt + (size_t)cur.pn * tstep;
    S.a_ready(cur);
    if constexpr (SP2) {
        PG8_STAGE(PG8_SB(0, 0), cB, voffB); PG8_STAGE(PG8_SB(0, 1), cB + hstep, voffB); PG8_STAGE(PG8_SA(0, 0), cA, voffA); PG8_STAGE(PG8_SA(0, 1), cA + hstep, voffA);
        if (wr == 1) PG8_BAR;
        PG8_WAIT_V(2); PG8_BAR;
        PG8_STAGE(PG8_SB(1, 0), cB + kstep, voffB); PG8_STAGE(PG8_SA(1, 0), cA + kstepA, voffA); PG8_STAGE(PG8_SB(1, 1), cB + hstep + kstep, voffB);
        PG8_WAIT_V(6); PG8_BAR;
    } else {
        PG8_STAGE(PG8_SB(0, 0), cB, voffB); PG8_STAGE(PG8_SA(0, 0), cA, voffA); PG8_STAGE(PG8_SB(0, 1), cB + hstep, voffB); PG8_STAGE(PG8_SA(0, 1), cA + hstep, voffA);
        if (wr == 1) PG8_BAR;
        PG8_WAIT_V(4); PG8_BAR;
        PG8_STAGE(PG8_SB(1, 0), cB + kstep, voffB); PG8_STAGE(PG8_SA(1, 0), cA + kstepA, voffA); PG8_STAGE(PG8_SB(1, 1), cB + hstep + kstep, voffB);
        PG8_WAIT_V(6); PG8_BAR;
    }
    for (;;) {
        const bool has_next = S.next(ui + 1, nxt);
        const char* nA = has_next ? (const char*)g.A + (size_t)nxt.pm * tstep : cA; const char* nB = has_next ? (const char*)g.Bt + (size_t)nxt.pn * tstep : cB;
        for (int t = 0; t < nt; t += 2) {
            const bool last = (t == nt - 2);
            const char* a1 = cA + (size_t)(t + 1) * kstepA;
            const char* a2 = last ? nA : cA + (size_t)(t + 2) * kstepA; const char* b2 = last ? nB : cB + (size_t)(t + 2) * kstep;
            const char* a3 = a2 + kstepA; const char* b3 = b2 + kstep;
            if (last && has_next) S.a_ready(nxt);
            if constexpr (SP2) {
            PG8_LDB(B0, 0, 0); PG8_LDB(B1, 0, 1); PG8_SCHED; PG8_LDA(At, 0, 0); PG8_STAGE(PG8_SA(1, 1), a1 + hstep, voffA);
            PG8_WAIT_V(8); PG8_WAIT_L(0); PG8_BAR; PG8_MMA(0, 0, At, B0); PG8_MMA(0, 1, At, B1); PG8_BAR; PG8_SCHED;
            PG8_LDA(At, 0, 1); PG8_STAGE(PG8_SB(0, 0), b2, voffB); PG8_STAGE(PG8_SB(0, 1), b2 + hstep, voffB); PG8_STAGE(PG8_SA(0, 0), a2, voffA);
            PG8_WAIT_V(8); PG8_WAIT_L(0); PG8_BAR; PG8_MMA(1, 0, At, B0); PG8_MMA(1, 1, At, B1); PG8_BAR; PG8_SCHED;
            PG8_LDB(B0, 1, 0); PG8_LDB(B1, 1, 1); PG8_SCHED; PG8_LDA(At, 1, 0); PG8_STAGE(PG8_SA(0, 1), a2 + hstep, voffA);
            PG8_WAIT_V(8); PG8_WAIT_L(0); PG8_BAR; PG8_MMA(0, 0, At, B0); PG8_MMA(0, 1, At, B1); PG8_BAR; PG8_SCHED;
            PG8_LDA(At, 1, 1); PG8_STAGE(PG8_SB(1, 0), b3, voffB); PG8_STAGE(PG8_SB(1, 1), b3 + hstep, voffB); PG8_STAGE(PG8_SA(1, 0), a3, voffA);
            PG8_WAIT_V(8); PG8_WAIT_L(0); PG8_BAR; PG8_MMA(1, 0, At, B0); PG8_MMA(1, 1, At, B1); PG8_BAR; PG8_SCHED;
            } else {
            PG8_LDB(B0, 0, 0); PG8_SCHED; PG8_LDA(At, 0, 0); PG8_STAGE(PG8_SA(1, 1), a1 + hstep, voffA);
            PG8_WAIT_L(8); PG8_BAR; PG8_WAIT_L(0); PG8_MMA(0, 0, At, B0); PG8_BAR; PG8_SCHED;
            PG8_LDB(B1, 0, 1); PG8_STAGE(PG8_SB(0, 0), b2, voffB);
            PG8_BAR; PG8_WAIT_L(0); PG8_MMA(0, 1, At, B1); PG8_BAR;
            PG8_LDA(At, 0, 1); PG8_STAGE(PG8_SA(0, 0), a2, voffA);
            PG8_BAR; PG8_WAIT_L(0); PG8_MMA(1, 0, At, B0); PG8_BAR; PG8_SCHED;
            PG8_STAGE(PG8_SB(0, 1), b2 + hstep, voffB);
            PG8_WAIT_V(6); PG8_BAR; PG8_MMA(1, 1, At, B1); PG8_BAR;
            PG8_LDB(B0, 1, 0); PG8_SCHED; PG8_LDA(At, 1, 0); PG8_STAGE(PG8_SA(0, 1), a2 + hstep, voffA);
            PG8_WAIT_L(8); PG8_BAR; PG8_WAIT_L(0); PG8_MMA(0, 0, At, B0); PG8_BAR; PG8_SCHED;
            PG8_LDB(B1, 1, 1); PG8_STAGE(PG8_SB(1, 0), b3, voffB);
            PG8_BAR; PG8_WAIT_L(0); PG8_MMA(0, 1, At, B1); PG8_BAR;
            PG8_LDA(At, 1, 1); PG8_STAGE(PG8_SA(1, 0), a3, voffA);
            PG8_BAR; PG8_WAIT_L(0); PG8_MMA(1, 0, At, B0); PG8_BAR; PG8_SCHED;
            PG8_STAGE(PG8_SB(1, 1), b3 + hstep, voffB);
            PG8_WAIT_V(6); PG8_BAR; PG8_MMA(1, 1, At, B1); PG8_BAR;
            }
        }
        if constexpr (ALIGN_EPI) { if (wr == 0) PG8_BAR; }
        if constexpr (!Epi::AFTER_DRAIN) { E(acc, cur, wr, wc, fr, fq); S.done(cur); }
        if (!has_next) break;
#pragma unroll
        for (int a = 0; a < 2; ++a)
#pragma unroll
            for (int b = 0; b < 2; ++b)
#pragma unroll
                for (int m = 0; m < 4; ++m)
#pragma unroll
                    for (int n = 0; n < 2; ++n) acc[a][b][m][n] = (f32x4){0.f, 0.f, 0.f, 0.f};
        cur = nxt; cA = nA; cB = nB; ++ui;
        if constexpr (ALIGN_EPI) { if (wr == 1) PG8_BAR; }
    }
    PG8_WAIT_V(0);
    if constexpr (!ALIGN_EPI) { if (wr == 0) PG8_BAR; }
    PG8_BAR;
    if constexpr (Epi::AFTER_DRAIN) { E.fused(acc, cur, wr, wc, fr, fq, lds, wid, lane); S.done(cur); }
#undef PG8_SA
#undef PG8_SB
#undef PG8_STAGE
#undef PG8_LDA
#undef PG8_LDB
#undef PG8_MMA
#undef PG8_WAIT_V
#undef PG8_WAIT_L
#undef PG8_BAR
#undef PG8_SCHED
}
}

namespace att {
typedef unsigned short bf16_t;
using bf16x8 = __attribute__((ext_vector_type(8))) short;
using s16x4  = __attribute__((ext_vector_type(4))) short;
using f32x16 = __attribute__((ext_vector_type(16))) float;
using u32x4  = __attribute__((ext_vector_type(4))) unsigned;
using f32x4a = __attribute__((ext_vector_type(4))) float;
constexpr int DV = 128, DQK = 64, NW = 8, QBLK = 32, KVBLK = 64, OLD = 1024, SEQ = 2048;
constexpr int NBUF = 4, SHM_V = KVBLK * DV * 2, SHM_K = KVBLK * DQK * 2, OFF_V = 0, OFF_K = NBUF * SHM_V, OFF_WS = OFF_K + NBUF * SHM_K, SHM_TOTAL = OFF_WS + NW * 64 * 4;
constexpr float THR2 = 11.5f;
__device__ __forceinline__ int tl(int row, int col) { return (((row >> 4) * 32 + (col >> 5)) << 9) + ((row & 15) << 5) + (col & 31); }
#define AKSW(row, colB) ((row) * 128 + ((colB) ^ ((((row) >> 1) & 7) << 4)))
#define ASBAR() __builtin_amdgcn_sched_barrier(0)
__device__ __forceinline__ int crow(int r, int hi) { return (r & 3) + 8 * (r >> 2) + 4 * hi; }
__device__ __forceinline__ unsigned cvtpk(float lo, float hi) { unsigned r; asm volatile("v_cvt_pk_bf16_f32 %0, %1, %2" : "=v"(r) : "v"(lo), "v"(hi)); return r; }

__device__ __forceinline__ float fadd_s(float a, float b) { float r; asm("v_add_f32_e32 %0, %1, %2" : "=v"(r) : "v"(a), "v"(b)); return r; }
__device__ __forceinline__ float fsub_s(float a, float b) { float r; asm("v_sub_f32_e32 %0, %1, %2" : "=v"(r) : "v"(a), "v"(b)); return r; }
template <bool FAST> __device__ __forceinline__ void partialSM(f32x16& p0, f32x16& p1, float& m_reg, float& mn, float& alpha) {
  if constexpr (FAST) {
#pragma unroll
    for (int r = 0; r < 16; ++r) p0[r] = __builtin_amdgcn_exp2f(p0[r]);
    alpha = 1.f; mn = 0.f; return;
  }
  float pmax = p0[0];
#pragma unroll
  for (int r = 1; r < 16; ++r) pmax = fmaxf(pmax, p0[r]);
#pragma unroll
  for (int r = 0; r < 16; ++r) pmax = fmaxf(pmax, p1[r]);
  { unsigned xa = __float_as_uint(pmax), xb; asm volatile("v_mov_b32 %0, %1" : "=v"(xb) : "v"(xa)); auto rr = __builtin_amdgcn_permlane32_swap(xa, xb, false, false);
    pmax = fmaxf(__uint_as_float(rr[0]), __uint_as_float(rr[1])); }
  if (__builtin_expect(__all(pmax - m_reg <= THR2), 1)) { mn = m_reg; alpha = 1.f; }
  else { mn = fmaxf(m_reg, pmax); alpha = __builtin_amdgcn_exp2f(m_reg - mn); m_reg = mn; }
#pragma unroll
  for (int r = 0; r < 16; ++r) p0[r] = fsub_s(p0[r], mn);
#pragma unroll
  for (int r = 0; r < 16; ++r) p1[r] = fsub_s(p1[r], mn);
#pragma unroll
  for (int r = 0; r < 16; ++r) p0[r] = __builtin_amdgcn_exp2f(p0[r]);
}
__device__ __forceinline__ void finishSM(f32x16& p0, f32x16& p1, float alpha, float& l_reg, bf16x8& pa0, bf16x8& pa1, bf16x8& pa2, bf16x8& pa3) {
#pragma unroll
  for (int r = 0; r < 16; ++r) p1[r] = __builtin_amdgcn_exp2f(p1[r]);
  float ps = fadd_s(p0[0], p1[0]), ps2 = fadd_s(p0[1], p1[1]);
#pragma unroll
  for (int r = 2; r < 16; r += 2) { ps = fadd_s(ps, p0[r]); ps2 = fadd_s(ps2, p0[r + 1]); }
#pragma unroll
  for (int r = 2; r < 16; r += 2) { ps = fadd_s(ps, p1[r]); ps2 = fadd_s(ps2, p1[r + 1]); }
  ps = fadd_s(ps, ps2);
  ps = lane_xor_add<32>(ps);
  l_reg = l_reg * alpha + ps;
#define APK4(P, BASE, OUT) do { unsigned a0 = cvtpk(P[BASE + 0], P[BASE + 1]), a1 = cvtpk(P[BASE + 2], P[BASE + 3]);   \
    unsigned b0 = cvtpk(P[BASE + 4], P[BASE + 5]), b1 = cvtpk(P[BASE + 6], P[BASE + 7]);                              \
    auto r0 = __builtin_amdgcn_permlane32_swap(a0, b0, false, false); auto r1 = __builtin_amdgcn_permlane32_swap(a1, b1, false, false); \
    u32x4 w = {r0[0], r1[0], r0[1], r1[1]}; OUT = *reinterpret_cast<bf16x8*>(&w); } while (0)
  APK4(p0, 0, pa0); APK4(p0, 8, pa1); APK4(p1, 0, pa2); APK4(p1, 8, pa3);
#undef APK4
}
__device__ __forceinline__ void qkt(f32x16& p0, f32x16& p1, const char* Ks, const bf16x8* qr, int r32, int hi) {
  p0 = f32x16{}; p1 = f32x16{};
#pragma unroll
  for (int d0 = 0; d0 < 4; ++d0) { const int cb = d0 * 32 + hi * 16;
    const bf16x8 b0 = *reinterpret_cast<const bf16x8*>(Ks + AKSW(r32, cb));
    const bf16x8 b1 = *reinterpret_cast<const bf16x8*>(Ks + AKSW(32 + r32, cb));
    p0 = __builtin_amdgcn_mfma_f32_32x32x16_bf16(b0, qr[d0], p0, 0, 0, 0);
    p1 = __builtin_amdgcn_mfma_f32_32x32x16_bf16(b1, qr[d0], p1, 0, 0, 0); }
}
__device__ __forceinline__ int v_st(int k, int c) { const int kk = (k & ~0xC) | ((k & 4) << 1) | ((k & 8) >> 1); return ((kk >> 3) * 4 + (c >> 5)) * 512 + ((kk & 7) * 32 + (c & 31)) * 2; }
__device__ __forceinline__ int v_rd_base(int lane) { return ((lane & 3) << 3) | (((lane >> 2) & 3) << 6) | (((lane >> 4) & 1) << 5) | (((lane >> 5) & 1) << 8); }
constexpr int v_rd_off(int d0, int ks, int half) { return d0 * 512 + ks * 4096 + half * 2048; }
template <int OFF> __device__ __forceinline__ s16x4 tr_read(int vb) {
  s16x4 r; asm volatile("ds_read_b64_tr_b16 %0, %1 offset:%2" : "=&v"(r) : "v"(vb), "i"(OFF) : "memory"); return r;
}
template <int KS> __device__ __forceinline__ void pv_step(f32x16* o, int vb, bf16x8 pa) {
  const s16x4 l0 = tr_read<v_rd_off(0, KS, 0)>(vb), h0 = tr_read<v_rd_off(0, KS, 1)>(vb), l1 = tr_read<v_rd_off(1, KS, 0)>(vb), h1 = tr_read<v_rd_off(1, KS, 1)>(vb);
  const s16x4 l2 = tr_read<v_rd_off(2, KS, 0)>(vb), h2 = tr_read<v_rd_off(2, KS, 1)>(vb), l3 = tr_read<v_rd_off(3, KS, 0)>(vb), h3 = tr_read<v_rd_off(3, KS, 1)>(vb);
  asm volatile("s_waitcnt lgkmcnt(0)" ::: "memory"); ASBAR();
#define APK(L, H) (bf16x8){L[0], L[1], L[2], L[3], H[0], H[1], H[2], H[3]}
  o[0] = __builtin_amdgcn_mfma_f32_32x32x16_bf16(pa, APK(l0, h0), o[0], 0, 0, 0);
  o[1] = __builtin_amdgcn_mfma_f32_32x32x16_bf16(pa, APK(l1, h1), o[1], 0, 0, 0);
  o[2] = __builtin_amdgcn_mfma_f32_32x32x16_bf16(pa, APK(l2, h2), o[2], 0, 0, 0);
  o[3] = __builtin_amdgcn_mfma_f32_32x32x16_bf16(pa, APK(l3, h3), o[3], 0, 0, 0);
#undef APK
}
__device__ __forceinline__ void pv_d0(f32x16* o, int vb, bf16x8 pa0, bf16x8 pa1, bf16x8 pa2, bf16x8 pa3) {
  pv_step<0>(o, vb, pa0); pv_step<1>(o, vb, pa1); pv_step<2>(o, vb, pa2); pv_step<3>(o, vb, pa3);
}

__device__ __forceinline__ void glds16(const void* gsrc, unsigned lds_dst) { unsigned keep;
  asm volatile("s_mov_b32 %0, m0\n\ts_mov_b32 m0, %2\n\ts_nop 0\n\tglobal_load_lds_dwordx4 %1, off\n\ts_mov_b32 m0, %0" : "=&s"(keep) : "v"(gsrc), "s"(lds_dst) : "memory"); }
#define AWAIT_BAR(N) asm volatile("s_waitcnt vmcnt(" #N ") lgkmcnt(0)\n\ts_barrier" ::: "memory")
template <bool FAST> __device__ __forceinline__ void attn_pass(const bf16_t* __restrict__ Qb, const bf16_t* __restrict__ Kh, const bf16_t* __restrict__ Vh, int qcol, int kcol, int vcol, char* lds, f32x16 (&o)[4]) {
  int tid = threadIdx.x; asm volatile("" : "+v"(tid));
  const int wid = tid >> 6, lane = tid & 63, r32 = lane & 31, hi = lane >> 5;
  const int wids = __builtin_amdgcn_readfirstlane(wid);
  char* V_lds = lds + OFF_V; char* K_lds = lds + OFF_K;
  float* ws = (float*)(lds + OFF_WS) + wid * 64; float* li_l = ws; float* al_l = ws + 32;
  float m_reg = -1e30f, l_reg = 0; bf16x8 qr[4];
#pragma unroll
  for (int d = 0; d < 4; ++d) o[d] = f32x16{};
#pragma unroll
  for (int d0 = 0; d0 < 4; ++d0) qr[d0] = *reinterpret_cast<const bf16x8*>(Qb + tl(wid * QBLK + r32, qcol + d0 * 16 + hi * 8));
  const int vb0 = (int)(uintptr_t)V_lds + v_rd_base(lane);
  const int krow = 8 * wid + (lane >> 3), kof = tl(krow, kcol + 8 * ((lane & 7) ^ ((krow >> 1) & 7)));
  int vof[2];
#pragma unroll
  for (int i = 0; i < 2; ++i) { const int q = 2 * wid + i, kk = (q >> 1) * 8 + ((lane >> 2) & 7), key = (kk & ~0xC) | ((kk & 4) << 1) | ((kk & 8) >> 1);
    vof[i] = tl(key, vcol + (2 * (q & 1) + (lane >> 5)) * 32 + (lane & 3) * 8); }
  const unsigned kdst = (unsigned)(uintptr_t)K_lds + wids * 1024, vdst = (unsigned)(uintptr_t)V_lds + wids * 2048;
#define ADMA(t) do { const int t_ = (t) < NT ? (t) : NT - 1; const int bb = (t) & 3; \
    glds16(Kh + (long)t_ * (KVBLK * 1024) + kof, (unsigned)__builtin_amdgcn_readfirstlane(kdst + bb * SHM_K)); \
    glds16(Vh + (long)t_ * (KVBLK * 1024) + vof[0], (unsigned)__builtin_amdgcn_readfirstlane(vdst + bb * SHM_V)); \
    glds16(Vh + (long)t_ * (KVBLK * 1024) + vof[1], (unsigned)__builtin_amdgcn_readfirstlane(vdst + bb * SHM_V + 1024)); } while (0)
#define ARESC(a) do { if (!FAST && __any((a) < 1.f)) { if (hi == 0) al_l[r32] = (a); asm volatile("s_waitcnt lgkmcnt(0)" ::: "memory"); \
    _Pragma("unroll") for (int d = 0; d < 4; ++d) _Pragma("unroll") for (int r = 0; r < 16; ++r) o[d][r] *= al_l[crow(r, hi)]; } } while (0)
  f32x16 pA0, pA1, pB0, pB1; float mnA, mnB, alA, alB; bf16x8 pa0, pa1, pa2, pa3; constexpr int NT = SEQ / KVBLK;
  ADMA(0); ADMA(1);
  AWAIT_BAR(3);
  qkt(pA0, pA1, K_lds, qr, r32, hi); partialSM<FAST>(pA0, pA1, m_reg, mnA, alA);
  ADMA(2);
  AWAIT_BAR(3);
  for (int j = 1; j + 1 < NT; j += 2) {
    ASBAR(); qkt(pB0, pB1, K_lds + (j & 3) * SHM_K, qr, r32, hi);
    finishSM(pA0, pA1, alA, l_reg, pa0, pa1, pa2, pa3); ASBAR();
    ADMA(j + 2); ASBAR();
    pv_d0(o, vb0 + ((j - 1) & 3) * SHM_V, pa0, pa1, pa2, pa3); partialSM<FAST>(pB0, pB1, m_reg, mnB, alB);
    ARESC(alB); AWAIT_BAR(3);
    ASBAR(); qkt(pA0, pA1, K_lds + ((j + 1) & 3) * SHM_K, qr, r32, hi);
    finishSM(pB0, pB1, alB, l_reg, pa0, pa1, pa2, pa3); ASBAR();
    ADMA(j + 3); ASBAR();
    pv_d0(o, vb0 + (j & 3) * SHM_V, pa0, pa1, pa2, pa3); partialSM<FAST>(pA0, pA1, m_reg, mnA, alA);
    ARESC(alA); AWAIT_BAR(3);
  }
  ASBAR(); qkt(pB0, pB1, K_lds + ((NT - 1) & 3) * SHM_K, qr, r32, hi);
  finishSM(pA0, pA1, alA, l_reg, pa0, pa1, pa2, pa3); ASBAR();
  pv_d0(o, vb0 + ((NT - 2) & 3) * SHM_V, pa0, pa1, pa2, pa3); partialSM<FAST>(pB0, pB1, m_reg, mnB, alB);
  ARESC(alB);
  finishSM(pB0, pB1, alB, l_reg, pa0, pa1, pa2, pa3); ASBAR();
  pv_d0(o, vb0 + ((NT - 1) & 3) * SHM_V, pa0, pa1, pa2, pa3);
  if (hi == 0) li_l[r32] = l_reg; asm volatile("s_waitcnt lgkmcnt(0)" ::: "memory");
#pragma unroll
  for (int r = 0; r < 16; ++r) { const float rl = __builtin_amdgcn_rcpf(li_l[crow(r, hi)]);
#pragma unroll
    for (int d = 0; d < 4; ++d) o[d][r] *= rl; }
  AWAIT_BAR(0);
#undef ADMA
#undef ARESC
}

__device__ __forceinline__ void attn_unit(int b, int h, int qb, const bf16_t* Q, const bf16_t* K, const bf16_t* V, bf16_t* O, float* stash,
                                          float lam, const float* subg, float osc, char* lds) {
  const long rowbase = (long)b * SEQ, q0 = (long)qb * 256;
  const bf16_t* Qb = Q + (rowbase + q0) * 1024; const bf16_t* Kh = K + rowbase * 1024; const bf16_t* Vh = V + rowbase * 1024;
#pragma unroll 1
  for (int c = 0; c < 2; ++c) {
    f32x16 o[4];
    attn_pass<false>(Qb, Kh, Vh, h * 128 + c * 64, h * 128 + c * 64, h * 128, lds, o);
    int zz = 0; asm volatile("" : "+v"(zz));
    const int tid = (int)threadIdx.x + zz, wid = tid >> 6, lane = tid & 63, r32 = lane & 31, hi = lane >> 5;
    f32x4a* st = (f32x4a*)(stash + ((size_t)blockIdx.x * 512 + tid) * 64);
    if (c == 0) {
#pragma unroll
      for (int d = 0; d < 4; ++d)
#pragma unroll
        for (int q = 0; q < 4; ++q) st[d * 4 + q] = (f32x4a){o[d][4 * q], o[d][4 * q + 1], o[d][4 * q + 2], o[d][4 * q + 3]};
    } else {
      float g4[4];
#pragma unroll
      for (int d = 0; d < 4; ++d) g4[d] = subg[32 * d + r32] * osc;
      bf16_t* Ow = O + (rowbase + q0 + wid * QBLK) * 1024;
#pragma unroll
      for (int q = 0; q < 4; ++q) {
        f32x4a s4[4];
#pragma unroll
        for (int d = 0; d < 4; ++d) s4[d] = st[d * 4 + q];
#pragma unroll
        for (int j = 0; j < 4; ++j) { const int r = 4 * q + j;
          float e[4];
#pragma unroll
          for (int d = 0; d < 4; ++d) e[d] = s4[d][j] - lam * o[d][r];
          float ss = (e[0] * e[0] + e[1] * e[1]) + (e[2] * e[2] + e[3] * e[3]);
          ss = lane_xor_add<1>(ss); ss = lane_xor_add<2>(ss); ss = lane_xor_add<4>(ss); ss = lane_xor_add<8>(ss); ss = lane_xor_add<16>(ss);
          const float rs = __builtin_amdgcn_rsqf(ss * (1.0f / 128.0f) + 1e-5f);
          const int orow = crow(r, hi);
#pragma unroll
          for (int d = 0; d < 4; ++d) Ow[tiled(orow, h * 128 + d * 32 + r32, 32)] = (bf16_t)(cvtpk(e[d] * rs * g4[d], 0.f) & 0xffffu);
        }
      }
    }
  }
}
#undef AKSW
#undef ASBAR
}
#ifndef LAS
#define LAS __attribute__((address_space(3)))
#endif
#define XB_TMO      128
#define XB_XCNT(j)  (256  + 64 * (j))
#define XB_XSUB(j)  (1280 + 64 * (j))
#define XB_XGEN(j)  (2304 + 64 * (j))
#define XB_TOP      3328
#define XB_TOPGEN   3392
#define XCD_BAR_WORDS 3456
#define XB_SPIN_CAP (1u << 18)

__device__ __forceinline__ unsigned xb_ld(unsigned* p)              { return __hip_atomic_load(p, __ATOMIC_RELAXED, __HIP_MEMORY_SCOPE_AGENT); }
__device__ __forceinline__ unsigned xb_add(unsigned* p, unsigned v) { return __hip_atomic_fetch_add(p, v, __ATOMIC_RELAXED, __HIP_MEMORY_SCOPE_AGENT); }
__device__ __forceinline__ unsigned xb_xcc_id() { return (unsigned)__builtin_amdgcn_s_getreg((3 << 11) | 20) & 0xFu; }
#define XB_SPIN(cond, bar) do { unsigned _sp = 0; while (cond) { __builtin_amdgcn_s_sleep(1); \
    if ((++_sp & 255u) == 0u) { if (xb_ld(&(bar)[XB_TMO])) break; if (_sp > XB_SPIN_CAP) { atomicAdd(&(bar)[XB_TMO], 1u); break; } } } } while (0)

struct XcdBarrier {
    unsigned* bar; unsigned x;
    volatile LAS unsigned* st;
};

__device__ __forceinline__ XcdBarrier xcd_barrier_post(unsigned* bar, volatile LAS unsigned* st) {
    XcdBarrier b; b.bar = bar; b.x = xb_xcc_id(); b.st = st;
    if (threadIdx.x == 0) (void)xb_add(&bar[XB_XCNT(b.x)], 1u);
    return b;
}
__device__ __forceinline__ void xcd_barrier_complete(unsigned* bar, unsigned x, unsigned& nloc, unsigned& nx) {
    const unsigned G = gridDim.x * gridDim.y * gridDim.z;
    unsigned sum, cnt, mine, sp = 0u;
    for (;;) {
        sum = 0u; cnt = 0u; mine = 0u;
#pragma unroll
        for (unsigned j = 0; j < 16; ++j) { const unsigned c = xb_ld(&bar[XB_XCNT(j)]); sum += c; cnt += (c > 0u) ? 1u : 0u; mine = (j == x) ? c : mine; }
        if (sum == G) break;
        __builtin_amdgcn_s_sleep(1);
        if ((++sp & 255u) == 0u) { if (xb_ld(&bar[XB_TMO])) break; if (sp > XB_SPIN_CAP) { atomicAdd(&bar[XB_TMO], 1u); break; } }
    }
    nloc = mine > 0u ? mine : 1u; nx = cnt > 0u ? cnt : 1u;
}

__device__ __forceinline__ void xcd_barrier(const XcdBarrier& b) {
    asm volatile("s_waitcnt vmcnt(0)" ::: "memory");
    __syncthreads();
    if (threadIdx.x == 0) {
        unsigned* bar = b.bar;
        __builtin_amdgcn_s_waitcnt(0);
        unsigned nloc = b.st[0], nx = b.st[1];
        if (nloc == 0u) { xcd_barrier_complete(bar, b.x, nloc, nx); b.st[0] = nloc; b.st[1] = nx; }
        const unsigned old = xb_add(&bar[XB_XSUB(b.x)], 1u);
        const unsigned gen = old / nloc;
        if (old + 1u == (gen + 1u) * nloc) {
            __builtin_amdgcn_fence(__ATOMIC_RELEASE, "agent");
            asm volatile("s_waitcnt vmcnt(0)" ::: "memory");
            const unsigned og = xb_add(&bar[XB_TOP], 1u);
            const unsigned tg = og / nx;
            if (og + 1u == (tg + 1u) * nx) xb_add(&bar[XB_TOPGEN], 1u);
            else XB_SPIN(xb_ld(&bar[XB_TOPGEN]) == tg, bar);
            __builtin_amdgcn_fence(__ATOMIC_ACQUIRE, "agent");
            xb_add(&bar[XB_XGEN(b.x)], 1u);
            asm volatile("s_waitcnt vmcnt(0)" ::: "memory");
        } else {
            XB_SPIN(xb_ld(&bar[XB_XGEN(b.x)]) == gen, bar);
            __builtin_amdgcn_fence(__ATOMIC_ACQUIRE, "agent");
            asm volatile("s_waitcnt vmcnt(0)" ::: "memory");
        }
    }
    __syncthreads();
}


namespace cg = cooperative_groups;
#define LAS __attribute__((address_space(3)))
typedef unsigned short bf16;
typedef unsigned v4u __attribute__((ext_vector_type(4)));
typedef float f32x4 __attribute__((ext_vector_type(4)));
typedef short bf16x8 __attribute__((ext_vector_type(8)));
constexpr int NWAVES = 8, NTHR = 512;
constexpr int BATCH = 32, SEQ = 2048, D = 1024, M = BATCH * SEQ, FF = 2816, FF2 = 2 * FF, NH = 8;
constexpr int MH = M / 2;
constexpr size_t MiB = 1u << 20;
constexpr size_t WS_WQKV = 0, WS_WO = 6 * MiB, WS_WIN = 8 * MiB, WS_WOUT = 14 * MiB, WS_WUP0 = 16 * MiB, WS_WUP1 = 27 * MiB, WS_WDN0 = 38 * MiB, WS_WDN1 = 44 * MiB;
constexpr size_t WS_COS = 64 * MiB, WS_SIN = 72 * MiB;
constexpr size_t WS_SSQ = 80 * MiB, SSQ_BYTES = 4 * MiB;
constexpr size_t WS_CTL = 100 * MiB, CTL_BYTES = 16384;
constexpr size_t WS_XB = 104 * MiB;
constexpr size_t WS_R = 232 * MiB;
constexpr size_t WS_Q = WS_R, WS_K = WS_R + 128 * MiB, WS_V = WS_R + 256 * MiB, WS_O = WS_R + 384 * MiB;
constexpr size_t WS_G = WS_R, WS_U = WS_R + 352 * MiB;
constexpr size_t WS_HU = WS_R + 352 * MiB, WS_HP = WS_HU + 16 * MiB;
constexpr size_t WS_STASH = 936 * MiB;
constexpr size_t WS_END = 1000 * MiB;
constexpr int LDS_BYTES = 147456;
static_assert(att::SHM_TOTAL <= 131072, "attention LDS");

__device__ __forceinline__ unsigned f2bf(float f) { unsigned u = __builtin_bit_cast(unsigned, f); return (u + 0x7fffu + ((u >> 16) & 1u)) >> 16; }
__device__ __forceinline__ unsigned pk2(float lo, float hi) { return f2bf(lo) | (f2bf(hi) << 16); }
__device__ __forceinline__ float bflo(unsigned w) { return __builtin_bit_cast(float, w << 16); }
__device__ __forceinline__ float bfhi(unsigned w) { return __builtin_bit_cast(float, w & 0xffff0000u); }
__device__ __forceinline__ float wave_sum(float v) {
    v = lane_xor_add<1>(v); v = lane_xor_add<2>(v); v = lane_xor_add<4>(v); v = lane_xor_add<8>(v); v = lane_xor_add<16>(v); v = lane_xor_add<32>(v);
    return v;
}
__device__ __forceinline__ int dest_row(int mode, int n) {
    if (mode == 1 && n < 2048) { const int d = n & 63, dd = d & 31; return (n & ~63) + 8 * (dd >> 2) + (dd & 3) + ((d >> 5) << 2); }
    if (mode == 3) { if (n < D) return 2 * D + n; const int isu = n >= 2 * D ? 1 : 0, ff = n - D - isu * D, fl = ff & 127; return (ff >> 7) * 256 + 128 * ((fl >> 2) & 1) + 8 * (fl >> 3) + 4 * isu + (fl & 3); }
    if (mode == 2) { const int isval = n >= FF ? 1 : 0, ff = n - isval * FF, fl = ff & 127; return (ff >> 7) * 256 + 128 * ((fl >> 2) & 1) + 8 * (fl >> 3) + 4 * isval + (fl & 3); }
    return n;
}
__device__ __forceinline__ void transpose_item(const float* W, int K, int N, bf16* WT, const float* gk, int mode, LAS float* scr, int item, int lane) {
    const int nblk = N / 32, kb = item / nblk, nb = item % nblk, k0 = 64 * kb, n0 = 32 * nb;
    f32x4 v[8]; float g[8];
#pragma unroll
    for (int i = 0; i < 8; ++i) { const int kk = 8 * i + (lane >> 3); v[i] = *(const f32x4*)(W + (size_t)(k0 + kk) * N + n0 + 4 * (lane & 7)); g[i] = gk ? gk[k0 + kk] : 1.f; }
#pragma unroll
    for (int i = 0; i < 8; ++i) { const int kk = 8 * i + (lane >> 3); LAS float* d = scr + kk * 33 + 4 * (lane & 7);
        d[0] = v[i][0] * g[i]; d[1] = v[i][1] * g[i]; d[2] = v[i][2] * g[i]; d[3] = v[i][3] * g[i]; }
    asm volatile("s_waitcnt lgkmcnt(0)" ::: "memory");
    const int c = lane & 7;
#pragma unroll
    for (int j = 0; j < 4; ++j) { const int n = (lane >> 3) + 8 * j; const LAS float* s = scr + (8 * c) * 33 + n;
        v4u o; o.x = pk2(s[0 * 33], s[1 * 33]); o.y = pk2(s[2 * 33], s[3 * 33]); o.z = pk2(s[4 * 33], s[5 * 33]); o.w = pk2(s[6 * 33], s[7 * 33]);
        *(v4u*)(WT + (size_t)dest_row(mode, n0 + n) * K + k0 + 8 * c) = o; }
    asm volatile("s_waitcnt lgkmcnt(0)" ::: "memory");
}
__device__ __forceinline__ void sincos_cw(float a, float& s, float& c) {
    const float kf = rintf(a * 0.63661977236758134f); const int k = (int)kf;
    float r = fmaf(kf, -1.5703125f, a); r = fmaf(kf, -4.837512969970703125e-4f, r); r = fmaf(kf, -7.54978995489188216e-8f, r);
    const float z = r * r;
    const float sp = fmaf(r * z, fmaf(z, fmaf(z, -1.9515295891e-4f, 8.3321608736e-3f), -1.6666654611e-1f), r);
    const float cp = fmaf(z * z, fmaf(z, fmaf(z, 2.443315711809948e-5f, -1.388731625493765e-3f), 4.166664568298827e-2f), fmaf(z, -0.5f, 1.0f));
    const float ss = (k & 1) ? cp : sp, cc = (k & 1) ? sp : cp;
    s = (k & 2) ? -ss : ss; c = ((k + 1) & 2) ? -cc : cc;
}

struct Args {
    const float* x; const int* pos;
    const float *attn_g, *w_qkv, *lq1, *lk1, *lq2, *lk2, *subg, *w_o, *conv_g, *w_in, *conv_w, *w_out, *ffn_g, *w_up, *ffn_cw, *ffn_cb, *w_dn, *fin_g;
    float* out; unsigned char* ws;
};

__device__ __forceinline__ void ffn_fix_rows(int pm, bf16* Gm, const float* HU, const float* HP, const float* cw, int tid) {
    for (int it = tid; it < 2 * 22 * 32; it += NTHR) {
        const int q = it & 31, pn = (it >> 5) % 22, which = it / (32 * 22);
        if (which == 0 ? ((pm & 7) == 0) : ((pm & 7) == 7)) continue;
        const int j0 = 128 * (q & 1) + 8 * (q >> 1), f0 = 128 * pn + 4 * q, nb = which == 0 ? pm - 1 : pm + 1;
        const size_t hb = ((size_t)pm * 2 + which) * FF2 + pn * 256 + j0, nbb = ((size_t)nb * 2 + (1 - which)) * FF2 + pn * 256 + j0;
        const f32x4 pg = *(const f32x4*)(HP + hb), pv = *(const f32x4*)(HP + hb + 4), ug = *(const f32x4*)(HU + nbb), uv = *(const f32x4*)(HU + nbb + 4);
        const int jw = which == 0 ? 0 : 2;
        const f32x4 wg = *(const f32x4*)(cw + (size_t)jw * FF2 + f0), wv = *(const f32x4*)(cw + (size_t)jw * FF2 + FF + f0);
        const f32x4 yg = pg + wg * ug, yv = pv + wv * uv;
        unsigned long long o = (unsigned long long)pk2(pg8::silu_f(yg[0]) * yv[0], pg8::silu_f(yg[1]) * yv[1]) | ((unsigned long long)pk2(pg8::silu_f(yg[2]) * yv[2], pg8::silu_f(yg[3]) * yv[3]) << 32);
        *(unsigned long long*)(Gm + tiled(pm * 256 + (which ? 255 : 0), f0, FF >> 5)) = o;
    }
}
__device__ __forceinline__ void mixer_ew_phase(const bf16* CU, const bf16* Bq, bf16* Y, const float* cw, int gtid, int nthreads) {
    constexpr int TC = 32, NFC = D / 8, NITEM = (M / TC) * NFC, NCT = D >> 5;
    for (int it = gtid; it < NITEM; it += nthreads) {
        const int fc = it % NFC, tc = it / NFC, t0 = tc * TC, f0 = fc * 8;
        float w[3][8];
#pragma unroll
        for (int j = 0; j < 3; ++j)
#pragma unroll
            for (int h = 0; h < 2; ++h) { const f32x4 a = *(const f32x4*)(cw + (size_t)j * D + f0 + 4 * h);
#pragma unroll
                for (int e = 0; e < 4; ++e) w[j][4 * h + e] = a[e]; }
        const v4u zero = {0u, 0u, 0u, 0u};
        v4u p = (t0 % SEQ == 0) ? zero : *(const v4u*)(CU + tiled(t0 - 1, f0, NCT));
        v4u c = *(const v4u*)(CU + tiled(t0, f0, NCT));
#pragma unroll 4
        for (int i = 0; i < TC; ++i) {
            const v4u n = (i == TC - 1 && (t0 + TC) % SEQ == 0) ? zero : *(const v4u*)(CU + tiled(t0 + i + 1, f0, NCT));
            const v4u b_ = *(const v4u*)(Bq + tiled(t0 + i, f0, NCT));
            v4u o;
#pragma unroll
            for (int q = 0; q < 4; ++q) {
                const float y0 = bflo(b_[q]) * fmaf(w[0][2 * q], bflo(p[q]), fmaf(w[1][2 * q], bflo(c[q]), w[2][2 * q] * bflo(n[q])));
                const float y1 = bfhi(b_[q]) * fmaf(w[0][2 * q + 1], bfhi(p[q]), fmaf(w[1][2 * q + 1], bfhi(c[q]), w[2][2 * q + 1] * bfhi(n[q])));
                o[q] = pk2(y0, y1);
            }
            *(v4u*)(Y + tiled(t0 + i, f0, NCT)) = o;
            p = c; c = n;
        }
    }
}

#ifndef PROBE_ATTN
#define PROBE_ATTN 1
#endif
#ifndef PROBE_EW
#define PROBE_EW 1
#endif
#ifndef PROBE_QKV
#define PROBE_QKV 1
#endif
__device__ __forceinline__ int opaque_bx() { int b = blockIdx.x; asm volatile("" : "+s"(b)); return b; }
#ifndef PROBE_UP
#define PROBE_UP 1
#endif
#ifndef STAGGER_TICKS
#define STAGGER_TICKS 0
#endif
__device__ __forceinline__ void stagger_start(int ticks) {
    if (ticks <= 0) return;
    const unsigned long long t0 = __builtin_amdgcn_s_memrealtime(); const unsigned long long d = (unsigned long long)(((blockIdx.x >> 3) & 3) * ticks);
    while (__builtin_amdgcn_s_memrealtime() - t0 < d) __builtin_amdgcn_s_sleep(16);
}
typedef const __attribute__((address_space(4))) Args* CArgs;
__device__ __forceinline__ CArgs get_args() { CArgs p = (CArgs)__builtin_amdgcn_kernarg_segment_ptr(); asm volatile("" : "+s"(p)); return p; }
#define WSP(off) (a->ws + (off))
#define WUP_T(l) ((bf16*)WSP(WS_WUP0 + (size_t)(l) * (WS_WUP1 - WS_WUP0)))
#define WDN_T(l) ((bf16*)WSP(WS_WDN0 + (size_t)(l) * (WS_WDN1 - WS_WDN0)))
#define SSQ(i) ((float*)WSP(WS_SSQ + (size_t)(i) * SSQ_BYTES))
#define GEO() int tid = threadIdx.x; asm volatile("" : "+v"(tid)); const int lane = tid & 63, wave = __builtin_amdgcn_readfirstlane(tid >> 6); const int G = gridDim.x, bx = blockIdx.x; \
    const int vcu = (G % 8 == 0) ? (bx % 8) * (G / 8) + bx / 8 : bx; const int gw = vcu * NWAVES + wave, NGW = G * NWAVES, gtid = bx * NTHR + tid, NT = G * NTHR; \
    (void)lane; (void)gw; (void)NGW; (void)gtid; (void)NT; (void)vcu

__global__ void __launch_bounds__(NTHR, 2) mega_fwd(Args a_unused) {
    extern __shared__ __attribute__((aligned(16))) unsigned char lds[];
    cg::grid_group grid = cg::this_grid();
    LAS unsigned char* ldsl = (LAS unsigned char*)lds;
    volatile LAS unsigned* bst = (volatile LAS unsigned*)(ldsl + 147456 - 64);
    if (threadIdx.x < 2) bst[threadIdx.x] = 0u;
    __syncthreads();
    if (blockIdx.x == 0) { unsigned* cw0 = (unsigned*)(get_args()->ws + WS_CTL); for (int i = threadIdx.x; i < (int)(CTL_BYTES / 4); i += NTHR) cw0[i] = 0u; }
#define GRID_SYNC() xcd_barrier(bar)

#ifndef PROBE_PRO
#define PROBE_PRO 1
#endif
    for (int prep = 0; prep < PROBE_PRO; ++prep)
    {
        CArgs a = get_args(); GEO();
        bf16* Wqkv_t = (bf16*)WSP(WS_WQKV); bf16* Wo_t = (bf16*)WSP(WS_WO); bf16* Win_t = (bf16*)WSP(WS_WIN); bf16* Wout_t = (bf16*)WSP(WS_WOUT);
        float* tcos = (float*)WSP(WS_COS); float* tsin = (float*)WSP(WS_SIN); bf16* XB = (bf16*)WSP(WS_XB);
        LAS float* scr = (LAS float*)(ldsl + wave * 16384);
        constexpr int I_QKV = (D / 64) * (3 * D / 32), I_O = (D / 64) * (D / 32), I_UP = (D / 64) * (FF2 / 32), I_DN = (FF / 64) * (D / 32);
        constexpr int NITEMS = 2 * I_QKV + 2 * I_O + 2 * I_UP + 2 * I_DN;
        for (int it = gw; it < NITEMS; it += NGW) {
            int r = it;
            if (r < I_QKV) { transpose_item(a->w_qkv, D, 3 * D, Wqkv_t, a->attn_g, 1, scr, r, lane); continue; } r -= I_QKV;
            if (r < I_QKV) { transpose_item(a->w_in, D, 3 * D, Win_t, a->conv_g, 3, scr, r, lane); continue; } r -= I_QKV;
            if (r < I_O) { transpose_item(a->w_o, D, D, Wo_t, nullptr, 0, scr, r, lane); continue; } r -= I_O;
            if (r < I_O) { transpose_item(a->w_out, D, D, Wout_t, nullptr, 0, scr, r, lane); continue; } r -= I_O;
            if (r < I_UP) { transpose_item(a->w_up, D, FF2, WUP_T(0), a->ffn_g, 2, scr, r, lane); continue; } r -= I_UP;
            if (r < I_UP) { transpose_item(a->w_up + (size_t)D * FF2, D, FF2, WUP_T(1), a->ffn_g + D, 2, scr, r, lane); continue; } r -= I_UP;
            if (r < I_DN) { transpose_item(a->w_dn, FF, D, WDN_T(0), nullptr, 0, scr, r, lane); continue; } r -= I_DN;
            transpose_item(a->w_dn + (size_t)FF * D, FF, D, WDN_T(1), nullptr, 0, scr, r, lane);
        }
        const int* pos = a->pos;
        for (int i = gtid; i < M * 32; i += NT) {
            const int d = i & 31; const float inv = __builtin_amdgcn_exp2f(-(float)d * (13.287712379549449f / 32.0f));
            float s, c; sincos_cw((float)pos[i >> 5] * inv, s, c); tcos[i] = c; tsin[i] = s;
        }
        const float* x = a->x; float* ssq0 = SSQ(0);
        for (int rg = gw; rg < M / 16; rg += NGW) {
            const int row = rg * 16 + (lane >> 2); const float* xr = x + (size_t)row * D + (lane & 3) * 8; bf16* tb = XB + (size_t)rg * (32 * 512) + lane * 8; float s = 0.f;
#pragma unroll 8
            for (int ct = 0; ct < 32; ++ct) { const f32x4 p = *(const f32x4*)(xr + ct * 32), q = *(const f32x4*)(xr + ct * 32 + 4);
                s += ((p.x * p.x + p.y * p.y) + (p.z * p.z + p.w * p.w)) + ((q.x * q.x + q.y * q.y) + (q.z * q.z + q.w * q.w));
                v4u o; o.x = pk2(p.x, p.y); o.y = pk2(p.z, p.w); o.z = pk2(q.x, q.y); o.w = pk2(q.z, q.w); *(v4u*)(tb + ct * 512) = o; }
            s = lane_xor_add<1>(s); s = lane_xor_add<2>(s);
            *(f32x4*)(ssq0 + (size_t)row * 16 + 4 * (lane & 3)) = (f32x4){(lane & 3) == 0 ? s : 0.f, 0.f, 0.f, 0.f};
        }
    }
    grid.sync();
    XcdBarrier bar = xcd_barrier_post((unsigned*)(get_args()->ws + WS_CTL), bst);

#ifdef PROBE_SYNC
    for (int rep = 0; rep < PROBE_SYNC; ++rep) GRID_SYNC();
#endif
    {
        CArgs a = get_args();
        pg8::Gemm g{(bf16*)WSP(WS_XB), (bf16*)WSP(WS_WQKV), M, 3 * D, D}; pg8::StaticOrder S; S.init(M, 3 * D, gridDim.x, opaque_bx());
        pg8::EpiRope E{(bf16*)WSP(WS_Q), (bf16*)WSP(WS_K), (bf16*)WSP(WS_V), SSQ(0), (float*)WSP(WS_COS), (float*)WSP(WS_SIN), 0.125f * 1.4426950408889634f};
        stagger_start(STAGGER_TICKS);
        for (int rep = 0; rep < PROBE_QKV; ++rep) pg8::gemm_phase<pg8::EpiRope, pg8::StaticOrder, true, true>(ldsl, g, S, E);
#ifdef PROBE_STORE
        { pg8::EpiStoreOnly EN{(bf16*)WSP(WS_O), 2048, 8}; pg8::gemm_phase<pg8::EpiStoreOnly, pg8::StaticOrder, true, true>(ldsl, g, S, EN); }
#endif
#ifdef PROBE_LOAD
        { pg8::EpiLoadOnly EN{(float*)WSP(WS_STASH), SSQ(0), (float*)WSP(WS_COS), (float*)WSP(WS_SIN)}; pg8::gemm_phase<pg8::EpiLoadOnly, pg8::StaticOrder, true, true>(ldsl, g, S, EN); }
#endif
#ifdef PROBE_KLOOP
        { pg8::EpiNull EN{(float*)WSP(WS_STASH)}; pg8::gemm_phase<pg8::EpiNull, pg8::StaticOrder, true, true>(ldsl, g, S, EN); }
#endif
    }
    GRID_SYNC();
    {
        CArgs a = get_args(); GEO();
        const float lambda_init = 0.8f - 0.6f * 1.0f;
        const float s1 = wave_sum(a->lq1[lane] * a->lk1[lane]), s2 = wave_sum(a->lq2[lane] * a->lk2[lane]);
        const float lam = __expf(s1) - __expf(s2) + lambda_init;
        const bf16* Qb = (const bf16*)WSP(WS_Q); const bf16* Kb = (const bf16*)WSP(WS_K); const bf16* Vb = (const bf16*)WSP(WS_V); bf16* Ob = (bf16*)WSP(WS_O);
        float* stash = (float*)WSP(WS_STASH); const float* subg = a->subg;
#pragma unroll 1
        for (int rep = 0; rep < PROBE_ATTN; ++rep)
#pragma unroll 1
        for (int i = 0;; ++i) {
            const int id = i * G + vcu; if (id >= BATCH * NH * (SEQ / 256)) break;
            const int bh = id >> 3, qb = id & 7;
            att::attn_unit(bh >> 3, bh & 7, qb, Qb, Kb, Vb, Ob, stash, lam, subg, 1.0f - lambda_init, (char*)lds);
        }
    }
    GRID_SYNC();
    {
        CArgs a = get_args();
        pg8::Gemm g{(bf16*)WSP(WS_O), (bf16*)WSP(WS_WO), M, D, D}; pg8::StaticOrder S; S.init(M, D, gridDim.x, opaque_bx());
        pg8::EpiRes<false> E{nullptr, (bf16*)WSP(WS_XB), SSQ(1)};
        pg8::gemm_phase<pg8::EpiRes<false>, pg8::StaticOrder, true, true>(ldsl, g, S, E);
    }
    GRID_SYNC();
#pragma unroll 1
    for (int layer = 0; layer < 2; ++layer) {
        if (layer == 1) {
            {   CArgs a = get_args();
                pg8::Gemm g{(bf16*)WSP(WS_XB), (bf16*)WSP(WS_WIN), M, 3 * D, D}; pg8::StaticOrder S; S.init(M, 3 * D, gridDim.x, opaque_bx());
                pg8::EpiMix E{(bf16*)WSP(WS_Q), (bf16*)WSP(WS_K), SSQ(2)};
                pg8::gemm_phase<pg8::EpiMix, pg8::StaticOrder, true, true>(ldsl, g, S, E); }
            GRID_SYNC();
            {   CArgs a = get_args(); GEO();
                mixer_ew_phase((const bf16*)WSP(WS_Q), (const bf16*)WSP(WS_K), (bf16*)WSP(WS_O), a->conv_w, gtid, NT); }
            GRID_SYNC();
            {   CArgs a = get_args();
                pg8::Gemm g{(bf16*)WSP(WS_O), (bf16*)WSP(WS_WOUT), M, D, D}; pg8::StaticOrder S; S.init(M, D, gridDim.x, opaque_bx());
                pg8::EpiRes<false> E{nullptr, (bf16*)WSP(WS_XB), SSQ(3)};
                pg8::gemm_phase<pg8::EpiRes<false>, pg8::StaticOrder, true, true>(ldsl, g, S, E); }
            GRID_SYNC();
        }
        {   CArgs a = get_args();
            pg8::Gemm g{(bf16*)WSP(WS_XB), WUP_T(layer), M, FF2, D}; pg8::StaticOrder S; S.init(M, FF2, gridDim.x, opaque_bx());
            pg8::EpiFfn E{(bf16*)WSP(WS_G), SSQ(layer == 0 ? 1 : 3), a->ffn_cw + (size_t)layer * 3 * FF2, a->ffn_cb + (size_t)layer * FF2, (float*)WSP(WS_HU), (float*)WSP(WS_HP), ldsl + 131072};
            stagger_start(STAGGER_TICKS);
            for (int rep = 0; rep < PROBE_UP; ++rep) pg8::gemm_phase<pg8::EpiFfn, pg8::StaticOrder, true, true>(ldsl, g, S, E); }
        GRID_SYNC();
        {   CArgs a = get_args();
            pg8::Gemm g{(bf16*)WSP(WS_G), WDN_T(layer), M, D, FF}; pg8::StaticOrder S; S.init(M, D, gridDim.x, opaque_bx());
            {   int tid = threadIdx.x; asm volatile("" : "+v"(tid));
                const float* cwl = a->ffn_cw + (size_t)layer * 3 * FF2;
#pragma unroll 1
                for (int i = 0;; ++i) { pg8::Unit u; if (!S.next(i, u)) break; ffn_fix_rows(u.pm, (bf16*)WSP(WS_G), (const float*)WSP(WS_HU), (const float*)WSP(WS_HP), cwl, tid); }
                __threadfence(); __syncthreads(); }
#ifdef PROBE_DOWN
            { pg8::EpiNull EN{(float*)WSP(WS_STASH)}; pg8::gemm_phase<pg8::EpiNull, pg8::StaticOrder, true, true>(ldsl, g, S, EN); }
#endif
            pg8::EpiRes<false> E{nullptr, (bf16*)WSP(WS_XB), SSQ(layer == 0 ? 2 : 4)};
            pg8::gemm_phase<pg8::EpiRes<false>, pg8::StaticOrder, true, true>(ldsl, g, S, E); }
        GRID_SYNC();
    }
    {   CArgs a = get_args(); GEO();
        float* out = a->out; const float* fg = a->fin_g; const float* ssq4 = SSQ(4); const bf16* XB = (const bf16*)WSP(WS_XB);
        for (int rg = gw; rg < M / 16; rg += NGW) {
            const int row = rg * 16 + (lane >> 2); const float rs = pg8::row_rstd(ssq4, row);
            const bf16* tb = XB + (size_t)rg * (32 * 512) + lane * 8; float* ob = out + (size_t)row * D + (lane & 3) * 8; const float* gp = fg + (lane & 3) * 8;
#pragma unroll 8
            for (int ct = 0; ct < 32; ++ct) { const v4u q = *(const v4u*)(tb + ct * 512); const f32x4 g0 = *(const f32x4*)(gp + ct * 32), g1 = *(const f32x4*)(gp + ct * 32 + 4);
                *(f32x4*)(ob + ct * 32) = (f32x4){bflo(q.x), bfhi(q.x), bflo(q.y), bfhi(q.y)} * rs * g0; *(f32x4*)(ob + ct * 32 + 4) = (f32x4){bflo(q.z), bfhi(q.z), bflo(q.w), bfhi(q.w)} * rs * g1; }
        }
    }
}

extern "C" void kernel_launch(void* const* d_in, const int* in_sizes, int n_in, void* d_out, int out_size, void* d_ws, size_t ws_size, hipStream_t stream) {
    static int grid = 0;
    if (grid == 0) {
        if (n_in != 20 || in_sizes[0] != M * D || out_size != M * D || ws_size < WS_END) { fprintf(stderr, "kernel_launch: shape mismatch n_in %d in0 %d out %d ws %zu\n", n_in, n_in > 0 ? in_sizes[0] : -1, out_size, ws_size); grid = -1; return; }
        int dev = 0, cus = 0, per_cu = 0;
        if (hipGetDevice(&dev) != hipSuccess || hipDeviceGetAttribute(&cus, hipDeviceAttributeMultiprocessorCount, dev) != hipSuccess) { grid = -1; return; }
        if (hipFuncSetAttribute((const void*)mega_fwd, hipFuncAttributeMaxDynamicSharedMemorySize, LDS_BYTES) != hipSuccess) { fprintf(stderr, "kernel_launch: hipFuncSetAttribute failed\n"); grid = -1; return; }
        if (hipOccupancyMaxActiveBlocksPerMultiprocessor(&per_cu, (const void*)mega_fwd, NTHR, LDS_BYTES) != hipSuccess || per_cu < 1) { fprintf(stderr, "kernel_launch: occupancy query says %d\n", per_cu); per_cu = 1; }
        (void)hipGetLastError();
        grid = cus;
    }
    if (grid < 0) return;
    Args a{};
    a.x = (const float*)d_in[0]; a.pos = (const int*)d_in[1];
    a.attn_g = (const float*)d_in[2]; a.w_qkv = (const float*)d_in[3]; a.lq1 = (const float*)d_in[4]; a.lk1 = (const float*)d_in[5]; a.lq2 = (const float*)d_in[6]; a.lk2 = (const float*)d_in[7];
    a.subg = (const float*)d_in[8]; a.w_o = (const float*)d_in[9]; a.conv_g = (const float*)d_in[10]; a.w_in = (const float*)d_in[11]; a.conv_w = (const float*)d_in[12]; a.w_out = (const float*)d_in[13];
    a.ffn_g = (const float*)d_in[14]; a.w_up = (const float*)d_in[15]; a.ffn_cw = (const float*)d_in[16]; a.ffn_cb = (const float*)d_in[17]; a.w_dn = (const float*)d_in[18]; a.fin_g = (const float*)d_in[19];
    a.out = (float*)d_out; a.ws = (unsigned char*)d_ws;
    void* args[] = {&a};
    const hipError_t e = hipLaunchCooperativeKernel((const void*)mega_fwd, dim3(grid), dim3(NTHR), args, LDS_BYTES, stream);
    if (e != hipSuccess) fprintf(stderr, "kernel_launch: cooperative launch failed: %s (grid %d)\n", hipGetErrorString(e), grid);
}
```

```cpp
#include <hip/hip_runtime.h>
#include <hip/hip_cooperative_groups.h>
#include <cstdio>
#include <cstdint>

template <int MASK> __device__ __forceinline__ float lane_xor_add(float x) {
    if constexpr (MASK == 32) {
        int l = (int)__builtin_amdgcn_mbcnt_hi(~0u, __builtin_amdgcn_mbcnt_lo(~0u, 0u)); asm volatile("" : "+v"(l));
        return x + __builtin_bit_cast(float, __builtin_amdgcn_ds_bpermute((l ^ 32) << 2, __builtin_bit_cast(int, x))); }
    else return x + __builtin_bit_cast(float, __builtin_amdgcn_ds_swizzle(__builtin_bit_cast(int, x), (MASK << 10) | 0x1F));
}
#ifndef DPP_PREV
#define DPP_PREV 0x121
#define DPP_NEXT 0x12F
#endif
#ifndef USE_NT
#define USE_NT 0
#endif
#if USE_NT
#define NT_STORE(v, p) __builtin_nontemporal_store((v), (p))
#else
#define NT_STORE(v, p) (*(p) = (v))
#endif
#ifndef QKV_LD
#define QKV_LD 1088
#endif
__device__ __forceinline__ size_t tiled(int row, int col, int nct) { return (((size_t)(row >> 4) * nct + (col >> 5)) << 9) + ((row & 15) << 5) + (col & 31); }
namespace pg8 {
#define PG8_LAS __attribute__((address_space(3)))
typedef unsigned short bf16_t;
typedef short bf16x8 __attribute__((ext_vector_type(8)));
typedef float f32x4 __attribute__((ext_vector_type(4)));
typedef unsigned u32x4 __attribute__((ext_vector_type(4)));
constexpr int BM = 256, BK = 64, HALF = 128, HTB = HALF * BK * 2  , STAGE_BYTES = 8 * HTB, NXCD = 8, WGM = 8;

__host__ __device__ __forceinline__ int lds_byte(int r, int c) { const int st = (r >> 4) * 2 + (c >> 5), rr = r & 15, cc = c & 31, ob = rr * 64 + cc * 2; return st * 1024 + (ob ^ (((ob >> 9) & 1) << 5)); }
__host__ __device__ __forceinline__ void stage_rc(int b, int& R, int& C) { const int st = b / 1024, sb = b % 1024, swz = sb ^ (((sb >> 9) & 1) << 5); R = (st >> 1) * 16 + swz / 64; C = (st & 1) * 32 + (swz % 64) / 2; }
__host__ __device__ __forceinline__ int perm32(int rho) { const int n = rho >> 4, i = rho & 15; return 8 * (i >> 2) + 4 * n + (i & 3); }

struct Unit { int pm, pn; };
struct Gemm { const bf16_t* A; const bf16_t* Bt; int M, N, K; };

struct StaticOrder {
    int nM, nN, nwg, G, c;
    __host__ __device__ void init(int M, int N, int G_, int c_) { nM = M / BM; nN = N / BM; nwg = nM * nN; G = G_; c = c_; }
    __host__ __device__ bool next(int i, Unit& u) const {
        const long L = (long)i * G + c; if (L >= nwg) return false;
        int wgid = (int)L; { const int q = nwg / NXCD, r = nwg % NXCD, xcd = wgid % NXCD, off = wgid / NXCD; wgid = (xcd < r ? xcd * (q + 1) : r * (q + 1) + (xcd - r) * q) + off; }
        const int nig = WGM * nN, gid = wgid / nig, fm = gid * WGM, gsz = (nM - fm) < WGM ? (nM - fm) : WGM;
        u.pm = fm + ((wgid % nig) % gsz); u.pn = (wgid % nig) / gsz; return true;
    }
    __device__ __forceinline__ void a_ready(const Unit&) const {}
    __device__ __forceinline__ void done(const Unit&) const {}
};

__device__ __forceinline__ unsigned cvt_pk_bf16(float lo, float hi) { unsigned r; asm volatile("v_cvt_pk_bf16_f32 %0, %1, %2" : "=v"(r) : "v"(lo), "v"(hi)); return r; }
typedef float f32x2 __attribute__((ext_vector_type(2)));

__device__ __forceinline__ float row_rstd(const float* ssq, int row) {
    const f32x4* p = (const f32x4*)(ssq + (size_t)row * 16);
    const f32x4 a = p[0], b = p[1], c = p[2], d = p[3];
    const float s = (((a[0] + a[1]) + (a[2] + a[3])) + ((b[0] + b[1]) + (b[2] + b[3]))) + (((c[0] + c[1]) + (c[2] + c[3])) + ((d[0] + d[1]) + (d[2] + d[3])));
    return __builtin_amdgcn_rsqf(s * (1.0f / 1024.0f) + 1e-5f);
}
__device__ __forceinline__ void rows_rstd(const float* ssq, int row0, int fq, float (&rs)[2][4]) {
    f32x4 p[2][4];
#pragma unroll
    for (int ai = 0; ai < 2; ++ai)
#pragma unroll
        for (int m = 0; m < 4; ++m) p[ai][m] = *(const f32x4*)(ssq + (size_t)(row0 + ai * HALF + m * 16) * 16 + 4 * fq);
#pragma unroll
    for (int ai = 0; ai < 2; ++ai)
#pragma unroll
        for (int m = 0; m < 4; ++m) { float s = (p[ai][m][0] + p[ai][m][1]) + (p[ai][m][2] + p[ai][m][3]); s = lane_xor_add<16>(s); s = lane_xor_add<32>(s);
            rs[ai][m] = __builtin_amdgcn_rsqf(s * (1.0f / 1024.0f) + 1e-5f); }
}
struct EpiRope {
    static constexpr bool PERM = true, AFTER_DRAIN = false;
    bf16_t* Q; bf16_t* K; bf16_t* V; const float* ssq; const float* tcos; const float* tsin; float qscale;
    __device__ __forceinline__ void operator()(const f32x4 (&acc)[2][2][4][2], const Unit& u, int wr, int wc, int fr, int fq) const {
        const int t = u.pn >> 2;
        const int colt = (u.pn & 3) * BM + wc * 32 + 8 * fq;
        const int row0 = u.pm * BM + wr * 64 + fr;
        const int fi = 4 * ((wc & 1) * 4 + fq);
        float rs[2][4]; rows_rstd(ssq, row0, fq, rs);
        if (t < 2) {
            bf16_t* base = (t == 0) ? Q : K; const float sc = (t == 0) ? qscale : 1.f;
#pragma unroll
            for (int ai = 0; ai < 2; ++ai) {
                f32x4 c4[4], s4[4];
#pragma unroll
                for (int m = 0; m < 4; ++m) { const int row = row0 + ai * HALF + m * 16; c4[m] = *(const f32x4*)(tcos + (size_t)row * 32 + fi); s4[m] = *(const f32x4*)(tsin + (size_t)row * 32 + fi); }
#pragma unroll
                for (int m = 0; m < 4; ++m) {
                    const int row = row0 + ai * HALF + m * 16;
                    const float k = rs[ai][m] * sc;
                    bf16_t* rowp = base + ((size_t)(row >> 4) * 32 + (colt >> 5)) * 512 + (row & 15) * 32 + (colt & 31);
#pragma unroll
                    for (int bj = 0; bj < 2; ++bj) {
                        const f32x4 x1 = acc[ai][bj][m][0] * k, x2 = acc[ai][bj][m][1] * k;
                        const f32x4 y1 = x1 * c4[m] - x2 * s4[m], y2 = x2 * c4[m] + x1 * s4[m];
                        u32x4 w; w.x = cvt_pk_bf16(y1[0], y1[1]); w.y = cvt_pk_bf16(y1[2], y1[3]); w.z = cvt_pk_bf16(y2[0], y2[1]); w.w = cvt_pk_bf16(y2[2], y2[3]);
                        NT_STORE(w, (u32x4*)(rowp + bj * 2048));
                    }
                }
                __builtin_amdgcn_sched_barrier(0);
            }
        } else {
#pragma unroll
            for (int ai = 0; ai < 2; ++ai)
#pragma unroll
                for (int m = 0; m < 4; ++m) {
                    const int row = row0 + ai * HALF + m * 16;
                    const float k = rs[ai][m];
                    bf16_t* rowp = V + ((size_t)(row >> 4) * 32 + (colt >> 5)) * 512 + (row & 15) * 32 + (colt & 31);
#pragma unroll
                    for (int bj = 0; bj < 2; ++bj) {
                        const f32x4 v0 = acc[ai][bj][m][0] * k, v1 = acc[ai][bj][m][1] * k;
                        u32x4 w; w.x = cvt_pk_bf16(v0[0], v0[1]); w.y = cvt_pk_bf16(v0[2], v0[3]); w.z = cvt_pk_bf16(v1[0], v1[1]); w.w = cvt_pk_bf16(v1[2], v1[3]);
                        NT_STORE(w, (u32x4*)(rowp + bj * 2048));
                    }
                }
        }
    }
};
struct EpiScale {
    static constexpr bool PERM = true, AFTER_DRAIN = false;
    bf16_t* O; int ldc; const float* ssq; int row_off;
    __device__ __forceinline__ void operator()(const f32x4 (&acc)[2][2][4][2], const Unit& u, int wr, int wc, int fr, int fq) const {
        const int row0 = u.pm * BM + wr * 64 + fr, col0 = u.pn * BM + wc * 32 + 8 * fq;
        float rs[2][4]; rows_rstd(ssq, row_off + row0, fq, rs);
#pragma unroll
        for (int ai = 0; ai < 2; ++ai)
#pragma unroll
            for (int m = 0; m < 4; ++m) {
                const int row = row0 + ai * HALF + m * 16;
                const float k = rs[ai][m];
                bf16_t* rowp = O + tiled(row, col0, ldc >> 5);
#pragma unroll
                for (int bj = 0; bj < 2; ++bj) {
                    const f32x4 v0 = acc[ai][bj][m][0] * k, v1 = acc[ai][bj][m][1] * k;
                    u32x4 w; w.x = cvt_pk_bf16(v0[0], v0[1]); w.y = cvt_pk_bf16(v0[2], v0[3]); w.z = cvt_pk_bf16(v1[0], v1[1]); w.w = cvt_pk_bf16(v1[2], v1[3]);
                    NT_STORE(w, (u32x4*)(rowp + bj * 2048));
                }
            }
    }
};
struct EpiMix {
    static constexpr bool PERM = true, AFTER_DRAIN = false;
    bf16_t* CU; bf16_t* Bq; const float* ssq;
    __device__ __forceinline__ void operator()(const f32x4 (&acc)[2][2][4][2], const Unit& u, int wr, int wc, int fr, int fq) const {
        typedef unsigned u32x2m __attribute__((ext_vector_type(2)));
        const int row0 = u.pm * BM + wr * 64 + fr;
        float rs[2][4]; rows_rstd(ssq, row0, fq, rs);
        if (u.pn < 8) {
            const int f0 = u.pn * 128 + wc * 32 + 8 * fq;
#pragma unroll
            for (int ai = 0; ai < 2; ++ai)
#pragma unroll
                for (int m = 0; m < 4; ++m) { const int row = row0 + ai * HALF + m * 16; const float r2 = rs[ai][m] * rs[ai][m];
                    const f32x4 p0 = acc[ai][0][m][0] * acc[ai][0][m][1] * r2, p1 = acc[ai][1][m][0] * acc[ai][1][m][1] * r2;
                    u32x4 w; w.x = cvt_pk_bf16(p0[0], p0[1]); w.y = cvt_pk_bf16(p0[2], p0[3]); w.z = cvt_pk_bf16(p1[0], p1[1]); w.w = cvt_pk_bf16(p1[2], p1[3]);
                    *(u32x4*)(CU + tiled(row, f0, 32)) = w; }
        } else {
            const int col0 = (u.pn - 8) * BM + wc * 32 + 8 * fq;
#pragma unroll
            for (int ai = 0; ai < 2; ++ai)
#pragma unroll
                for (int m = 0; m < 4; ++m) { const int row = row0 + ai * HALF + m * 16; const float k = rs[ai][m]; bf16_t* rowp = Bq + tiled(row, col0, 32);
#pragma unroll
                    for (int bj = 0; bj < 2; ++bj) { const f32x4 v0 = acc[ai][bj][m][0] * k, v1 = acc[ai][bj][m][1] * k;
                        u32x4 w; w.x = cvt_pk_bf16(v0[0], v0[1]); w.y = cvt_pk_bf16(v0[2], v0[3]); w.z = cvt_pk_bf16(v1[0], v1[1]); w.w = cvt_pk_bf16(v1[2], v1[3]);
                        *(u32x4*)(rowp + bj * 2048) = w; } }
        }
    }
};
template <bool BASE_F32> struct EpiRes {
    static constexpr bool PERM = true, AFTER_DRAIN = false;
    const float* basef; bf16_t* xb; float* ssq_out;
    __device__ __forceinline__ void operator()(const f32x4 (&acc)[2][2][4][2], const Unit& u, int wr, int wc, int fr, int fq) const {
        const int row0 = u.pm * BM + wr * 64 + fr, col0 = u.pn * BM + wc * 32 + 8 * fq;
#pragma unroll
        for (int ai = 0; ai < 2; ++ai) {
            f32x4 bf[BASE_F32 ? 4 : 1][2][2]; u32x4 bb[BASE_F32 ? 1 : 4][2];
#pragma unroll
            for (int m = 0; m < 4; ++m) { const size_t off = (size_t)(row0 + ai * HALF + m * 16) * 1024 + col0, toff = tiled(row0 + ai * HALF + m * 16, col0, 32);
#pragma unroll
                for (int bj = 0; bj < 2; ++bj) {
                    if constexpr (BASE_F32) { bf[m][bj][0] = *(const f32x4*)(basef + off + bj * HALF); bf[m][bj][1] = *(const f32x4*)(basef + off + bj * HALF + 4); }
                    else bb[m][bj] = *(const u32x4*)(xb + toff + bj * 2048); } }
#pragma unroll
            for (int m = 0; m < 4; ++m) {
                const int row = row0 + ai * HALF + m * 16; const size_t toff = tiled(row, col0, 32); float ss = 0.f;
#pragma unroll
                for (int bj = 0; bj < 2; ++bj) {
                    f32x4 b0, b1;
                    if constexpr (BASE_F32) { b0 = bf[m][bj][0]; b1 = bf[m][bj][1]; }
                    else { const u32x4 w = bb[m][bj];
                        b0 = (f32x4){__builtin_bit_cast(float, w.x << 16), __builtin_bit_cast(float, w.x & 0xffff0000u), __builtin_bit_cast(float, w.y << 16), __builtin_bit_cast(float, w.y & 0xffff0000u)};
                        b1 = (f32x4){__builtin_bit_cast(float, w.z << 16), __builtin_bit_cast(float, w.z & 0xffff0000u), __builtin_bit_cast(float, w.w << 16), __builtin_bit_cast(float, w.w & 0xffff0000u)}; }
                    const f32x4 o0 = b0 + acc[ai][bj][m][0], o1 = b1 + acc[ai][bj][m][1];
                    ss += ((o0[0] * o0[0] + o0[1] * o0[1]) + (o0[2] * o0[2] + o0[3] * o0[3])) + ((o1[0] * o1[0] + o1[1] * o1[1]) + (o1[2] * o1[2] + o1[3] * o1[3]));
                    u32x4 w; w.x = cvt_pk_bf16(o0[0], o0[1]); w.y = cvt_pk_bf16(o0[2], o0[3]); w.z = cvt_pk_bf16(o1[0], o1[1]); w.w = cvt_pk_bf16(o1[2], o1[3]);
                    NT_STORE(w, (u32x4*)(xb + toff + bj * 2048));
                }
                ss = lane_xor_add<16>(ss); ss = lane_xor_add<32>(ss);
                if (fq == 0) ssq_out[(size_t)row * 16 + u.pn * 4 + wc] = ss;
            }
        }
    }
};
__device__ __forceinline__ float dpp_ror1_f(float x) { return __builtin_bit_cast(float, __builtin_amdgcn_update_dpp(0, __builtin_bit_cast(int, x), DPP_PREV, 0xF, 0xF, true)); }
__device__ __forceinline__ float dpp_ror15_f(float x) { return __builtin_bit_cast(float, __builtin_amdgcn_update_dpp(0, __builtin_bit_cast(int, x), DPP_NEXT, 0xF, 0xF, true)); }
__device__ __forceinline__ f32x4 dpp_ror1(f32x4 v) { f32x4 r; r.x = dpp_ror1_f(v.x); r.y = dpp_ror1_f(v.y); r.z = dpp_ror1_f(v.z); r.w = dpp_ror1_f(v.w); return r; }
__device__ __forceinline__ f32x4 dpp_ror15(f32x4 v) { f32x4 r; r.x = dpp_ror15_f(v.x); r.y = dpp_ror15_f(v.y); r.z = dpp_ror15_f(v.z); r.w = dpp_ror15_f(v.w); return r; }
__device__ __forceinline__ f32x4 sel4(bool c, f32x4 a, f32x4 b) { return (f32x4){c ? a[0] : b[0], c ? a[1] : b[1], c ? a[2] : b[2], c ? a[3] : b[3]}; }
__device__ __forceinline__ float silu_f(float g) { return g * __builtin_amdgcn_rcpf(1.f + __builtin_amdgcn_exp2f(-1.4426950408889634f * g)); }
struct EpiFfn {
    static constexpr bool PERM = true, AFTER_DRAIN = false;
    bf16_t* G; const float* ssq; const float* cw; const float* cb; float* HU; float* HP; PG8_LAS unsigned char* ex;
    __device__ __forceinline__ void operator()(f32x4 (&acc)[2][2][4][2], const Unit& u, int wr, int wc, int fr_in, int fq_in) const {
        typedef unsigned u32x2e __attribute__((ext_vector_type(2)));
        int t_ = threadIdx.x; asm volatile("" : "+v"(t_)); const int fr = t_ & 15, fq = (t_ >> 4) & 3; (void)fr_in; (void)fq_in;
        constexpr int FFc = 2816, FF2c = 5632;
        const int row0 = u.pm * BM + wr * 64 + fr;
        const bool is_first = (fr == 0), is_last = (fr == 15);
        PG8_LAS float* RS = (PG8_LAS float*)(ex + 8192); PG8_LAS float* CWL = (PG8_LAS float*)(ex + 8192 + 1024);
        {
            const int t = t_ & 511;
            if (t < 256) {
                const f32x4* p = (const f32x4*)(ssq + (size_t)(u.pm * BM + t) * 16);
                const f32x4 a = p[0], b = p[1], c = p[2], d = p[3];
                const float s = (((a[0] + a[1]) + (a[2] + a[3])) + ((b[0] + b[1]) + (b[2] + b[3]))) + (((c[0] + c[1]) + (c[2] + c[3])) + ((d[0] + d[1]) + (d[2] + d[3])));
                RS[t] = __builtin_amdgcn_rsqf(s * (1.0f / 1024.0f) + 1e-5f);
            } else {
                const int q = t - 256, p = q >> 6, jq = q & 63, n = jq & 1, wq = (jq >> 1) & 15, bjj = jq >> 5;
                const float* src = (p < 3) ? (cw + (size_t)p * FF2c) : cb;
                *(PG8_LAS f32x4*)(CWL + p * 256 + 4 * jq) = *(const f32x4*)(src + n * FFc + u.pn * 128 + 8 * wq + 4 * bjj);
            }
        }
        asm volatile("s_waitcnt lgkmcnt(0)" ::: "memory"); __builtin_amdgcn_s_barrier(); asm volatile("" ::: "memory");
#pragma unroll
        for (int ai = 0; ai < 2; ++ai)
#pragma unroll
            for (int m = 0; m < 4; ++m) { const float r = RS[wr * 64 + fr + ai * HALF + m * 16];
#pragma unroll
                for (int bj = 0; bj < 2; ++bj)
#pragma unroll
                    for (int n = 0; n < 2; ++n) acc[ai][bj][m][n] = acc[ai][bj][m][n] * r; }
        PG8_LAS float* EX = (PG8_LAS float*)ex;
        const int cj = wc * 32 + 8 * fq;
#pragma unroll
        for (int ai = 0; ai < 2; ++ai)
#pragma unroll
            for (int bj = 0; bj < 2; ++bj)
#pragma unroll
                for (int n = 0; n < 2; ++n) {
                    if (is_first) *(PG8_LAS f32x4*)(EX + ((ai * 2 + wr) * 2 + 0) * 256 + bj * 128 + cj + 4 * n) = acc[ai][bj][0][n];
                    if (is_last)  *(PG8_LAS f32x4*)(EX + ((ai * 2 + wr) * 2 + 1) * 256 + bj * 128 + cj + 4 * n) = acc[ai][bj][3][n];
                }
        asm volatile("s_waitcnt lgkmcnt(0)" ::: "memory"); __builtin_amdgcn_s_barrier(); asm volatile("" ::: "memory");
        const int f0 = u.pn * 128 + wc * 32 + 8 * fq;
        const f32x4 zero4 = {0.f, 0.f, 0.f, 0.f};
#pragma unroll
        for (int ai = 0; ai < 2; ++ai) {
            const int g = ai * 2 + wr;
            unsigned park[4][2];
#pragma unroll
            for (int bj = 0; bj < 2; ++bj) {
#pragma unroll
                for (int n = 0; n < 2; ++n) {
                    f32x4 wgt[4];
#pragma unroll
                    for (int j = 0; j < 4; ++j) wgt[j] = *(const PG8_LAS f32x4*)(CWL + j * 256 + bj * 128 + cj + 4 * n);
                    const f32x4 hp = (g == 0) ? zero4 : *(const PG8_LAS f32x4*)(EX + ((g - 1) * 2 + 1) * 256 + bj * 128 + cj + 4 * n);
                    const f32x4 hn = (g == 3) ? zero4 : *(const PG8_LAS f32x4*)(EX + ((g + 1) * 2 + 0) * 256 + bj * 128 + cj + 4 * n);
                    f32x4 r1p = hp, r15c = dpp_ror15(acc[ai][bj][0][n]);
#pragma unroll
                    for (int m = 0; m < 4; ++m) {
                        const f32x4 X = acc[ai][bj][m][n];
                        const f32x4 r1m = dpp_ror1(X);
                        const f32x4 prev = sel4(is_first, r1p, r1m); r1p = r1m;
                        const f32x4 r15n = (m < 3) ? dpp_ror15(acc[ai][bj][m < 3 ? m + 1 : 3][n]) : hn;
                        const f32x4 next = sel4(is_last, r15n, r15c); r15c = r15n;
                        const f32x4 Y = wgt[0] * prev + (wgt[1] * X + (wgt[2] * next + wgt[3]));
                        if (m == 0) { if (g == 0 && is_first) { int co = cj; asm volatile("" : "+v"(co)); const size_t hb = ((size_t)u.pm * 2 + 0) * FF2c + u.pn * 256 + bj * 128 + co + 4 * n; *(f32x4*)(HU + hb) = X; *(f32x4*)(HP + hb) = Y; } }
                        if (m == 3) { if (g == 3 && is_last) { int co = cj; asm volatile("" : "+v"(co)); const size_t hb = ((size_t)u.pm * 2 + 1) * FF2c + u.pn * 256 + bj * 128 + co + 4 * n; *(f32x4*)(HU + hb) = X; *(f32x4*)(HP + hb) = Y; } }
                        if (n == 0) acc[ai][bj][m][0] = (f32x4){silu_f(Y[0]), silu_f(Y[1]), silu_f(Y[2]), silu_f(Y[3])};
                        else { const f32x4 o = acc[ai][bj][m][0] * Y; const unsigned wl = cvt_pk_bf16(o[0], o[1]), wh = cvt_pk_bf16(o[2], o[3]);
                            if (bj == 0) { park[m][0] = wl; park[m][1] = wh; }
                            else { u32x4 w; w.x = park[m][0]; w.y = park[m][1]; w.z = wl; w.w = wh; NT_STORE(w, (u32x4*)(G + tiled(row0 + ai * HALF + m * 16, f0, FFc >> 5))); } }
                    }
                    __builtin_amdgcn_sched_barrier(0);
                }
            }
        }
    }
};
struct EpiNull {
    static constexpr bool PERM = true, AFTER_DRAIN = false;
    float* sink;
    __device__ __forceinline__ void operator()(const f32x4 (&acc)[2][2][4][2], const Unit& u, int wr, int wc, int fr, int fq) const {
        float s = 0.f;
#pragma unroll
        for (int ai = 0; ai < 2; ++ai)
#pragma unroll
            for (int bj = 0; bj < 2; ++bj)
#pragma unroll
                for (int m = 0; m < 4; ++m)
#pragma unroll
                    for (int n = 0; n < 2; ++n) s += (acc[ai][bj][m][n][0] + acc[ai][bj][m][n][1]) + (acc[ai][bj][m][n][2] + acc[ai][bj][m][n][3]);
        if (s == 1.2345678e30f) sink[0] = s;
    }
};

struct EpiStoreOnly {
    static constexpr bool PERM = true, AFTER_DRAIN = false;
    bf16_t* O; int ldc; int pn_lim;
    __device__ __forceinline__ void operator()(const f32x4 (&acc)[2][2][4][2], const Unit& u, int wr, int wc, int fr, int fq) const {
        if (u.pn >= pn_lim) return;
        const int row0 = u.pm * BM + wr * 64 + fr, col0 = u.pn * BM + wc * 32 + 8 * fq;
#pragma unroll
        for (int ai = 0; ai < 2; ++ai)
#pragma unroll
            for (int m = 0; m < 4; ++m) {
                bf16_t* rowp = O + (size_t)(row0 + ai * HALF + m * 16) * ldc + col0;
#pragma unroll
                for (int bj = 0; bj < 2; ++bj) {
                    const f32x4 v0 = acc[ai][bj][m][0], v1 = acc[ai][bj][m][1];
                    u32x4 w; w.x = cvt_pk_bf16(v0[0], v0[1]); w.y = cvt_pk_bf16(v0[2], v0[3]); w.z = cvt_pk_bf16(v1[0], v1[1]); w.w = cvt_pk_bf16(v1[2], v1[3]);
                    *(u32x4*)(rowp + bj * HALF) = w;
                }
            }
    }
};
struct EpiLoadOnly {
    static constexpr bool PERM = true, AFTER_DRAIN = false;
    float* sink; const float* ssq; const float* tcos; const float* tsin;
    __device__ __forceinline__ void operator()(const f32x4 (&acc)[2][2][4][2], const Unit& u, int wr, int wc, int fr, int fq) const {
        const int row0 = u.pm * BM + wr * 64 + fr; const int fi = 4 * ((wc & 1) * 4 + fq);
        float rs[2][4]; rows_rstd(ssq, row0, fq, rs); float s = 0.f;
#pragma unroll
        for (int ai = 0; ai < 2; ++ai)
#pragma unroll
            for (int m = 0; m < 4; ++m) { const int row = row0 + ai * HALF + m * 16; const f32x4 c4 = *(const f32x4*)(tcos + (size_t)row * 32 + fi), s4 = *(const f32x4*)(tsin + (size_t)row * 32 + fi);
#pragma unroll
                for (int bj = 0; bj < 2; ++bj) { const f32x4 x1 = acc[ai][bj][m][0] * rs[ai][m], x2 = acc[ai][bj][m][1] * rs[ai][m]; const f32x4 y1 = x1 * c4 - x2 * s4, y2 = x2 * c4 + x1 * s4;
                    s += (y1[0] + y1[1]) + (y1[2] + y1[3]) + (y2[0] + y2[1]) + (y2[2] + y2[3]); } }
        if (s == 1.2345678e30f) sink[0] = s;
    }
};
template <class Epi, class Sched, bool ALIGN_EPI = false, bool SP2 = false>
__device__ __forceinline__ void gemm_phase(PG8_LAS unsigned char* lds, const Gemm g, const Sched& S, const Epi& E) {
    int tid = threadIdx.x; asm volatile("" : "+v"(tid));
    const int wid = __builtin_amdgcn_readfirstlane(tid >> 6), lane = tid & 63, wr = wid >> 2, wc = wid & 3, fr = lane & 15, fq = lane >> 4;
    const int K = g.K, nt = K / BK;
    unsigned voffA[2], voffB[2];
#pragma unroll
    for (int i = 0; i < 2; ++i) { int R, C; stage_rc(tid * 16 + i * 8192, R, C); const int Rb = Epi::PERM ? ((R & ~31) + perm32(R & 31)) : R;
        voffA[i] = (unsigned)((R >> 4) * 16 * K + (C >> 5) * 512 + (R & 15) * 32 + (C & 31)) * 2u;     voffB[i] = (unsigned)(Rb * K + C) * 2u; }
    const size_t kstep = (size_t)(BK * 2);
    const size_t kstepA = 2048;
    const size_t hstep = (size_t)HALF * K * 2;
    const size_t tstep = 2 * hstep;
    const unsigned ldsw = (unsigned)wid * 1024u;
    const int aoff = lds_byte(wr * 64 + fr, fq * 8), boff = lds_byte(wc * 32 + fr, fq * 8);
#define PG8_SA(b, h) (((b) * 2 + (h)) * HTB)
#define PG8_SB(b, h) ((4 + (b) * 2 + (h)) * HTB)
#define PG8_STAGE(bufoff, gbase, voff) do { _Pragma("unroll") for (int _i = 0; _i < 2; ++_i) \
        __builtin_amdgcn_global_load_lds((const unsigned*)((const char*)(gbase) + (voff)[_i]), (PG8_LAS unsigned*)(lds + (bufoff) + ldsw + _i * 8192), 16, 0, 0); } while (0)
#define PG8_LDA(dst, b, h) do { _Pragma("unroll") for (int m = 0; m < 4; ++m) _Pragma("unroll") for (int k = 0; k < 2; ++k) dst[m][k] = *(const PG8_LAS bf16x8*)(lds + PG8_SA(b, h) + aoff + m * 2048 + k * 1024); } while (0)
#define PG8_LDB(dst, b, h) do { _Pragma("unroll") for (int n = 0; n < 2; ++n) _Pragma("unroll") for (int k = 0; k < 2; ++k) dst[n][k] = *(const PG8_LAS bf16x8*)(lds + PG8_SB(b, h) + boff + n * 2048 + k * 1024); } while (0)
#define PG8_MMA(ai, bj, At, Bt) do { __builtin_amdgcn_s_setprio(1); _Pragma("unroll") for (int m = 0; m < 4; ++m) _Pragma("unroll") for (int n = 0; n < 2; ++n) _Pragma("unroll") for (int k = 0; k < 2; ++k) \
        acc[ai][bj][m][n] = __builtin_amdgcn_mfma_f32_16x16x32_bf16(Bt[n][k], At[m][k], acc[ai][bj][m][n], 0, 0, 0); __builtin_amdgcn_s_setprio(0); } while (0)
#define PG8_WAIT_V(n) asm volatile("s_waitcnt vmcnt(" #n ")" ::: "memory")
#define PG8_WAIT_L(n) asm volatile("s_waitcnt lgkmcnt(" #n ")" ::: "memory")
#define PG8_BAR __builtin_amdgcn_s_barrier()
#define PG8_SCHED __builtin_amdgcn_sched_barrier(0)
    Unit cur, nxt; int ui = 0;
    if (!S.next(0, cur)) return;
    f32x4 acc[2][2][4][2];
#pragma unroll
    for (int a = 0; a < 2; ++a)
#pragma unroll
        for (int b = 0; b < 2; ++b)
#pragma unroll
            for (int m = 0; m < 4; ++m)
#pragma unroll
                for (int n = 0; n < 2; ++n) acc[a][b][m][n] = (f32x4){0.f, 0.f, 0.f, 0.f};
    bf16x8 At[4][2], B0[2][2], B1[2][2];
    const char* cA = (const char*)g.A + (size_t)cur.pm * tstep; const char* cB = (const char*)g.Bt + (size_t)cur.pn * tstep;
    S.a_ready(cur);
    if constexpr (SP2) {
        PG8_STAGE(PG8_SB(0, 0), cB, voffB); PG8_STAGE(PG8_SB(0, 1), cB + hstep, voffB); PG8_STAGE(PG8_SA(0, 0), cA, voffA); PG8_STAGE(PG8_SA(0, 1), cA + hstep, voffA);
        if (wr == 1) PG8_BAR;
        PG8_WAIT_V(2); PG8_BAR;
        PG8_STAGE(PG8_SB(1, 0), cB + kstep, voffB); PG8_STAGE(PG8_SA(1, 0), cA + kstepA, voffA); PG8_STAGE(PG8_SB(1, 1), cB + hstep + kstep, voffB);
        PG8_WAIT_V(6); PG8_BAR;
    } else {
        PG8_STAGE(PG8_SB(0, 0), cB, voffB); PG8_STAGE(PG8_SA(0, 0), cA, voffA); PG8_STAGE(PG8_SB(0, 1), cB + hstep, voffB); PG8_STAGE(PG8_SA(0, 1), cA + hstep, voffA);
        if (wr == 1) PG8_BAR;
        PG8_WAIT_V(4); PG8_BAR;
        PG8_STAGE(PG8_SB(1, 0), cB + kstep, voffB); PG8_STAGE(PG8_SA(1, 0), cA + kstepA, voffA); PG8_STAGE(PG8_SB(1, 1), cB + hstep + kstep, voffB);
        PG8_WAIT_V(6); PG8_BAR;
    }
    for (;;) {
        const bool has_next = S.next(ui + 1, nxt);
        const char* nA = has_next ? (const char*)g.A + (size_t)nxt.pm * tstep : cA; const char* nB = has_next ? (const char*)g.Bt + (size_t)nxt.pn * tstep : cB;
        for (int t = 0; t < nt; t += 2) {
            const bool last = (t == nt - 2);
            const char* a1 = cA + (size_t)(t + 1) * kstepA;
            const char* a2 = last ? nA : cA + (size_t)(t + 2) * kstepA; const char* b2 = last ? nB : cB + (size_t)(t + 2) * kstep;
            const char* a3 = a2 + kstepA; const char* b3 = b2 + kstep;
            if (last && has_next) S.a_ready(nxt);
            if constexpr (SP2) {
            PG8_LDB(B0, 0, 0); PG8_LDB(B1, 0, 1); PG8_SCHED; PG8_LDA(At, 0, 0); PG8_STAGE(PG8_SA(1, 1), a1 + hstep, voffA);
            PG8_WAIT_V(8); PG8_WAIT_L(0); PG8_BAR; PG8_MMA(0, 0, At, B0); PG8_MMA(0, 1, At, B1); PG8_BAR; PG8_SCHED;
            PG8_LDA(At, 0, 1); PG8_STAGE(PG8_SB(0, 0), b2, voffB); PG8_STAGE(PG8_SB(0, 1), b2 + hstep, voffB); PG8_STAGE(PG8_SA(0, 0), a2, voffA);
            PG8_WAIT_V(8); PG8_WAIT_L(0); PG8_BAR; PG8_MMA(1, 0, At, B0); PG8_MMA(1, 1, At, B1); PG8_BAR; PG8_SCHED;
            PG8_LDB(B0, 1, 0); PG8_LDB(B1, 1, 1); PG8_SCHED; PG8_LDA(At, 1, 0); PG8_STAGE(PG8_SA(0, 1), a2 + hstep, voffA);
            PG8_WAIT_V(8); PG8_WAIT_L(0); PG8_BAR; PG8_MMA(0, 0, At, B0); PG8_MMA(0, 1, At, B1); PG8_BAR; PG8_SCHED;
            PG8_LDA(At, 1, 1); PG8_STAGE(PG8_SB(1, 0), b3, voffB); PG8_STAGE(PG8_SB(1, 1), b3 + hstep, voffB); PG8_STAGE(PG8_SA(1, 0), a3, voffA);
            PG8_WAIT_V(8); PG8_WAIT_L(0); PG8_BAR; PG8_MMA(1, 0, At, B0); PG8_MMA(1, 1, At, B1); PG8_BAR; PG8_SCHED;
            } else {
            PG8_LDB(B0, 0, 0); PG8_SCHED; PG8_LDA(At, 0, 0); PG8_STAGE(PG8_SA(1, 1), a1 + hstep, voffA);
            PG8_WAIT_L(8); PG8_BAR; PG8_WAIT_L(0); PG8_MMA(0, 0, At, B0); PG8_BAR; PG8_SCHED;
            PG8_LDB(B1, 0, 1); PG8_STAGE(PG8_SB(0, 0), b2, voffB);
            PG8_BAR; PG8_WAIT_L(0); PG8_MMA(0, 1, At, B1); PG8_BAR;
            PG8_LDA(At, 0, 1); PG8_STAGE(PG8_SA(0, 0), a2, voffA);
            PG8_BAR; PG8_WAIT_L(0); PG8_MMA(1, 0, At, B0); PG8_BAR; PG8_SCHED;
            PG8_STAGE(PG8_SB(0, 1), b2 + hstep, voffB);
            PG8_WAIT_V(6); PG8_BAR; PG8_MMA(1, 1, At, B1); PG8_BAR;
            PG8_LDB(B0, 1, 0); PG8_SCHED; PG8_LDA(At, 1, 0); PG8_STAGE(PG8_SA(0, 1), a2 + hstep, voffA);
            PG8_WAIT_L(8); PG8_BAR; PG8_WAIT_L(0); PG8_MMA(0, 0, At, B0); PG8_BAR; PG8_SCHED;
            PG8_LDB(B1, 1, 1); PG8_STAGE(PG8_SB(1, 0), b3, voffB);
            PG8_BAR; PG8_WAIT_L(0); PG8_MMA(0, 1, At, B1); PG8_BAR;
            PG8_LDA(At, 1, 1); PG8_STAGE(PG8_SA(1, 0), a3, voffA);
            PG8_BAR; PG8_WAIT_L(0); PG8_MMA(1, 0, At, B0); PG8_BAR; PG8_SCHED;
            PG8_STAGE(PG8_SB(1, 1), b3 + hstep, voffB);
            PG8_WAIT_V(6); PG8_BAR; PG8_MMA(1, 1, At, B1); PG8_BAR;
            }
        }
        if constexpr (ALIGN_EPI) { if (wr == 0) PG8_BAR; }
        if constexpr (!Epi::AFTER_DRAIN) { E(acc, cur, wr, wc, fr, fq); S.done(cur); }
        if (!has_next) break;
#pragma unroll
        for (int a = 0; a < 2; ++a)
#pragma unroll
            for (int b = 0; b < 2; ++b)
#pragma unroll
                for (int m = 0; m < 4; ++m)
#pragma unroll
                    for (int n = 0; n < 2; ++n) acc[a][b][m][n] = (f32x4){0.f, 0.f, 0.f, 0.f};
        cur = nxt; cA = nA; cB = nB; ++ui;
        if constexpr (ALIGN_EPI) { if (wr == 1) PG8_BAR; }
    }
    PG8_WAIT_V(0);
    if constexpr (!ALIGN_EPI) { if (wr == 0) PG8_BAR; }
    PG8_BAR;
    if constexpr (Epi::AFTER_DRAIN) { E.fused(acc, cur, wr, wc, fr, fq, lds, wid, lane); S.done(cur); }
#undef PG8_SA
#undef PG8_SB
#undef PG8_STAGE
#undef PG8_LDA
#undef PG8_LDB
#undef PG8_MMA
#undef PG8_WAIT_V
#undef PG8_WAIT_L
#undef PG8_BAR
#undef PG8_SCHED
}
}

namespace att {
typedef unsigned short bf16_t;
using bf16x8 = __attribute__((ext_vector_type(8))) short;
using s16x4  = __attribute__((ext_vector_type(4))) short;
using f32x16 = __attribute__((ext_vector_type(16))) float;
using u32x4  = __attribute__((ext_vector_type(4))) unsigned;
using f32x4a = __attribute__((ext_vector_type(4))) float;
constexpr int DV = 128, DQK = 64, NW = 8, QBLK = 32, KVBLK = 64, OLD = 1024, SEQ = 2048;
constexpr int NBUF = 4, SHM_V = KVBLK * DV * 2, SHM_K = KVBLK * DQK * 2, OFF_V = 0, OFF_K = NBUF * SHM_V, OFF_WS = OFF_K + NBUF * SHM_K, SHM_TOTAL = OFF_WS + NW * 64 * 4;
constexpr float THR2 = 11.5f;
__device__ __forceinline__ int tl(int row, int col) { return (((row >> 4) * 32 + (col >> 5)) << 9) + ((row & 15) << 5) + (col & 31); }
#define AKSW(row, colB) ((row) * 128 + ((colB) ^ ((((row) >> 1) & 7) << 4)))
#define ASBAR() __builtin_amdgcn_sched_barrier(0)
__device__ __forceinline__ int crow(int r, int hi) { return (r & 3) + 8 * (r >> 2) + 4 * hi; }
__device__ __forceinline__ unsigned cvtpk(float lo, float hi) { unsigned r; asm volatile("v_cvt_pk_bf16_f32 %0, %1, %2" : "=v"(r) : "v"(lo), "v"(hi)); return r; }

__device__ __forceinline__ float fadd_s(float a, float b) { float r; asm("v_add_f32_e32 %0, %1, %2" : "=v"(r) : "v"(a), "v"(b)); return r; }
__device__ __forceinline__ float fsub_s(float a, float b) { float r; asm("v_sub_f32_e32 %0, %1, %2" : "=v"(r) : "v"(a), "v"(b)); return r; }
template <bool FAST> __device__ __forceinline__ void partialSM(f32x16& p0, f32x16& p1, float& m_reg, float& mn, float& alpha) {
  if constexpr (FAST) {
#pragma unroll
    for (int r = 0; r < 16; ++r) p0[r] = __builtin_amdgcn_exp2f(p0[r]);
    alpha = 1.f; mn = 0.f; return;
  }
  float pmax = p0[0];
#pragma unroll
  for (int r = 1; r < 16; ++r) pmax = fmaxf(pmax, p0[r]);
#pragma unroll
  for (int r = 0; r < 16; ++r) pmax = fmaxf(pmax, p1[r]);
  { unsigned xa = __float_as_uint(pmax), xb; asm volatile("v_mov_b32 %0, %1" : "=v"(xb) : "v"(xa)); auto rr = __builtin_amdgcn_permlane32_swap(xa, xb, false, false);
    pmax = fmaxf(__uint_as_float(rr[0]), __uint_as_float(rr[1])); }
  if (__builtin_expect(__all(pmax - m_reg <= THR2), 1)) { mn = m_reg; alpha = 1.f; }
  else { mn = fmaxf(m_reg, pmax); alpha = __builtin_amdgcn_exp2f(m_reg - mn); m_reg = mn; }
#pragma unroll
  for (int r = 0; r < 16; ++r) p0[r] = fsub_s(p0[r], mn);
#pragma unroll
  for (int r = 0; r < 16; ++r) p1[r] = fsub_s(p1[r], mn);
#pragma unroll
  for (int r = 0; r < 16; ++r) p0[r] = __builtin_amdgcn_exp2f(p0[r]);
}
__device__ __forceinline__ void finishSM(f32x16& p0, f32x16& p1, float alpha, float& l_reg, bf16x8& pa0, bf16x8& pa1, bf16x8& pa2, bf16x8& pa3) {
#pragma unroll
  for (int r = 0; r < 16; ++r) p1[r] = __builtin_amdgcn_exp2f(p1[r]);
  float ps = fadd_s(p0[0], p1[0]), ps2 = fadd_s(p0[1], p1[1]);
#pragma unroll
  for (int r = 2; r < 16; r += 2) { ps = fadd_s(ps, p0[r]); ps2 = fadd_s(ps2, p0[r + 1]); }
#pragma unroll
  for (int r = 2; r < 16; r += 2) { ps = fadd_s(ps, p1[r]); ps2 = fadd_s(ps2, p1[r + 1]); }
  ps = fadd_s(ps, ps2);
  ps = lane_xor_add<32>(ps);
  l_reg = l_reg * alpha + ps;
#define APK4(P, BASE, OUT) do { unsigned a0 = cvtpk(P[BASE + 0], P[BASE + 1]), a1 = cvtpk(P[BASE + 2], P[BASE + 3]);   \
    unsigned b0 = cvtpk(P[BASE + 4], P[BASE + 5]), b1 = cvtpk(P[BASE + 6], P[BASE + 7]);                              \
    auto r0 = __builtin_amdgcn_permlane32_swap(a0, b0, false, false); auto r1 = __builtin_amdgcn_permlane32_swap(a1, b1, false, false); \
    u32x4 w = {r0[0], r1[0], r0[1], r1[1]}; OUT = *reinterpret_cast<bf16x8*>(&w); } while (0)
  APK4(p0, 0, pa0); APK4(p0, 8, pa1); APK4(p1, 0, pa2); APK4(p1, 8, pa3);
#undef APK4
}
__device__ __forceinline__ void qkt(f32x16& p0, f32x16& p1, const char* Ks, const bf16x8* qr, int r32, int hi) {
  p0 = f32x16{}; p1 = f32x16{};
#pragma unroll
  for (int d0 = 0; d0 < 4; ++d0) { const int cb = d0 * 32 + hi * 16;
    const bf16x8 b0 = *reinterpret_cast<const bf16x8*>(Ks + AKSW(r32, cb));
    const bf16x8 b1 = *reinterpret_cast<const bf16x8*>(Ks + AKSW(32 + r32, cb));
    p0 = __builtin_amdgcn_mfma_f32_32x32x16_bf16(b0, qr[d0], p0, 0, 0, 0);
    p1 = __builtin_amdgcn_mfma_f32_32x32x16_bf16(b1, qr[d0], p1, 0, 0, 0); }
}
__device__ __forceinline__ int v_st(int k, int c) { const int kk = (k & ~0xC) | ((k & 4) << 1) | ((k & 8) >> 1); return ((kk >> 3) * 4 + (c >> 5)) * 512 + ((kk & 7) * 32 + (c & 31)) * 2; }
__device__ __forceinline__ int v_rd_base(int lane) { return ((lane & 3) << 3) | (((lane >> 2) & 3) << 6) | (((lane >> 4) & 1) << 5) | (((lane >> 5) & 1) << 8); }
constexpr int v_rd_off(int d0, int ks, int half) { return d0 * 512 + ks * 4096 + half * 2048; }
template <int OFF> __device__ __forceinline__ s16x4 tr_read(int vb) {
  s16x4 r; asm volatile("ds_read_b64_tr_b16 %0, %1 offset:%2" : "=&v"(r) : "v"(vb), "i"(OFF) : "memory"); return r;
}
template <int KS> __device__ __forceinline__ void pv_step(f32x16* o, int vb, bf16x8 pa) {
  const s16x4 l0 = tr_read<v_rd_off(0, KS, 0)>(vb), h0 = tr_read<v_rd_off(0, KS, 1)>(vb), l1 = tr_read<v_rd_off(1, KS, 0)>(vb), h1 = tr_read<v_rd_off(1, KS, 1)>(vb);
  const s16x4 l2 = tr_read<v_rd_off(2, KS, 0)>(vb), h2 = tr_read<v_rd_off(2, KS, 1)>(vb), l3 = tr_read<v_rd_off(3, KS, 0)>(vb), h3 = tr_read<v_rd_off(3, KS, 1)>(vb);
  asm volatile("s_waitcnt lgkmcnt(0)" ::: "memory"); ASBAR();
#define APK(L, H) (bf16x8){L[0], L[1], L[2], L[3], H[0], H[1], H[2], H[3]}
  o[0] = __builtin_amdgcn_mfma_f32_32x32x16_bf16(pa, APK(l0, h0), o[0], 0, 0, 0);
  o[1] = __builtin_amdgcn_mfma_f32_32x32x16_bf16(pa, APK(l1, h1), o[1], 0, 0, 0);
  o[2] = __builtin_amdgcn_mfma_f32_32x32x16_bf16(pa, APK(l2, h2), o[2], 0, 0, 0);
  o[3] = __builtin_amdgcn_mfma_f32_32x32x16_bf16(pa, APK(l3, h3), o[3], 0, 0, 0);
#undef APK
}
__device__ __forceinline__ void pv_d0(f32x16* o, int vb, bf16x8 pa0, bf16x8 pa1, bf16x8 pa2, bf16x8 pa3) {
  pv_step<0>(o, vb, pa0); pv_step<1>(o, vb, pa1); pv_step<2>(o, vb, pa2); pv_step<3>(o, vb, pa3);
}

__device__ __forceinline__ void glds16(const void* gsrc, unsigned lds_dst) { unsigned keep;
  asm volatile("s_mov_b32 %0, m0\n\ts_mov_b32 m0, %2\n\ts_nop 0\n\tglobal_load_lds_dwordx4 %1, off\n\ts_mov_b32 m0, %0" : "=&s"(keep) : "v"(gsrc), "s"(lds_dst) : "memory"); }
#define AWAIT_BAR(N) asm volatile("s_waitcnt vmcnt(" #N ") lgkmcnt(0)\n\ts_barrier" ::: "memory")
template <bool FAST> __device__ __forceinline__ void attn_pass(const bf16_t* __restrict__ Qb, const bf16_t* __restrict__ Kh, const bf16_t* __restrict__ Vh, int qcol, int kcol, int vcol, char* lds, f32x16 (&o)[4]) {
  int tid = threadIdx.x; asm volatile("" : "+v"(tid));
  const int wid = tid >> 6, lane = tid & 63, r32 = lane & 31, hi = lane >> 5;
  const int wids = __builtin_amdgcn_readfirstlane(wid);
  char* V_lds = lds + OFF_V; char* K_lds = lds + OFF_K;
  float* ws = (float*)(lds + OFF_WS) + wid * 64; float* li_l = ws; float* al_l = ws + 32;
  float m_reg = -1e30f, l_reg = 0; bf16x8 qr[4];
#pragma unroll
  for (int d = 0; d < 4; ++d) o[d] = f32x16{};
#pragma unroll
  for (int d0 = 0; d0 < 4; ++d0) qr[d0] = *reinterpret_cast<const bf16x8*>(Qb + tl(wid * QBLK + r32, qcol + d0 * 16 + hi * 8));
  const int vb0 = (int)(uintptr_t)V_lds + v_rd_base(lane);
  const int krow = 8 * wid + (lane >> 3), kof = tl(krow, kcol + 8 * ((lane & 7) ^ ((krow >> 1) & 7)));
  int vof[2];
#pragma unroll
  for (int i = 0; i < 2; ++i) { const int q = 2 * wid + i, kk = (q >> 1) * 8 + ((lane >> 2) & 7), key = (kk & ~0xC) | ((kk & 4) << 1) | ((kk & 8) >> 1);
    vof[i] = tl(key, vcol + (2 * (q & 1) + (lane >> 5)) * 32 + (lane & 3) * 8); }
  const unsigned kdst = (unsigned)(uintptr_t)K_lds + wids * 1024, vdst = (unsigned)(uintptr_t)V_lds + wids * 2048;
#define ADMA(t) do { const int t_ = (t) < NT ? (t) : NT - 1; const int bb = (t) & 3; \
    glds16(Kh + (long)t_ * (KVBLK * 1024) + kof, (unsigned)__builtin_amdgcn_readfirstlane(kdst + bb * SHM_K)); \
    glds16(Vh + (long)t_ * (KVBLK * 1024) + vof[0], (unsigned)__builtin_amdgcn_readfirstlane(vdst + bb * SHM_V)); \
    glds16(Vh + (long)t_ * (KVBLK * 1024) + vof[1], (unsigned)__builtin_amdgcn_readfirstlane(vdst + bb * SHM_V + 1024)); } while (0)
#define ARESC(a) do { if (!FAST && __any((a) < 1.f)) { if (hi == 0) al_l[r32] = (a); asm volatile("s_waitcnt lgkmcnt(0)" ::: "memory"); \
    _Pragma("unroll") for (int d = 0; d < 4; ++d) _Pragma("unroll") for (int r = 0; r < 16; ++r) o[d][r] *= al_l[crow(r, hi)]; } } while (0)
  f32x16 pA0, pA1, pB0, pB1; float mnA, mnB, alA, alB; bf16x8 pa0, pa1, pa2, pa3; constexpr int NT = SEQ / KVBLK;
  ADMA(0); ADMA(1);
  AWAIT_BAR(3);
  qkt(pA0, pA1, K_lds, qr, r32, hi); partialSM<FAST>(pA0, pA1, m_reg, mnA, alA);
  ADMA(2);
  AWAIT_BAR(3);
  for (int j = 1; j + 1 < NT; j += 2) {
    ASBAR(); qkt(pB0, pB1, K_lds + (j & 3) * SHM_K, qr, r32, hi);
    finishSM(pA0, pA1, alA, l_reg, pa0, pa1, pa2, pa3); ASBAR();
    ADMA(j + 2); ASBAR();
    pv_d0(o, vb0 + ((j - 1) & 3) * SHM_V, pa0, pa1, pa2, pa3); partialSM<FAST>(pB0, pB1, m_reg, mnB, alB);
    ARESC(alB); AWAIT_BAR(3);
    ASBAR(); qkt(pA0, pA1, K_lds + ((j + 1) & 3) * SHM_K, qr, r32, hi);
    finishSM(pB0, pB1, alB, l_reg, pa0, pa1, pa2, pa3); ASBAR();
    ADMA(j + 3); ASBAR();
    pv_d0(o, vb0 + (j & 3) * SHM_V, pa0, pa1, pa2, pa3); partialSM<FAST>(pA0, pA1, m_reg, mnA, alA);
    ARESC(alA); AWAIT_BAR(3);
  }
  ASBAR(); qkt(pB0, pB1, K_lds + ((NT - 1) & 3) * SHM_K, qr, r32, hi);
  finishSM(pA0, pA1, alA, l_reg, pa0, pa1, pa2, pa3); ASBAR();
  pv_d0(o, vb0 + ((NT - 2) & 3) * SHM_V, pa0, pa1, pa2, pa3); partialSM<FAST>(pB0, pB1, m_reg, mnB, alB);
  ARESC(alB);
  finishSM(pB0, pB1, alB, l_reg, pa0, pa1, pa2, pa3); ASBAR();
  pv_d0(o, vb0 + ((NT - 1) & 3) * SHM_V, pa0, pa1, pa2, pa3);
  if (hi == 0) li_l[r32] = l_reg; asm volatile("s_waitcnt lgkmcnt(0)" ::: "memory");
#pragma unroll
  for (int r = 0; r < 16; ++r) { const float rl = __builtin_amdgcn_rcpf(li_l[crow(r, hi)]);
#pragma unroll
    for (int d = 0; d < 4; ++d) o[d][r] *= rl; }
  AWAIT_BAR(0);
#undef ADMA
#undef ARESC
}

__device__ __forceinline__ void attn_unit(int b, int h, int qb, const bf16_t* Q, const bf16_t* K, const bf16_t* V, bf16_t* O, float* stash,
                                          float lam, const float* subg, float osc, char* lds) {
  const long rowbase = (long)b * SEQ, q0 = (long)qb * 256;
  const bf16_t* Qb = Q + (rowbase + q0) * 1024; const bf16_t* Kh = K + rowbase * 1024; const bf16_t* Vh = V + rowbase * 1024;
  unsigned keep[32];
#pragma unroll 1
  for (int c = 0; c < 2; ++c) {
    f32x16 o[4];
    attn_pass<false>(Qb, Kh, Vh, h * 128 + c * 64, h * 128 + c * 64, h * 128, lds, o);
    int zz = 0; asm volatile("" : "+v"(zz));
    const int tid = (int)threadIdx.x + zz, wid = tid >> 6, lane = tid & 63, r32 = lane & 31, hi = lane >> 5;
    (void)stash;
    if (c == 0) {
#pragma unroll
      for (int d = 0; d < 4; ++d)
#pragma unroll
        for (int q = 0; q < 8; ++q) keep[d * 8 + q] = cvtpk(o[d][2 * q], o[d][2 * q + 1]);
    } else {
      float g4[4];
#pragma unroll
      for (int d = 0; d < 4; ++d) g4[d] = subg[32 * d + r32] * osc;
      bf16_t* Ow = O + (rowbase + q0 + wid * QBLK) * 1024;
#pragma unroll
      for (int q = 0; q < 4; ++q) {
        f32x4a s4[4];
#pragma unroll
        for (int d = 0; d < 4; ++d) { const unsigned w0 = keep[d * 8 + 2 * q], w1 = keep[d * 8 + 2 * q + 1];
          s4[d] = (f32x4a){__uint_as_float(w0 << 16), __uint_as_float(w0 & 0xffff0000u), __uint_as_float(w1 << 16), __uint_as_float(w1 & 0xffff0000u)}; }
#pragma unroll
        for (int j = 0; j < 4; ++j) { const int r = 4 * q + j;
          float e[4];
#pragma unroll
          for (int d = 0; d < 4; ++d) e[d] = s4[d][j] - lam * o[d][r];
          float ss = (e[0] * e[0] + e[1] * e[1]) + (e[2] * e[2] + e[3] * e[3]);
          ss = lane_xor_add<1>(ss); ss = lane_xor_add<2>(ss); ss = lane_xor_add<4>(ss); ss = lane_xor_add<8>(ss); ss = lane_xor_add<16>(ss);
          const float rs = __builtin_amdgcn_rsqf(ss * (1.0f / 128.0f) + 1e-5f);
          const int orow = crow(r, hi);
#pragma unroll
          for (int d = 0; d < 4; ++d) Ow[tiled(orow, h * 128 + d * 32 + r32, 32)] = (bf16_t)(cvtpk(e[d] * rs * g4[d], 0.f) & 0xffffu);
        }
      }
    }
  }
}
#undef AKSW
#undef ASBAR
}
#ifndef LAS
#define LAS __attribute__((address_space(3)))
#endif
#define XB_TMO      128
#define XB_XCNT(j)  (256  + 64 * (j))
#define XB_XSUB(j)  (1280 + 64 * (j))
#define XB_XGEN(j)  (2304 + 64 * (j))
#define XB_TOP      3328
#define XB_TOPGEN   3392
#define XCD_BAR_WORDS 3456
#define XB_SPIN_CAP (1u << 18)

__device__ __forceinline__ unsigned xb_ld(unsigned* p)              { return __hip_atomic_load(p, __ATOMIC_RELAXED, __HIP_MEMORY_SCOPE_AGENT); }
__device__ __forceinline__ unsigned xb_add(unsigned* p, unsigned v) { return __hip_atomic_fetch_add(p, v, __ATOMIC_RELAXED, __HIP_MEMORY_SCOPE_AGENT); }
__device__ __forceinline__ unsigned xb_xcc_id() { return (unsigned)__builtin_amdgcn_s_getreg((3 << 11) | 20) & 0xFu; }
#define XB_SPIN(cond, bar) do { unsigned _sp = 0; while (cond) { __builtin_amdgcn_s_sleep(1); \
    if ((++_sp & 255u) == 0u) { if (xb_ld(&(bar)[XB_TMO])) break; if (_sp > XB_SPIN_CAP) { atomicAdd(&(bar)[XB_TMO], 1u); break; } } } } while (0)

struct XcdBarrier {
    unsigned* bar; unsigned x;
    volatile LAS unsigned* st;
};

__device__ __forceinline__ XcdBarrier xcd_barrier_post(unsigned* bar, volatile LAS unsigned* st) {
    XcdBarrier b; b.bar = bar; b.x = xb_xcc_id(); b.st = st;
    if (threadIdx.x == 0) (void)xb_add(&bar[XB_XCNT(b.x)], 1u);
    return b;
}
__device__ __forceinline__ void xcd_barrier_complete(unsigned* bar, unsigned x, unsigned& nloc, unsigned& nx) {
    const unsigned G = gridDim.x * gridDim.y * gridDim.z;
    unsigned sum, cnt, mine, sp = 0u;
    for (;;) {
        sum = 0u; cnt = 0u; mine = 0u;
#pragma unroll
        for (unsigned j = 0; j < 16; ++j) { const unsigned c = xb_ld(&bar[XB_XCNT(j)]); sum += c; cnt += (c > 0u) ? 1u : 0u; mine = (j == x) ? c : mine; }
        if (sum == G) break;
        __builtin_amdgcn_s_sleep(1);
        if ((++sp & 255u) == 0u) { if (xb_ld(&bar[XB_TMO])) break; if (sp > XB_SPIN_CAP) { atomicAdd(&bar[XB_TMO], 1u); break; } }
    }
    nloc = mine > 0u ? mine : 1u; nx = cnt > 0u ? cnt : 1u;
}

__device__ __forceinline__ void xcd_barrier(const XcdBarrier& b) {
    asm volatile("s_waitcnt vmcnt(0)" ::: "memory");
    __syncthreads();
    if (threadIdx.x == 0) {
        unsigned* bar = b.bar;
        __builtin_amdgcn_s_waitcnt(0);
        unsigned nloc = b.st[0], nx = b.st[1];
        if (nloc == 0u) { xcd_barrier_complete(bar, b.x, nloc, nx); b.st[0] = nloc; b.st[1] = nx; }
        const unsigned old = xb_add(&bar[XB_XSUB(b.x)], 1u);
        const unsigned gen = old / nloc;
        if (old + 1u == (gen + 1u) * nloc) {
            __builtin_amdgcn_fence(__ATOMIC_RELEASE, "agent");
            asm volatile("s_waitcnt vmcnt(0)" ::: "memory");
            const unsigned og = xb_add(&bar[XB_TOP], 1u);
            const unsigned tg = og / nx;
            if (og + 1u == (tg + 1u) * nx) xb_add(&bar[XB_TOPGEN], 1u);
            else XB_SPIN(xb_ld(&bar[XB_TOPGEN]) == tg, bar);
            __builtin_amdgcn_fence(__ATOMIC_ACQUIRE, "agent");
            xb_add(&bar[XB_XGEN(b.x)], 1u);
            asm volatile("s_waitcnt vmcnt(0)" ::: "memory");
        } else {
            XB_SPIN(xb_ld(&bar[XB_XGEN(b.x)]) == gen, bar);
            __builtin_amdgcn_fence(__ATOMIC_ACQUIRE, "agent");
            asm volatile("s_waitcnt vmcnt(0)" ::: "memory");
        }
    }
    __syncthreads();
}


namespace cg = cooperative_groups;
#define LAS __attribute__((address_space(3)))
typedef unsigned short bf16;
typedef unsigned v4u __attribute__((ext_vector_type(4)));
typedef float f32x4 __attribute__((ext_vector_type(4)));
typedef short bf16x8 __attribute__((ext_vector_type(8)));
constexpr int NWAVES = 8, NTHR = 512;
constexpr int BATCH = 32, SEQ = 2048, D = 1024, M = BATCH * SEQ, FF = 2816, FF2 = 2 * FF, NH = 8;
constexpr int MH = M / 2;
constexpr size_t MiB = 1u << 20;
constexpr size_t WS_WQKV = 0, WS_WO = 6 * MiB, WS_WIN = 8 * MiB, WS_WOUT = 14 * MiB, WS_WUP0 = 16 * MiB, WS_WUP1 = 27 * MiB, WS_WDN0 = 38 * MiB, WS_WDN1 = 44 * MiB;
constexpr size_t WS_COS = 64 * MiB, WS_SIN = 72 * MiB;
constexpr size_t WS_SSQ = 80 * MiB, SSQ_BYTES = 4 * MiB;
constexpr size_t WS_CTL = 100 * MiB, CTL_BYTES = 16384;
constexpr size_t WS_XB = 104 * MiB;
constexpr size_t WS_R = 232 * MiB;
constexpr size_t WS_Q = WS_R, WS_K = WS_R + 128 * MiB, WS_V = WS_R + 256 * MiB, WS_O = WS_R + 384 * MiB;
constexpr size_t WS_G = WS_R, WS_U = WS_R + 352 * MiB;
constexpr size_t WS_HU = WS_R + 352 * MiB, WS_HP = WS_HU + 16 * MiB;
constexpr size_t WS_STASH = 936 * MiB;
constexpr size_t WS_END = 1000 * MiB;
constexpr int LDS_BYTES = 147456;
static_assert(att::SHM_TOTAL <= 131072, "attention LDS");

__device__ __forceinline__ unsigned f2bf(float f) { unsigned u = __builtin_bit_cast(unsigned, f); return (u + 0x7fffu + ((u >> 16) & 1u)) >> 16; }
__device__ __forceinline__ unsigned pk2(float lo, float hi) { return f2bf(lo) | (f2bf(hi) << 16); }
__device__ __forceinline__ float bflo(unsigned w) { return __builtin_bit_cast(float, w << 16); }
__device__ __forceinline__ float bfhi(unsigned w) { return __builtin_bit_cast(float, w & 0xffff0000u); }
__device__ __forceinline__ float wave_sum(float v) {
    v = lane_xor_add<1>(v); v = lane_xor_add<2>(v); v = lane_xor_add<4>(v); v = lane_xor_add<8>(v); v = lane_xor_add<16>(v); v = lane_xor_add<32>(v);
    return v;
}
__device__ __forceinline__ int dest_row(int mode, int n) {
    if (mode == 1 && n < 2048) { const int d = n & 63, dd = d & 31; return (n & ~63) + 8 * (dd >> 2) + (dd & 3) + ((d >> 5) << 2); }
    if (mode == 3) { if (n < D) return 2 * D + n; const int isu = n >= 2 * D ? 1 : 0, ff = n - D - isu * D, fl = ff & 127; return (ff >> 7) * 256 + 128 * ((fl >> 2) & 1) + 8 * (fl >> 3) + 4 * isu + (fl & 3); }
    if (mode == 2) { const int isval = n >= FF ? 1 : 0, ff = n - isval * FF, fl = ff & 127; return (ff >> 7) * 256 + 128 * ((fl >> 2) & 1) + 8 * (fl >> 3) + 4 * isval + (fl & 3); }
    return n;
}
__device__ __forceinline__ void transpose_item(const float* W, int K, int N, bf16* WT, const float* gk, int mode, LAS float* scr, int item, int lane) {
    const int nblk = N / 32, kb = item / nblk, nb = item % nblk, k0 = 64 * kb, n0 = 32 * nb;
    f32x4 v[8]; float g[8];
#pragma unroll
    for (int i = 0; i < 8; ++i) { const int kk = 8 * i + (lane >> 3); v[i] = *(const f32x4*)(W + (size_t)(k0 + kk) * N + n0 + 4 * (lane & 7)); g[i] = gk ? gk[k0 + kk] : 1.f; }
#pragma unroll
    for (int i = 0; i < 8; ++i) { const int kk = 8 * i + (lane >> 3); LAS float* d = scr + kk * 33 + 4 * (lane & 7);
        d[0] = v[i][0] * g[i]; d[1] = v[i][1] * g[i]; d[2] = v[i][2] * g[i]; d[3] = v[i][3] * g[i]; }
    asm volatile("s_waitcnt lgkmcnt(0)" ::: "memory");
    const int c = lane & 7;
#pragma unroll
    for (int j = 0; j < 4; ++j) { const int n = (lane >> 3) + 8 * j; const LAS float* s = scr + (8 * c) * 33 + n;
        v4u o; o.x = pk2(s[0 * 33], s[1 * 33]); o.y = pk2(s[2 * 33], s[3 * 33]); o.z = pk2(s[4 * 33], s[5 * 33]); o.w = pk2(s[6 * 33], s[7 * 33]);
        *(v4u*)(WT + (size_t)dest_row(mode, n0 + n) * K + k0 + 8 * c) = o; }
    asm volatile("s_waitcnt lgkmcnt(0)" ::: "memory");
}
__device__ __forceinline__ void sincos_cw(float a, float& s, float& c) {
    const float kf = rintf(a * 0.63661977236758134f); const int k = (int)kf;
    float r = fmaf(kf, -1.5703125f, a); r = fmaf(kf, -4.837512969970703125e-4f, r); r = fmaf(kf, -7.54978995489188216e-8f, r);
    const float z = r * r;
    const float sp = fmaf(r * z, fmaf(z, fmaf(z, -1.9515295891e-4f, 8.3321608736e-3f), -1.6666654611e-1f), r);
    const float cp = fmaf(z * z, fmaf(z, fmaf(z, 2.443315711809948e-5f, -1.388731625493765e-3f), 4.166664568298827e-2f), fmaf(z, -0.5f, 1.0f));
    const float ss = (k & 1) ? cp : sp, cc = (k & 1) ? sp : cp;
    s = (k & 2) ? -ss : ss; c = ((k + 1) & 2) ? -cc : cc;
}

struct Args {
    const float* x; const int* pos;
    const float *attn_g, *w_qkv, *lq1, *lk1, *lq2, *lk2, *subg, *w_o, *conv_g, *w_in, *conv_w, *w_out, *ffn_g, *w_up, *ffn_cw, *ffn_cb, *w_dn, *fin_g;
    float* out; unsigned char* ws;
};

__device__ __forceinline__ void ffn_fix_rows(int pm, bf16* Gm, const float* HU, const float* HP, const float* cw, int tid) {
    for (int it = tid; it < 2 * 22 * 32; it += NTHR) {
        const int q = it & 31, pn = (it >> 5) % 22, which = it / (32 * 22);
        if (which == 0 ? ((pm & 7) == 0) : ((pm & 7) == 7)) continue;
        const int j0 = 128 * (q & 1) + 8 * (q >> 1), f0 = 128 * pn + 4 * q, nb = which == 0 ? pm - 1 : pm + 1;
        const size_t hb = ((size_t)pm * 2 + which) * FF2 + pn * 256 + j0, nbb = ((size_t)nb * 2 + (1 - which)) * FF2 + pn * 256 + j0;
        const f32x4 pg = *(const f32x4*)(HP + hb), pv = *(const f32x4*)(HP + hb + 4), ug = *(const f32x4*)(HU + nbb), uv = *(const f32x4*)(HU + nbb + 4);
        const int jw = which == 0 ? 0 : 2;
        const f32x4 wg = *(const f32x4*)(cw + (size_t)jw * FF2 + f0), wv = *(const f32x4*)(cw + (size_t)jw * FF2 + FF + f0);
        const f32x4 yg = pg + wg * ug, yv = pv + wv * uv;
        unsigned long long o = (unsigned long long)pk2(pg8::silu_f(yg[0]) * yv[0], pg8::silu_f(yg[1]) * yv[1]) | ((unsigned long long)pk2(pg8::silu_f(yg[2]) * yv[2], pg8::silu_f(yg[3]) * yv[3]) << 32);
        *(unsigned long long*)(Gm + tiled(pm * 256 + (which ? 255 : 0), f0, FF >> 5)) = o;
    }
}
__device__ __forceinline__ void mixer_ew_phase(const bf16* CU, const bf16* Bq, bf16* Y, const float* cw, int gtid, int nthreads) {
    constexpr int TC = 32, NFC = D / 8, NITEM = (M / TC) * NFC, NCT = D >> 5;
    for (int it = gtid; it < NITEM; it += nthreads) {
        const int fc = it % NFC, tc = it / NFC, t0 = tc * TC, f0 = fc * 8;
        float w[3][8];
#pragma unroll
        for (int j = 0; j < 3; ++j)
#pragma unroll
            for (int h = 0; h < 2; ++h) { const f32x4 a = *(const f32x4*)(cw + (size_t)j * D + f0 + 4 * h);
#pragma unroll
                for (int e = 0; e < 4; ++e) w[j][4 * h + e] = a[e]; }
        const v4u zero = {0u, 0u, 0u, 0u};
        v4u p = (t0 % SEQ == 0) ? zero : *(const v4u*)(CU + tiled(t0 - 1, f0, NCT));
        v4u c = *(const v4u*)(CU + tiled(t0, f0, NCT));
#pragma unroll 4
        for (int i = 0; i < TC; ++i) {
            const v4u n = (i == TC - 1 && (t0 + TC) % SEQ == 0) ? zero : *(const v4u*)(CU + tiled(t0 + i + 1, f0, NCT));
            const v4u b_ = *(const v4u*)(Bq + tiled(t0 + i, f0, NCT));
            v4u o;
#pragma unroll
            for (int q = 0; q < 4; ++q) {
                const float y0 = bflo(b_[q]) * fmaf(w[0][2 * q], bflo(p[q]), fmaf(w[1][2 * q], bflo(c[q]), w[2][2 * q] * bflo(n[q])));
                const float y1 = bfhi(b_[q]) * fmaf(w[0][2 * q + 1], bfhi(p[q]), fmaf(w[1][2 * q + 1], bfhi(c[q]), w[2][2 * q + 1] * bfhi(n[q])));
                o[q] = pk2(y0, y1);
            }
            *(v4u*)(Y + tiled(t0 + i, f0, NCT)) = o;
            p = c; c = n;
        }
    }
}

#ifndef PROBE_ATTN
#define PROBE_ATTN 1
#endif
#ifndef PROBE_EW
#define PROBE_EW 1
#endif
#ifndef PROBE_QKV
#define PROBE_QKV 1
#endif
__device__ __forceinline__ int opaque_bx() { int b = blockIdx.x; asm volatile("" : "+s"(b)); return b; }
#ifndef PROBE_UP
#define PROBE_UP 1
#endif
#ifndef STAGGER_TICKS
#define STAGGER_TICKS 0
#endif
__device__ __forceinline__ void stagger_start(int ticks) {
    if (ticks <= 0) return;
    const unsigned long long t0 = __builtin_amdgcn_s_memrealtime(); const unsigned long long d = (unsigned long long)(((blockIdx.x >> 3) & 3) * ticks);
    while (__builtin_amdgcn_s_memrealtime() - t0 < d) __builtin_amdgcn_s_sleep(16);
}
typedef const __attribute__((address_space(4))) Args* CArgs;
__device__ __forceinline__ CArgs get_args() { CArgs p = (CArgs)__builtin_amdgcn_kernarg_segment_ptr(); asm volatile("" : "+s"(p)); return p; }
#define WSP(off) (a->ws + (off))
#define WUP_T(l) ((bf16*)WSP(WS_WUP0 + (size_t)(l) * (WS_WUP1 - WS_WUP0)))
#define WDN_T(l) ((bf16*)WSP(WS_WDN0 + (size_t)(l) * (WS_WDN1 - WS_WDN0)))
#define SSQ(i) ((float*)WSP(WS_SSQ + (size_t)(i) * SSQ_BYTES))
#define GEO() int tid = threadIdx.x; asm volatile("" : "+v"(tid)); const int lane = tid & 63, wave = __builtin_amdgcn_readfirstlane(tid >> 6); const int G = gridDim.x, bx = blockIdx.x; \
    const int vcu = (G % 8 == 0) ? (bx % 8) * (G / 8) + bx / 8 : bx; const int gw = vcu * NWAVES + wave, NGW = G * NWAVES, gtid = bx * NTHR + tid, NT = G * NTHR; \
    (void)lane; (void)gw; (void)NGW; (void)gtid; (void)NT; (void)vcu

__global__ void __launch_bounds__(NTHR, 2) mega_fwd(Args a_unused) {
    extern __shared__ __attribute__((aligned(16))) unsigned char lds[];
    cg::grid_group grid = cg::this_grid();
    LAS unsigned char* ldsl = (LAS unsigned char*)lds;
    volatile LAS unsigned* bst = (volatile LAS unsigned*)(ldsl + 147456 - 64);
    if (threadIdx.x < 2) bst[threadIdx.x] = 0u;
    __syncthreads();
    if (blockIdx.x == 0) { unsigned* cw0 = (unsigned*)(get_args()->ws + WS_CTL); for (int i = threadIdx.x; i < (int)(CTL_BYTES / 4); i += NTHR) cw0[i] = 0u; }
#define GRID_SYNC() xcd_barrier(bar)

#ifndef PROBE_PRO
#define PROBE_PRO 1
#endif
    for (int prep = 0; prep < PROBE_PRO; ++prep)
    {
        CArgs a = get_args(); GEO();
        bf16* Wqkv_t = (bf16*)WSP(WS_WQKV); bf16* Wo_t = (bf16*)WSP(WS_WO); bf16* Win_t = (bf16*)WSP(WS_WIN); bf16* Wout_t = (bf16*)WSP(WS_WOUT);
        float* tcos = (float*)WSP(WS_COS); float* tsin = (float*)WSP(WS_SIN); bf16* XB = (bf16*)WSP(WS_XB);
        LAS float* scr = (LAS float*)(ldsl + wave * 16384);
        constexpr int I_QKV = (D / 64) * (3 * D / 32), I_O = (D / 64) * (D / 32), I_UP = (D / 64) * (FF2 / 32), I_DN = (FF / 64) * (D / 32);
        constexpr int NITEMS = 2 * I_QKV + 2 * I_O + 2 * I_UP + 2 * I_DN;
        for (int it = gw; it < NITEMS; it += NGW) {
            int r = it;
            if (r < I_QKV) { transpose_item(a->w_qkv, D, 3 * D, Wqkv_t, a->attn_g, 1, scr, r, lane); continue; } r -= I_QKV;
            if (r < I_QKV) { transpose_item(a->w_in, D, 3 * D, Win_t, a->conv_g, 3, scr, r, lane); continue; } r -= I_QKV;
            if (r < I_O) { transpose_item(a->w_o, D, D, Wo_t, nullptr, 0, scr, r, lane); continue; } r -= I_O;
            if (r < I_O) { transpose_item(a->w_out, D, D, Wout_t, nullptr, 0, scr, r, lane); continue; } r -= I_O;
            if (r < I_UP) { transpose_item(a->w_up, D, FF2, WUP_T(0), a->ffn_g, 2, scr, r, lane); continue; } r -= I_UP;
            if (r < I_UP) { transpose_item(a->w_up + (size_t)D * FF2, D, FF2, WUP_T(1), a->ffn_g + D, 2, scr, r, lane); continue; } r -= I_UP;
            if (r < I_DN) { transpose_item(a->w_dn, FF, D, WDN_T(0), nullptr, 0, scr, r, lane); continue; } r -= I_DN;
            transpose_item(a->w_dn + (size_t)FF * D, FF, D, WDN_T(1), nullptr, 0, scr, r, lane);
        }
        const int* pos = a->pos;
        for (int i = gtid; i < M * 32; i += NT) {
            const int d = i & 31; const float inv = __builtin_amdgcn_exp2f(-(float)d * (13.287712379549449f / 32.0f));
            float s, c; sincos_cw((float)pos[i >> 5] * inv, s, c); tcos[i] = c; tsin[i] = s;
        }
        const float* x = a->x; float* ssq0 = SSQ(0);
        for (int rg = gw; rg < M / 16; rg += NGW) {
            const int row = rg * 16 + (lane >> 2); const float* xr = x + (size_t)row * D + (lane & 3) * 8; bf16* tb = XB + (size_t)rg * (32 * 512) + lane * 8; float s = 0.f;
#pragma unroll 8
            for (int ct = 0; ct < 32; ++ct) { const f32x4 p = *(const f32x4*)(xr + ct * 32), q = *(const f32x4*)(xr + ct * 32 + 4);
                s += ((p.x * p.x + p.y * p.y) + (p.z * p.z + p.w * p.w)) + ((q.x * q.x + q.y * q.y) + (q.z * q.z + q.w * q.w));
                v4u o; o.x = pk2(p.x, p.y); o.y = pk2(p.z, p.w); o.z = pk2(q.x, q.y); o.w = pk2(q.z, q.w); *(v4u*)(tb + ct * 512) = o; }
            s = lane_xor_add<1>(s); s = lane_xor_add<2>(s);
            *(f32x4*)(ssq0 + (size_t)row * 16 + 4 * (lane & 3)) = (f32x4){(lane & 3) == 0 ? s : 0.f, 0.f, 0.f, 0.f};
        }
    }
    grid.sync();
    XcdBarrier bar = xcd_barrier_post((unsigned*)(get_args()->ws + WS_CTL), bst);

#ifdef PROBE_SYNC
    for (int rep = 0; rep < PROBE_SYNC; ++rep) GRID_SYNC();
#endif
    {
        CArgs a = get_args();
        pg8::Gemm g{(bf16*)WSP(WS_XB), (bf16*)WSP(WS_WQKV), M, 3 * D, D}; pg8::StaticOrder S; S.init(M, 3 * D, gridDim.x, opaque_bx());
        pg8::EpiRope E{(bf16*)WSP(WS_Q), (bf16*)WSP(WS_K), (bf16*)WSP(WS_V), SSQ(0), (float*)WSP(WS_COS), (float*)WSP(WS_SIN), 0.125f * 1.4426950408889634f};
        stagger_start(STAGGER_TICKS);
        for (int rep = 0; rep < PROBE_QKV; ++rep) pg8::gemm_phase<pg8::EpiRope, pg8::StaticOrder, true, true>(ldsl, g, S, E);
#ifdef PROBE_STORE
        { pg8::EpiStoreOnly EN{(bf16*)WSP(WS_O), 2048, 8}; pg8::gemm_phase<pg8::EpiStoreOnly, pg8::StaticOrder, true, true>(ldsl, g, S, EN); }
#endif
#ifdef PROBE_LOAD
        { pg8::EpiLoadOnly EN{(float*)WSP(WS_STASH), SSQ(0), (float*)WSP(WS_COS), (float*)WSP(WS_SIN)}; pg8::gemm_phase<pg8::EpiLoadOnly, pg8::StaticOrder, true, true>(ldsl, g, S, EN); }
#endif
#ifdef PROBE_KLOOP
        { pg8::EpiNull EN{(float*)WSP(WS_STASH)}; pg8::gemm_phase<pg8::EpiNull, pg8::StaticOrder, true, true>(ldsl, g, S, EN); }
#endif
    }
    GRID_SYNC();
    {
        CArgs a = get_args(); GEO();
        const float lambda_init = 0.8f - 0.6f * 1.0f;
        const float s1 = wave_sum(a->lq1[lane] * a->lk1[lane]), s2 = wave_sum(a->lq2[lane] * a->lk2[lane]);
        const float lam = __expf(s1) - __expf(s2) + lambda_init;
        const bf16* Qb = (const bf16*)WSP(WS_Q); const bf16* Kb = (const bf16*)WSP(WS_K); const bf16* Vb = (const bf16*)WSP(WS_V); bf16* Ob = (bf16*)WSP(WS_O);
        float* stash = (float*)WSP(WS_STASH); const float* subg = a->subg;
#pragma unroll 1
        for (int rep = 0; rep < PROBE_ATTN; ++rep)
#pragma unroll 1
        for (int i = 0;; ++i) {
            const int id = i * G + vcu; if (id >= BATCH * NH * (SEQ / 256)) break;
            const int bh = id >> 3, qb = id & 7;
            att::attn_unit(bh >> 3, bh & 7, qb, Qb, Kb, Vb, Ob, stash, lam, subg, 1.0f - lambda_init, (char*)lds);
        }
    }
    GRID_SYNC();
    {
        CArgs a = get_args();
        pg8::Gemm g{(bf16*)WSP(WS_O), (bf16*)WSP(WS_WO), M, D, D}; pg8::StaticOrder S; S.init(M, D, gridDim.x, opaque_bx());
        pg8::EpiRes<false> E{nullptr, (bf16*)WSP(WS_XB), SSQ(1)};
        pg8::gemm_phase<pg8::EpiRes<false>, pg8::StaticOrder, true, true>(ldsl, g, S, E);
    }
    GRID_SYNC();
#pragma unroll 1
    for (int layer = 0; layer < 2; ++layer) {
        if (layer == 1) {
            {   CArgs a = get_args();
                pg8::Gemm g{(bf16*)WSP(WS_XB), (bf16*)WSP(WS_WIN), M, 3 * D, D}; pg8::StaticOrder S; S.init(M, 3 * D, gridDim.x, opaque_bx());
                pg8::EpiMix E{(bf16*)WSP(WS_Q), (bf16*)WSP(WS_K), SSQ(2)};
                pg8::gemm_phase<pg8::EpiMix, pg8::StaticOrder, true, true>(ldsl, g, S, E); }
            GRID_SYNC();
            {   CArgs a = get_args(); GEO();
                mixer_ew_phase((const bf16*)WSP(WS_Q), (const bf16*)WSP(WS_K), (bf16*)WSP(WS_O), a->conv_w, gtid, NT); }
            GRID_SYNC();
            {   CArgs a = get_args();
                pg8::Gemm g{(bf16*)WSP(WS_O), (bf16*)WSP(WS_WOUT), M, D, D}; pg8::StaticOrder S; S.init(M, D, gridDim.x, opaque_bx());
                pg8::EpiRes<false> E{nullptr, (bf16*)WSP(WS_XB), SSQ(3)};
                pg8::gemm_phase<pg8::EpiRes<false>, pg8::StaticOrder, true, true>(ldsl, g, S, E); }
            GRID_SYNC();
        }
        {   CArgs a = get_args();
            pg8::Gemm g{(bf16*)WSP(WS_XB), WUP_T(layer), M, FF2, D}; pg8::StaticOrder S; S.init(M, FF2, gridDim.x, opaque_bx());
            pg8::EpiFfn E{(bf16*)WSP(WS_G), SSQ(layer == 0 ? 1 : 3), a->ffn_cw + (size_t)layer * 3 * FF2, a->ffn_cb + (size_t)layer * FF2, (float*)WSP(WS_HU), (float*)WSP(WS_HP), ldsl + 131072};
            stagger_start(STAGGER_TICKS);
            for (int rep = 0; rep < PROBE_UP; ++rep) pg8::gemm_phase<pg8::EpiFfn, pg8::StaticOrder, true, true>(ldsl, g, S, E); }
        GRID_SYNC();
        {   CArgs a = get_args();
            pg8::Gemm g{(bf16*)WSP(WS_G), WDN_T(layer), M, D, FF}; pg8::StaticOrder S; S.init(M, D, gridDim.x, opaque_bx());
            {   int tid = threadIdx.x; asm volatile("" : "+v"(tid));
                const float* cwl = a->ffn_cw + (size_t)layer * 3 * FF2;
#pragma unroll 1
                for (int i = 0;; ++i) { pg8::Unit u; if (!S.next(i, u)) break; ffn_fix_rows(u.pm, (bf16*)WSP(WS_G), (const float*)WSP(WS_HU), (const float*)WSP(WS_HP), cwl, tid); }
                __threadfence(); __syncthreads(); }
#ifdef PROBE_DOWN
            { pg8::EpiNull EN{(float*)WSP(WS_STASH)}; pg8::gemm_phase<pg8::EpiNull, pg8::StaticOrder, true, true>(ldsl, g, S, EN); }
#endif
            pg8::EpiRes<false> E{nullptr, (bf16*)WSP(WS_XB), SSQ(layer == 0 ? 2 : 4)};
            pg8::gemm_phase<pg8::EpiRes<false>, pg8::StaticOrder, true, true>(ldsl, g, S, E); }
        GRID_SYNC();
    }
    {   CArgs a = get_args(); GEO();
        float* out = a->out; const float* fg = a->fin_g; const float* ssq4 = SSQ(4); const bf16* XB = (const bf16*)WSP(WS_XB);
        for (int rg = gw; rg < M / 16; rg += NGW) {
            const int row = rg * 16 + (lane >> 2); const float rs = pg8::row_rstd(ssq4, row);
            const bf16* tb = XB + (size_t)rg * (32 * 512) + lane * 8; float* ob = out + (size_t)row * D + (lane & 3) * 8; const float* gp = fg + (lane & 3) * 8;
#pragma unroll 8
            for (int ct = 0; ct < 32; ++ct) { const v4u q = *(const v4u*)(tb + ct * 512); const f32x4 g0 = *(const f32x4*)(gp + ct * 32), g1 = *(const f32x4*)(gp + ct * 32 + 4);
                *(f32x4*)(ob + ct * 32) = (f32x4){bflo(q.x), bfhi(q.x), bflo(q.y), bfhi(q.y)} * rs * g0; *(f32x4*)(ob + ct * 32 + 4) = (f32x4){bflo(q.z), bfhi(q.z), bflo(q.w), bfhi(q.w)} * rs * g1; }
        }
    }
}

extern "C" void kernel_launch(void* const* d_in, const int* in_sizes, int n_in, void* d_out, int out_size, void* d_ws, size_t ws_size, hipStream_t stream) {
    static int grid = 0;
    if (grid == 0) {
        if (n_in != 20 || in_sizes[0] != M * D || out_size != M * D || ws_size < WS_END) { fprintf(stderr, "kernel_launch: shape mismatch n_in %d in0 %d out %d ws %zu\n", n_in, n_in > 0 ? in_sizes[0] : -1, out_size, ws_size); grid = -1; return; }
        int dev = 0, cus = 0, per_cu = 0;
        if (hipGetDevice(&dev) != hipSuccess || hipDeviceGetAttribute(&cus, hipDeviceAttributeMultiprocessorCount, dev) != hipSuccess) { grid = -1; return; }
        if (hipFuncSetAttribute((const void*)mega_fwd, hipFuncAttributeMaxDynamicSharedMemorySize, LDS_BYTES) != hipSuccess) { fprintf(stderr, "kernel_launch: hipFuncSetAttribute failed\n"); grid = -1; return; }
        if (hipOccupancyMaxActiveBlocksPerMultiprocessor(&per_cu, (const void*)mega_fwd, NTHR, LDS_BYTES) != hipSuccess || per_cu < 1) { fprintf(stderr, "kernel_launch: occupancy query says %d\n", per_cu); per_cu = 1; }
        (void)hipGetLastError();
        grid = cus;
    }
    if (grid < 0) return;
    Args a{};
    a.x = (const float*)d_in[0]; a.pos = (const int*)d_in[1];
    a.attn_g = (const float*)d_in[2]; a.w_qkv = (const float*)d_in[3]; a.lq1 = (const float*)d_in[4]; a.lk1 = (const float*)d_in[5]; a.lq2 = (const float*)d_in[6]; a.lk2 = (const float*)d_in[7];
    a.subg = (const float*)d_in[8]; a.w_o = (const float*)d_in[9]; a.conv_g = (const float*)d_in[10]; a.w_in = (const float*)d_in[11]; a.conv_w = (const float*)d_in[12]; a.w_out = (const float*)d_in[13];
    a.ffn_g = (const float*)d_in[14]; a.w_up = (const float*)d_in[15]; a.ffn_cw = (const float*)d_in[16]; a.ffn_cb = (const float*)d_in[17]; a.w_dn = (const float*)d_in[18]; a.fin_g = (const float*)d_in[19];
    a.out = (float*)d_out; a.ws = (unsigned char*)d_ws;
    void* args[] = {&a};
    const hipError_t e = hipLaunchCooperativeKernel((const void*)mega_fwd, dim3(grid), dim3(NTHR), args, LDS_BYTES, stream);
    if (e != hipSuccess) fprintf(stderr, "kernel_launch: cooperative launch failed: %s (grid %d)\n", hipGetErrorString(e), grid);
}
```

```cpp
#include <hip/hip_runtime.h>
#include <hip/hip_cooperative_groups.h>
#include <cstdio>
#include <cstdint>

template <int MASK> __device__ __forceinline__ float lane_xor_add(float x) {
    if constexpr (MASK == 32) {
        int l = (int)__builtin_amdgcn_mbcnt_hi(~0u, __builtin_amdgcn_mbcnt_lo(~0u, 0u)); asm volatile("" : "+v"(l));
        return x + __builtin_bit_cast(float, __builtin_amdgcn_ds_bpermute((l ^ 32) << 2, __builtin_bit_cast(int, x))); }
    else return x + __builtin_bit_cast(float, __builtin_amdgcn_ds_swizzle(__builtin_bit_cast(int, x), (MASK << 10) | 0x1F));
}
#ifndef DPP_PREV
#define DPP_PREV 0x121
#define DPP_NEXT 0x12F
#endif
#ifndef USE_NT
#define USE_NT 0
#endif
#if USE_NT
#define NT_STORE(v, p) __builtin_nontemporal_store((v), (p))
#else
#define NT_STORE(v, p) (*(p) = (v))
#endif
#ifndef QKV_LD
#define QKV_LD 1088
#endif
__device__ __forceinline__ size_t tiled(int row, int col, int nct) { return (((size_t)(row >> 4) * nct + (col >> 5)) << 9) + ((row & 15) << 5) + (col & 31); }
namespace pg8 {
#define PG8_LAS __attribute__((address_space(3)))
typedef unsigned short bf16_t;
typedef short bf16x8 __attribute__((ext_vector_type(8)));
typedef float f32x4 __attribute__((ext_vector_type(4)));
typedef unsigned u32x4 __attribute__((ext_vector_type(4)));
constexpr int BM = 256, BK = 64, HALF = 128, HTB = HALF * BK * 2  , STAGE_BYTES = 8 * HTB, NXCD = 8, WGM = 8;

__host__ __device__ __forceinline__ int lds_byte(int r, int c) { const int st = (r >> 4) * 2 + (c >> 5), rr = r & 15, cc = c & 31, ob = rr * 64 + cc * 2; return st * 1024 + (ob ^ (((ob >> 9) & 1) << 5)); }
__host__ __device__ __forceinline__ void stage_rc(int b, int& R, int& C) { const int st = b / 1024, sb = b % 1024, swz = sb ^ (((sb >> 9) & 1) << 5); R = (st >> 1) * 16 + swz / 64; C = (st & 1) * 32 + (swz % 64) / 2; }
__host__ __device__ __forceinline__ int perm32(int rho) { const int n = rho >> 4, i = rho & 15; return 8 * (i >> 2) + 4 * n + (i & 3); }

struct Unit { int pm, pn; };
struct Gemm { const bf16_t* A; const bf16_t* Bt; int M, N, K; };

struct StaticOrder {
    int nM, nN, nwg, G, c;
    __host__ __device__ void init(int M, int N, int G_, int c_) { nM = M / BM; nN = N / BM; nwg = nM * nN; G = G_; c = c_; }
    __host__ __device__ bool next(int i, Unit& u) const {
        const long L = (long)i * G + c; if (L >= nwg) return false;
        int wgid = (int)L; { const int q = nwg / NXCD, r = nwg % NXCD, xcd = wgid % NXCD, off = wgid / NXCD; wgid = (xcd < r ? xcd * (q + 1) : r * (q + 1) + (xcd - r) * q) + off; }
        const int nig = WGM * nN, gid = wgid / nig, fm = gid * WGM, gsz = (nM - fm) < WGM ? (nM - fm) : WGM;
        u.pm = fm + ((wgid % nig) % gsz); u.pn = (wgid % nig) / gsz; return true;
    }
    __device__ __forceinline__ void a_ready(const Unit&) const {}
    __device__ __forceinline__ void done(const Unit&) const {}
};

__device__ __forceinline__ unsigned cvt_pk_bf16(float lo, float hi) { unsigned r; asm volatile("v_cvt_pk_bf16_f32 %0, %1, %2" : "=v"(r) : "v"(lo), "v"(hi)); return r; }
typedef float f32x2 __attribute__((ext_vector_type(2)));

__device__ __forceinline__ float row_rstd(const float* ssq, int row) {
    const f32x4* p = (const f32x4*)(ssq + (size_t)row * 16);
    const f32x4 a = p[0], b = p[1], c = p[2], d = p[3];
    const float s = (((a[0] + a[1]) + (a[2] + a[3])) + ((b[0] + b[1]) + (b[2] + b[3]))) + (((c[0] + c[1]) + (c[2] + c[3])) + ((d[0] + d[1]) + (d[2] + d[3])));
    return __builtin_amdgcn_rsqf(s * (1.0f / 1024.0f) + 1e-5f);
}
__device__ __forceinline__ void rows_rstd(const float* ssq, int row0, int fq, float (&rs)[2][4]) {
    f32x4 p[2][4];
#pragma unroll
    for (int ai = 0; ai < 2; ++ai)
#pragma unroll
        for (int m = 0; m < 4; ++m) p[ai][m] = *(const f32x4*)(ssq + (size_t)(row0 + ai * HALF + m * 16) * 16 + 4 * fq);
#pragma unroll
    for (int ai = 0; ai < 2; ++ai)
#pragma unroll
        for (int m = 0; m < 4; ++m) { float s = (p[ai][m][0] + p[ai][m][1]) + (p[ai][m][2] + p[ai][m][3]); s = lane_xor_add<16>(s); s = lane_xor_add<32>(s);
            rs[ai][m] = __builtin_amdgcn_rsqf(s * (1.0f / 1024.0f) + 1e-5f); }
}
struct EpiRope {
    static constexpr bool PERM = true, AFTER_DRAIN = false;
    bf16_t* Q; bf16_t* K; bf16_t* V; const float* ssq; const float* tcos; const float* tsin; float qscale;
    __device__ __forceinline__ void operator()(const f32x4 (&acc)[2][2][4][2], const Unit& u, int wr, int wc, int fr, int fq) const {
        const int t = u.pn >> 2;
        const int colt = (u.pn & 3) * BM + wc * 32 + 8 * fq;
        const int row0 = u.pm * BM + wr * 64 + fr;
        const int fi = 4 * ((wc & 1) * 4 + fq);
        float rs[2][4]; rows_rstd(ssq, row0, fq, rs);
        if (t < 2) {
            bf16_t* base = (t == 0) ? Q : K; const float sc = (t == 0) ? qscale : 1.f;
#pragma unroll
            for (int ai = 0; ai < 2; ++ai) {
                f32x4 c4[4], s4[4];
#pragma unroll
                for (int m = 0; m < 4; ++m) { const int row = row0 + ai * HALF + m * 16; c4[m] = *(const f32x4*)(tcos + (size_t)row * 32 + fi); s4[m] = *(const f32x4*)(tsin + (size_t)row * 32 + fi); }
#pragma unroll
                for (int m = 0; m < 4; ++m) {
                    const int row = row0 + ai * HALF + m * 16;
                    const float k = rs[ai][m] * sc;
                    bf16_t* rowp = base + ((size_t)(row >> 4) * 32 + (colt >> 5)) * 512 + (row & 15) * 32 + (colt & 31);
#pragma unroll
                    for (int bj = 0; bj < 2; ++bj) {
                        const f32x4 x1 = acc[ai][bj][m][0] * k, x2 = acc[ai][bj][m][1] * k;
                        const f32x4 y1 = x1 * c4[m] - x2 * s4[m], y2 = x2 * c4[m] + x1 * s4[m];
                        u32x4 w; w.x = cvt_pk_bf16(y1[0], y1[1]); w.y = cvt_pk_bf16(y1[2], y1[3]); w.z = cvt_pk_bf16(y2[0], y2[1]); w.w = cvt_pk_bf16(y2[2], y2[3]);
                        NT_STORE(w, (u32x4*)(rowp + bj * 2048));
                    }
                }
                __builtin_amdgcn_sched_barrier(0);
            }
        } else {
#pragma unroll
            for (int ai = 0; ai < 2; ++ai)
#pragma unroll
                for (int m = 0; m < 4; ++m) {
                    const int row = row0 + ai * HALF + m * 16;
                    const float k = rs[ai][m];
                    bf16_t* rowp = V + ((size_t)(row >> 4) * 32 + (colt >> 5)) * 512 + (row & 15) * 32 + (colt & 31);
#pragma unroll
                    for (int bj = 0; bj < 2; ++bj) {
                        const f32x4 v0 = acc[ai][bj][m][0] * k, v1 = acc[ai][bj][m][1] * k;
                        u32x4 w; w.x = cvt_pk_bf16(v0[0], v0[1]); w.y = cvt_pk_bf16(v0[2], v0[3]); w.z = cvt_pk_bf16(v1[0], v1[1]); w.w = cvt_pk_bf16(v1[2], v1[3]);
                        NT_STORE(w, (u32x4*)(rowp + bj * 2048));
                    }
                }
        }
    }
};
struct EpiScale {
    static constexpr bool PERM = true, AFTER_DRAIN = false;
    bf16_t* O; int ldc; const float* ssq; int row_off;
    __device__ __forceinline__ void operator()(const f32x4 (&acc)[2][2][4][2], const Unit& u, int wr, int wc, int fr, int fq) const {
        const int row0 = u.pm * BM + wr * 64 + fr, col0 = u.pn * BM + wc * 32 + 8 * fq;
        float rs[2][4]; rows_rstd(ssq, row_off + row0, fq, rs);
#pragma unroll
        for (int ai = 0; ai < 2; ++ai)
#pragma unroll
            for (int m = 0; m < 4; ++m) {
                const int row = row0 + ai * HALF + m * 16;
                const float k = rs[ai][m];
                bf16_t* rowp = O + tiled(row, col0, ldc >> 5);
#pragma unroll
                for (int bj = 0; bj < 2; ++bj) {
                    const f32x4 v0 = acc[ai][bj][m][0] * k, v1 = acc[ai][bj][m][1] * k;
                    u32x4 w; w.x = cvt_pk_bf16(v0[0], v0[1]); w.y = cvt_pk_bf16(v0[2], v0[3]); w.z = cvt_pk_bf16(v1[0], v1[1]); w.w = cvt_pk_bf16(v1[2], v1[3]);
                    NT_STORE(w, (u32x4*)(rowp + bj * 2048));
                }
            }
    }
};
struct EpiMix {
    static constexpr bool PERM = true, AFTER_DRAIN = false;
    bf16_t* CU; bf16_t* Bq; const float* ssq;
    __device__ __forceinline__ void operator()(const f32x4 (&acc)[2][2][4][2], const Unit& u, int wr, int wc, int fr, int fq) const {
        typedef unsigned u32x2m __attribute__((ext_vector_type(2)));
        const int row0 = u.pm * BM + wr * 64 + fr;
        float rs[2][4]; rows_rstd(ssq, row0, fq, rs);
        if (u.pn < 8) {
            const int f0 = u.pn * 128 + wc * 32 + 8 * fq;
#pragma unroll
            for (int ai = 0; ai < 2; ++ai)
#pragma unroll
                for (int m = 0; m < 4; ++m) { const int row = row0 + ai * HALF + m * 16; const float r2 = rs[ai][m] * rs[ai][m];
                    const f32x4 p0 = acc[ai][0][m][0] * acc[ai][0][m][1] * r2, p1 = acc[ai][1][m][0] * acc[ai][1][m][1] * r2;
                    u32x4 w; w.x = cvt_pk_bf16(p0[0], p0[1]); w.y = cvt_pk_bf16(p0[2], p0[3]); w.z = cvt_pk_bf16(p1[0], p1[1]); w.w = cvt_pk_bf16(p1[2], p1[3]);
                    *(u32x4*)(CU + tiled(row, f0, 32)) = w; }
        } else {
            const int col0 = (u.pn - 8) * BM + wc * 32 + 8 * fq;
#pragma unroll
            for (int ai = 0; ai < 2; ++ai)
#pragma unroll
                for (int m = 0; m < 4; ++m) { const int row = row0 + ai * HALF + m * 16; const float k = rs[ai][m]; bf16_t* rowp = Bq + tiled(row, col0, 32);
#pragma unroll
                    for (int bj = 0; bj < 2; ++bj) { const f32x4 v0 = acc[ai][bj][m][0] * k, v1 = acc[ai][bj][m][1] * k;
                        u32x4 w; w.x = cvt_pk_bf16(v0[0], v0[1]); w.y = cvt_pk_bf16(v0[2], v0[3]); w.z = cvt_pk_bf16(v1[0], v1[1]); w.w = cvt_pk_bf16(v1[2], v1[3]);
                        *(u32x4*)(rowp + bj * 2048) = w; } }
        }
    }
};
template <bool BASE_F32> struct EpiRes {
    static constexpr bool PERM = true, AFTER_DRAIN = false;
    const float* basef; bf16_t* xb; float* ssq_out;
    __device__ __forceinline__ void operator()(const f32x4 (&acc)[2][2][4][2], const Unit& u, int wr, int wc, int fr, int fq) const {
        const int row0 = u.pm * BM + wr * 64 + fr, col0 = u.pn * BM + wc * 32 + 8 * fq;
#pragma unroll
        for (int ai = 0; ai < 2; ++ai) {
            f32x4 bf[BASE_F32 ? 4 : 1][2][2]; u32x4 bb[BASE_F32 ? 1 : 4][2];
#pragma unroll
            for (int m = 0; m < 4; ++m) { const size_t off = (size_t)(row0 + ai * HALF + m * 16) * 1024 + col0, toff = tiled(row0 + ai * HALF + m * 16, col0, 32);
#pragma unroll
                for (int bj = 0; bj < 2; ++bj) {
                    if constexpr (BASE_F32) { bf[m][bj][0] = *(const f32x4*)(basef + off + bj * HALF); bf[m][bj][1] = *(const f32x4*)(basef + off + bj * HALF + 4); }
                    else bb[m][bj] = *(const u32x4*)(xb + toff + bj * 2048); } }
#pragma unroll
            for (int m = 0; m < 4; ++m) {
                const int row = row0 + ai * HALF + m * 16; const size_t toff = tiled(row, col0, 32); float ss = 0.f;
#pragma unroll
                for (int bj = 0; bj < 2; ++bj) {
                    f32x4 b0, b1;
                    if constexpr (BASE_F32) { b0 = bf[m][bj][0]; b1 = bf[m][bj][1]; }
                    else { const u32x4 w = bb[m][bj];
                        b0 = (f32x4){__builtin_bit_cast(float, w.x << 16), __builtin_bit_cast(float, w.x & 0xffff0000u), __builtin_bit_cast(float, w.y << 16), __builtin_bit_cast(float, w.y & 0xffff0000u)};
                        b1 = (f32x4){__builtin_bit_cast(float, w.z << 16), __builtin_bit_cast(float, w.z & 0xffff0000u), __builtin_bit_cast(float, w.w << 16), __builtin_bit_cast(float, w.w & 0xffff0000u)}; }
                    const f32x4 o0 = b0 + acc[ai][bj][m][0], o1 = b1 + acc[ai][bj][m][1];
                    ss += ((o0[0] * o0[0] + o0[1] * o0[1]) + (o0[2] * o0[2] + o0[3] * o0[3])) + ((o1[0] * o1[0] + o1[1] * o1[1]) + (o1[2] * o1[2] + o1[3] * o1[3]));
                    u32x4 w; w.x = cvt_pk_bf16(o0[0], o0[1]); w.y = cvt_pk_bf16(o0[2], o0[3]); w.z = cvt_pk_bf16(o1[0], o1[1]); w.w = cvt_pk_bf16(o1[2], o1[3]);
                    NT_STORE(w, (u32x4*)(xb + toff + bj * 2048));
                }
                ss = lane_xor_add<16>(ss); ss = lane_xor_add<32>(ss);
                if (fq == 0) ssq_out[(size_t)row * 16 + u.pn * 4 + wc] = ss;
            }
        }
    }
};
__device__ __forceinline__ float dpp_ror1_f(float x) { return __builtin_bit_cast(float, __builtin_amdgcn_update_dpp(0, __builtin_bit_cast(int, x), DPP_PREV, 0xF, 0xF, true)); }
__device__ __forceinline__ float dpp_ror15_f(float x) { return __builtin_bit_cast(float, __builtin_amdgcn_update_dpp(0, __builtin_bit_cast(int, x), DPP_NEXT, 0xF, 0xF, true)); }
__device__ __forceinline__ f32x4 dpp_ror1(f32x4 v) { f32x4 r; r.x = dpp_ror1_f(v.x); r.y = dpp_ror1_f(v.y); r.z = dpp_ror1_f(v.z); r.w = dpp_ror1_f(v.w); return r; }
__device__ __forceinline__ f32x4 dpp_ror15(f32x4 v) { f32x4 r; r.x = dpp_ror15_f(v.x); r.y = dpp_ror15_f(v.y); r.z = dpp_ror15_f(v.z); r.w = dpp_ror15_f(v.w); return r; }
__device__ __forceinline__ f32x4 sel4(bool c, f32x4 a, f32x4 b) { return (f32x4){c ? a[0] : b[0], c ? a[1] : b[1], c ? a[2] : b[2], c ? a[3] : b[3]}; }
__device__ __forceinline__ float silu_f(float g) { return g * __builtin_amdgcn_rcpf(1.f + __builtin_amdgcn_exp2f(-1.4426950408889634f * g)); }
struct EpiFfn {
    static constexpr bool PERM = true, AFTER_DRAIN = false;
    bf16_t* G; const float* ssq; const float* cw; const float* cb; float* HU; float* HP; PG8_LAS unsigned char* ex;
    __device__ __forceinline__ void operator()(f32x4 (&acc)[2][2][4][2], const Unit& u, int wr, int wc, int fr_in, int fq_in) const {
        typedef unsigned u32x2e __attribute__((ext_vector_type(2)));
        int t_ = threadIdx.x; asm volatile("" : "+v"(t_)); const int fr = t_ & 15, fq = (t_ >> 4) & 3; (void)fr_in; (void)fq_in;
        constexpr int FFc = 2816, FF2c = 5632;
        const int row0 = u.pm * BM + wr * 64 + fr;
        const bool is_first = (fr == 0), is_last = (fr == 15);
        PG8_LAS float* RS = (PG8_LAS float*)(ex + 8192); PG8_LAS float* CWL = (PG8_LAS float*)(ex + 8192 + 1024);
        {
            const int t = t_ & 511;
            if (t < 256) {
                const f32x4* p = (const f32x4*)(ssq + (size_t)(u.pm * BM + t) * 16);
                const f32x4 a = p[0], b = p[1], c = p[2], d = p[3];
                const float s = (((a[0] + a[1]) + (a[2] + a[3])) + ((b[0] + b[1]) + (b[2] + b[3]))) + (((c[0] + c[1]) + (c[2] + c[3])) + ((d[0] + d[1]) + (d[2] + d[3])));
                RS[t] = __builtin_amdgcn_rsqf(s * (1.0f / 1024.0f) + 1e-5f);
            } else {
                const int q = t - 256, p = q >> 6, jq = q & 63, n = jq & 1, wq = (jq >> 1) & 15, bjj = jq >> 5;
                const float* src = (p < 3) ? (cw + (size_t)p * FF2c) : cb;
                *(PG8_LAS f32x4*)(CWL + p * 256 + 4 * jq) = *(const f32x4*)(src + n * FFc + u.pn * 128 + 8 * wq + 4 * bjj);
            }
        }
        asm volatile("s_waitcnt lgkmcnt(0)" ::: "memory"); __builtin_amdgcn_s_barrier(); asm volatile("" ::: "memory");
#pragma unroll
        for (int ai = 0; ai < 2; ++ai)
#pragma unroll
            for (int m = 0; m < 4; ++m) { const float r = RS[wr * 64 + fr + ai * HALF + m * 16];
#pragma unroll
                for (int bj = 0; bj < 2; ++bj)
#pragma unroll
                    for (int n = 0; n < 2; ++n) acc[ai][bj][m][n] = acc[ai][bj][m][n] * r; }
        PG8_LAS float* EX = (PG8_LAS float*)ex;
        const int cj = wc * 32 + 8 * fq;
#pragma unroll
        for (int ai = 0; ai < 2; ++ai)
#pragma unroll
            for (int bj = 0; bj < 2; ++bj)
#pragma unroll
                for (int n = 0; n < 2; ++n) {
                    if (is_first) *(PG8_LAS f32x4*)(EX + ((ai * 2 + wr) * 2 + 0) * 256 + bj * 128 + cj + 4 * n) = acc[ai][bj][0][n];
                    if (is_last)  *(PG8_LAS f32x4*)(EX + ((ai * 2 + wr) * 2 + 1) * 256 + bj * 128 + cj + 4 * n) = acc[ai][bj][3][n];
                }
        asm volatile("s_waitcnt lgkmcnt(0)" ::: "memory"); __builtin_amdgcn_s_barrier(); asm volatile("" ::: "memory");
        const int f0 = u.pn * 128 + wc * 32 + 8 * fq;
        const f32x4 zero4 = {0.f, 0.f, 0.f, 0.f};
#pragma unroll
        for (int ai = 0; ai < 2; ++ai) {
            const int g = ai * 2 + wr;
            unsigned park[4][2];
#pragma unroll
            for (int bj = 0; bj < 2; ++bj) {
#pragma unroll
                for (int n = 0; n < 2; ++n) {
                    f32x4 wgt[4];
#pragma unroll
                    for (int j = 0; j < 4; ++j) wgt[j] = *(const PG8_LAS f32x4*)(CWL + j * 256 + bj * 128 + cj + 4 * n);
                    const f32x4 hp = (g == 0) ? zero4 : *(const PG8_LAS f32x4*)(EX + ((g - 1) * 2 + 1) * 256 + bj * 128 + cj + 4 * n);
                    const f32x4 hn = (g == 3) ? zero4 : *(const PG8_LAS f32x4*)(EX + ((g + 1) * 2 + 0) * 256 + bj * 128 + cj + 4 * n);
                    f32x4 r1p = hp, r15c = dpp_ror15(acc[ai][bj][0][n]);
#pragma unroll
                    for (int m = 0; m < 4; ++m) {
                        const f32x4 X = acc[ai][bj][m][n];
                        const f32x4 r1m = dpp_ror1(X);
                        const f32x4 prev = sel4(is_first, r1p, r1m); r1p = r1m;
                        const f32x4 r15n = (m < 3) ? dpp_ror15(acc[ai][bj][m < 3 ? m + 1 : 3][n]) : hn;
                        const f32x4 next = sel4(is_last, r15n, r15c); r15c = r15n;
                        const f32x4 Y = wgt[0] * prev + (wgt[1] * X + (wgt[2] * next + wgt[3]));
                        if (m == 0) { if (g == 0 && is_first) { int co = cj; asm volatile("" : "+v"(co)); const size_t hb = ((size_t)u.pm * 2 + 0) * FF2c + u.pn * 256 + bj * 128 + co + 4 * n; *(f32x4*)(HU + hb) = X; *(f32x4*)(HP + hb) = Y; } }
                        if (m == 3) { if (g == 3 && is_last) { int co = cj; asm volatile("" : "+v"(co)); const size_t hb = ((size_t)u.pm * 2 + 1) * FF2c + u.pn * 256 + bj * 128 + co + 4 * n; *(f32x4*)(HU + hb) = X; *(f32x4*)(HP + hb) = Y; } }
                        if (n == 0) acc[ai][bj][m][0] = (f32x4){silu_f(Y[0]), silu_f(Y[1]), silu_f(Y[2]), silu_f(Y[3])};
                        else { const f32x4 o = acc[ai][bj][m][0] * Y; const unsigned wl = cvt_pk_bf16(o[0], o[1]), wh = cvt_pk_bf16(o[2], o[3]);
                            if (bj == 0) { park[m][0] = wl; park[m][1] = wh; }
                            else { u32x4 w; w.x = park[m][0]; w.y = park[m][1]; w.z = wl; w.w = wh; NT_STORE(w, (u32x4*)(G + tiled(row0 + ai * HALF + m * 16, f0, FFc >> 5))); } }
                    }
                    __builtin_amdgcn_sched_barrier(0);
                }
            }
        }
    }
};
struct EpiNull {
    static constexpr bool PERM = true, AFTER_DRAIN = false;
    float* sink;
    __device__ __forceinline__ void operator()(const f32x4 (&acc)[2][2][4][2], const Unit& u, int wr, int wc, int fr, int fq) const {
        float s = 0.f;
#pragma unroll
        for (int ai = 0; ai < 2; ++ai)
#pragma unroll
            for (int bj = 0; bj < 2; ++bj)
#pragma unroll
                for (int m = 0; m < 4; ++m)
#pragma unroll
                    for (int n = 0; n < 2; ++n) s += (acc[ai][bj][m][n][0] + acc[ai][bj][m][n][1]) + (acc[ai][bj][m][n][2] + acc[ai][bj][m][n][3]);
        if (s == 1.2345678e30f) sink[0] = s;
    }
};

struct EpiStoreOnly {
    static constexpr bool PERM = true, AFTER_DRAIN = false;
    bf16_t* O; int ldc; int pn_lim;
    __device__ __forceinline__ void operator()(const f32x4 (&acc)[2][2][4][2], const Unit& u, int wr, int wc, int fr, int fq) const {
        if (u.pn >= pn_lim) return;
        const int row0 = u.pm * BM + wr * 64 + fr, col0 = u.pn * BM + wc * 32 + 8 * fq;
#pragma unroll
        for (int ai = 0; ai < 2; ++ai)
#pragma unroll
            for (int m = 0; m < 4; ++m) {
                bf16_t* rowp = O + (size_t)(row0 + ai * HALF + m * 16) * ldc + col0;
#pragma unroll
                for (int bj = 0; bj < 2; ++bj) {
                    const f32x4 v0 = acc[ai][bj][m][0], v1 = acc[ai][bj][m][1];
                    u32x4 w; w.x = cvt_pk_bf16(v0[0], v0[1]); w.y = cvt_pk_bf16(v0[2], v0[3]); w.z = cvt_pk_bf16(v1[0], v1[1]); w.w = cvt_pk_bf16(v1[2], v1[3]);
                    *(u32x4*)(rowp + bj * HALF) = w;
                }
            }
    }
};
struct EpiLoadOnly {
    static constexpr bool PERM = true, AFTER_DRAIN = false;
    float* sink; const float* ssq; const float* tcos; const float* tsin;
    __device__ __forceinline__ void operator()(const f32x4 (&acc)[2][2][4][2], const Unit& u, int wr, int wc, int fr, int fq) const {
        const int row0 = u.pm * BM + wr * 64 + fr; const int fi = 4 * ((wc & 1) * 4 + fq);
        float rs[2][4]; rows_rstd(ssq, row0, fq, rs); float s = 0.f;
#pragma unroll
        for (int ai = 0; ai < 2; ++ai)
#pragma unroll
            for (int m = 0; m < 4; ++m) { const int row = row0 + ai * HALF + m * 16; const f32x4 c4 = *(const f32x4*)(tcos + (size_t)row * 32 + fi), s4 = *(const f32x4*)(tsin + (size_t)row * 32 + fi);
#pragma unroll
                for (int bj = 0; bj < 2; ++bj) { const f32x4 x1 = acc[ai][bj][m][0] * rs[ai][m], x2 = acc[ai][bj][m][1] * rs[ai][m]; const f32x4 y1 = x1 * c4 - x2 * s4, y2 = x2 * c4 + x1 * s4;
                    s += (y1[0] + y1[1]) + (y1[2] + y1[3]) + (y2[0] + y2[1]) + (y2[2] + y2[3]); } }
        if (s == 1.2345678e30f) sink[0] = s;
    }
};
template <class Epi, class Sched, bool ALIGN_EPI = false, bool SP2 = false>
__device__ __forceinline__ void gemm_phase(PG8_LAS unsigned char* lds, const Gemm g, const Sched& S, const Epi& E) {
    int tid = threadIdx.x; asm volatile("" : "+v"(tid));
    const int wid = __builtin_amdgcn_readfirstlane(tid >> 6), lane = tid & 63, wr = wid >> 2, wc = wid & 3, fr = lane & 15, fq = lane >> 4;
    const int K = g.K, nt = K / BK;
    unsigned voffA[2], voffB[2];
#pragma unroll
    for (int i = 0; i < 2; ++i) { int R, C; stage_rc(tid * 16 + i * 8192, R, C); const int Rb = Epi::PERM ? ((R & ~31) + perm32(R & 31)) : R;
        voffA[i] = (unsigned)((R >> 4) * 16 * K + (C >> 5) * 512 + (R & 15) * 32 + (C & 31)) * 2u;     voffB[i] = (unsigned)(Rb * K + C) * 2u; }
    const size_t kstep = (size_t)(BK * 2);
    const size_t kstepA = 2048;
    const size_t hstep = (size_t)HALF * K * 2;
    const size_t tstep = 2 * hstep;
    const unsigned ldsw = (unsigned)wid * 1024u;
    const int aoff = lds_byte(wr * 64 + fr, fq * 8), boff = lds_byte(wc * 32 + fr, fq * 8);
#define PG8_SA(b, h) (((b) * 2 + (h)) * HTB)
#define PG8_SB(b, h) ((4 + (b) * 2 + (h)) * HTB)
#define PG8_STAGE(bufoff, gbase, voff) do { _Pragma("unroll") for (int _i = 0; _i < 2; ++_i) \
        __builtin_amdgcn_global_load_lds((const unsigned*)((const char*)(gbase) + (voff)[_i]), (PG8_LAS unsigned*)(lds + (bufoff) + ldsw + _i * 8192), 16, 0, 0); } while (0)
#define PG8_LDA(dst, b, h) do { _Pragma("unroll") for (int m = 0; m < 4; ++m) _Pragma("unroll") for (int k = 0; k < 2; ++k) dst[m][k] = *(const PG8_LAS bf16x8*)(lds + PG8_SA(b, h) + aoff + m * 2048 + k * 1024); } while (0)
#define PG8_LDB(dst, b, h) do { _Pragma("unroll") for (int n = 0; n < 2; ++n) _Pragma("unroll") for (int k = 0; k < 2; ++k) dst[n][k] = *(const PG8_LAS bf16x8*)(lds + PG8_SB(b, h) + boff + n * 2048 + k * 1024); } while (0)
#define PG8_MMA(ai, bj, At, Bt) do { __builtin_amdgcn_s_setprio(1); _Pragma("unroll") for (int m = 0; m < 4; ++m) _Pragma("unroll") for (int n = 0; n < 2; ++n) _Pragma("unroll") for (int k = 0; k < 2; ++k) \
        acc[ai][bj][m][n] = __builtin_amdgcn_mfma_f32_16x16x32_bf16(Bt[n][k], At[m][k], acc[ai][bj][m][n], 0, 0, 0); __builtin_amdgcn_s_setprio(0); } while (0)
#define PG8_WAIT_V(n) asm volatile("s_waitcnt vmcnt(" #n ")" ::: "memory")
#define PG8_WAIT_L(n) asm volatile("s_waitcnt lgkmcnt(" #n ")" ::: "memory")
#define PG8_BAR __builtin_amdgcn_s_barrier()
#define PG8_SCHED __builtin_amdgcn_sched_barrier(0)
    Unit cur, nxt; int ui = 0;
    if (!S.next(0, cur)) return;
    f32x4 acc[2][2][4][2];
#pragma unroll
    for (int a = 0; a < 2; ++a)
#pragma unroll
        for (int b = 0; b < 2; ++b)
#pragma unroll
            for (int m = 0; m < 4; ++m)
#pragma unroll
                for (int n = 0; n < 2; ++n) acc[a][b][m][n] = (f32x4){0.f, 0.f, 0.f, 0.f};
    bf16x8 At[4][2], B0[2][2], B1[2][2];
    const char* cA = (const char*)g.A + (size_t)cur.pm * tstep; const char* cB = (const char*)g.Bt + (size_t)cur.pn * tstep;
    S.a_ready(cur);
    if constexpr (SP2) {
        PG8_STAGE(PG8_SB(0, 0), cB, voffB); PG8_STAGE(PG8_SB(0, 1), cB + hstep, voffB); PG8_STAGE(PG8_SA(0, 0), cA, voffA); PG8_STAGE(PG8_SA(0, 1), cA + hstep, voffA);
        if (wr == 1) PG8_BAR;
        PG8_WAIT_V(2); PG8_BAR;
        PG8_STAGE(PG8_SB(1, 0), cB + kstep, voffB); PG8_STAGE(PG8_SA(1, 0), cA + kstepA, voffA); PG8_STAGE(PG8_SB(1, 1), cB + hstep + kstep, voffB);
        PG8_WAIT_V(6); PG8_BAR;
    } else {
        PG8_STAGE(PG8_SB(0, 0), cB, voffB); PG8_STAGE(PG8_SA(0, 0), cA, voffA); PG8_STAGE(PG8_SB(0, 1), cB + hstep, voffB); PG8_STAGE(PG8_SA(0, 1), cA + hstep, voffA);
        if (wr == 1) PG8_BAR;
        PG8_WAIT_V(4); PG8_BAR;
        PG8_STAGE(PG8_SB(1, 0), cB + kstep, voffB); PG8_STAGE(PG8_SA(1, 0), cA + kstepA, voffA); PG8_STAGE(PG8_SB(1, 1), cB + hstep + kstep, voffB);
        PG8_WAIT_V(6); PG8_BAR;
    }
    for (;;) {
        const bool has_next = S.next(ui + 1, nxt);
        const char* nA = has_next ? (const char*)g.A + (size_t)nxt.pm * tstep : cA; const char* nB = has_next ? (const char*)g.Bt + (size_t)nxt.pn * tstep : cB;
        for (int t = 0; t < nt; t += 2) {
            const bool last = (t == nt - 2);
            const char* a1 = cA + (size_t)(t + 1) * kstepA;
            const char* a2 = last ? nA : cA + (size_t)(t + 2) * kstepA; const char* b2 = last ? nB : cB + (size_t)(t + 2) * kstep;
            const char* a3 = a2 + kstepA; const char* b3 = b2 + kstep;
            if (last && has_next) S.a_ready(nxt);
            if constexpr (SP2) {
            PG8_LDB(B0, 0, 0); PG8_LDB(B1, 0, 1); PG8_SCHED; PG8_LDA(At, 0, 0); PG8_STAGE(PG8_SA(1, 1), a1 + hstep, voffA);
            PG8_WAIT_V(8); PG8_WAIT_L(0); PG8_BAR; PG8_MMA(0, 0, At, B0); PG8_MMA(0, 1, At, B1); PG8_BAR; PG8_SCHED;
            PG8_LDA(At, 0, 1); PG8_STAGE(PG8_SB(0, 0), b2, voffB); PG8_STAGE(PG8_SB(0, 1), b2 + hstep, voffB); PG8_STAGE(PG8_SA(0, 0), a2, voffA);
            PG8_WAIT_V(8); PG8_WAIT_L(0); PG8_BAR; PG8_MMA(1, 0, At, B0); PG8_MMA(1, 1, At, B1); PG8_BAR; PG8_SCHED;
            PG8_LDB(B0, 1, 0); PG8_LDB(B1, 1, 1); PG8_SCHED; PG8_LDA(At, 1, 0); PG8_STAGE(PG8_SA(0, 1), a2 + hstep, voffA);
            PG8_WAIT_V(8); PG8_WAIT_L(0); PG8_BAR; PG8_MMA(0, 0, At, B0); PG8_MMA(0, 1, At, B1); PG8_BAR; PG8_SCHED;
            PG8_LDA(At, 1, 1); PG8_STAGE(PG8_SB(1, 0), b3, voffB); PG8_STAGE(PG8_SB(1, 1), b3 + hstep, voffB); PG8_STAGE(PG8_SA(1, 0), a3, voffA);
            PG8_WAIT_V(8); PG8_WAIT_L(0); PG8_BAR; PG8_MMA(1, 0, At, B0); PG8_MMA(1, 1, At, B1); PG8_BAR; PG8_SCHED;
            } else {
            PG8_LDB(B0, 0, 0); PG8_SCHED; PG8_LDA(At, 0, 0); PG8_STAGE(PG8_SA(1, 1), a1 + hstep, voffA);
            PG8_WAIT_L(8); PG8_BAR; PG8_WAIT_L(0); PG8_MMA(0, 0, At, B0); PG8_BAR; PG8_SCHED;
            PG8_LDB(B1, 0, 1); PG8_STAGE(PG8_SB(0, 0), b2, voffB);
            PG8_BAR; PG8_WAIT_L(0); PG8_MMA(0, 1, At, B1); PG8_BAR;
            PG8_LDA(At, 0, 1); PG8_STAGE(PG8_SA(0, 0), a2, voffA);
            PG8_BAR; PG8_WAIT_L(0); PG8_MMA(1, 0, At, B0); PG8_BAR; PG8_SCHED;
            PG8_STAGE(PG8_SB(0, 1), b2 + hstep, voffB);
            PG8_WAIT_V(6); PG8_BAR; PG8_MMA(1, 1, At, B1); PG8_BAR;
            PG8_LDB(B0, 1, 0); PG8_SCHED; PG8_LDA(At, 1, 0); PG8_STAGE(PG8_SA(0, 1), a2 + hstep, voffA);
            PG8_WAIT_L(8); PG8_BAR; PG8_WAIT_L(0); PG8_MMA(0, 0, At, B0); PG8_BAR; PG8_SCHED;
            PG8_LDB(B1, 1, 1); PG8_STAGE(PG8_SB(1, 0), b3, voffB);
            PG8_BAR; PG8_WAIT_L(0); PG8_MMA(0, 1, At, B1); PG8_BAR;
            PG8_LDA(At, 1, 1); PG8_STAGE(PG8_SA(1, 0), a3, voffA);
            PG8_BAR; PG8_WAIT_L(0); PG8_MMA(1, 0, At, B0); PG8_BAR; PG8_SCHED;
            PG8_STAGE(PG8_SB(1, 1), b3 + hstep, voffB);
            PG8_WAIT_V(6); PG8_BAR; PG8_MMA(1, 1, At, B1); PG8_BAR;
            }
        }
        if constexpr (ALIGN_EPI) { if (wr == 0) PG8_BAR; }
        if constexpr (!Epi::AFTER_DRAIN) { E(acc, cur, wr, wc, fr, fq); S.done(cur); }
        if (!has_next) break;
#pragma unroll
        for (int a = 0; a < 2; ++a)
#pragma unroll
            for (int b = 0; b < 2; ++b)
#pragma unroll
                for (int m = 0; m < 4; ++m)
#pragma unroll
                    for (int n = 0; n < 2; ++n) acc[a][b][m][n] = (f32x4){0.f, 0.f, 0.f, 0.f};
        cur = nxt; cA = nA; cB = nB; ++ui;
        if constexpr (ALIGN_EPI) { if (wr == 1) PG8_BAR; }
    }
    PG8_WAIT_V(0);
    if constexpr (!ALIGN_EPI) { if (wr == 0) PG8_BAR; }
    PG8_BAR;
    if constexpr (Epi::AFTER_DRAIN) { E.fused(acc, cur, wr, wc, fr, fq, lds, wid, lane); S.done(cur); }
#undef PG8_SA
#undef PG8_SB
#undef PG8_STAGE
#undef PG8_LDA
#undef PG8_LDB
#undef PG8_MMA
#undef PG8_WAIT_V
#undef PG8_WAIT_L
#undef PG8_BAR
#undef PG8_SCHED
}
}

namespace att {
typedef unsigned short bf16_t;
using bf16x8 = __attribute__((ext_vector_type(8))) short;
using s16x4  = __attribute__((ext_vector_type(4))) short;
using f32x16 = __attribute__((ext_vector_type(16))) float;
using u32x4  = __attribute__((ext_vector_type(4))) unsigned;
using f32x4a = __attribute__((ext_vector_type(4))) float;
constexpr int DV = 128, DQK = 64, NW = 8, QBLK = 32, KVBLK = 64, OLD = 1024, SEQ = 2048;
constexpr int NBUF = 4, SHM_V = KVBLK * DV * 2, SHM_K = KVBLK * DQK * 2, OFF_V = 0, OFF_K = NBUF * SHM_V, OFF_WS = OFF_K + NBUF * SHM_K, SHM_TOTAL = OFF_WS + NW * 64 * 4;
constexpr float THR2 = 11.5f;
__device__ __forceinline__ int tl(int row, int col) { return (((row >> 4) * 32 + (col >> 5)) << 9) + ((row & 15) << 5) + (col & 31); }
#define AKSW(row, colB) ((row) * 128 + ((colB) ^ ((((row) >> 1) & 7) << 4)))
#define ASBAR() __builtin_amdgcn_sched_barrier(0)
__device__ __forceinline__ int crow(int r, int hi) { return (r & 3) + 8 * (r >> 2) + 4 * hi; }
__device__ __forceinline__ unsigned cvtpk(float lo, float hi) { unsigned r; asm volatile("v_cvt_pk_bf16_f32 %0, %1, %2" : "=v"(r) : "v"(lo), "v"(hi)); return r; }

__device__ __forceinline__ float fadd_s(float a, float b) { float r; asm("v_add_f32_e32 %0, %1, %2" : "=v"(r) : "v"(a), "v"(b)); return r; }
__device__ __forceinline__ float fsub_s(float a, float b) { float r; asm("v_sub_f32_e32 %0, %1, %2" : "=v"(r) : "v"(a), "v"(b)); return r; }
template <bool FAST> __device__ __forceinline__ void partialSM(f32x16& p0, f32x16& p1, float& m_reg, float& mn, float& alpha) {
  if constexpr (FAST) {
#pragma unroll
    for (int r = 0; r < 16; ++r) p0[r] = __builtin_amdgcn_exp2f(p0[r]);
    alpha = 1.f; mn = 0.f; return;
  }
  float pmax = p0[0];
#pragma unroll
  for (int r = 1; r < 16; ++r) pmax = fmaxf(pmax, p0[r]);
#pragma unroll
  for (int r = 0; r < 16; ++r) pmax = fmaxf(pmax, p1[r]);
  { unsigned xa = __float_as_uint(pmax), xb; asm volatile("v_mov_b32 %0, %1" : "=v"(xb) : "v"(xa)); auto rr = __builtin_amdgcn_permlane32_swap(xa, xb, false, false);
    pmax = fmaxf(__uint_as_float(rr[0]), __uint_as_float(rr[1])); }
  if (__builtin_expect(__all(pmax - m_reg <= THR2), 1)) { mn = m_reg; alpha = 1.f; }
  else { mn = fmaxf(m_reg, pmax); alpha = __builtin_amdgcn_exp2f(m_reg - mn); m_reg = mn; }
#pragma unroll
  for (int r = 0; r < 16; ++r) p0[r] = fsub_s(p0[r], mn);
#pragma unroll
  for (int r = 0; r < 16; ++r) p1[r] = fsub_s(p1[r], mn);
#pragma unroll
  for (int r = 0; r < 16; ++r) p0[r] = __builtin_amdgcn_exp2f(p0[r]);
}
__device__ __forceinline__ void finishSM(f32x16& p0, f32x16& p1, float alpha, float& l_reg, bf16x8& pa0, bf16x8& pa1, bf16x8& pa2, bf16x8& pa3) {
#pragma unroll
  for (int r = 0; r < 16; ++r) p1[r] = __builtin_amdgcn_exp2f(p1[r]);
  float ps = fadd_s(p0[0], p1[0]), ps2 = fadd_s(p0[1], p1[1]);
#pragma unroll
  for (int r = 2; r < 16; r += 2) { ps = fadd_s(ps, p0[r]); ps2 = fadd_s(ps2, p0[r + 1]); }
#pragma unroll
  for (int r = 2; r < 16; r += 2) { ps = fadd_s(ps, p1[r]); ps2 = fadd_s(ps2, p1[r + 1]); }
  ps = fadd_s(ps, ps2);
  ps = lane_xor_add<32>(ps);
  l_reg = l_reg * alpha + ps;
#define APK4(P, BASE, OUT) do { unsigned a0 = cvtpk(P[BASE + 0], P[BASE + 1]), a1 = cvtpk(P[BASE + 2], P[BASE + 3]);   \
    unsigned b0 = cvtpk(P[BASE + 4], P[BASE + 5]), b1 = cvtpk(P[BASE + 6], P[BASE + 7]);                              \
    auto r0 = __builtin_amdgcn_permlane32_swap(a0, b0, false, false); auto r1 = __builtin_amdgcn_permlane32_swap(a1, b1, false, false); \
    u32x4 w = {r0[0], r1[0], r0[1], r1[1]}; OUT = *reinterpret_cast<bf16x8*>(&w); } while (0)
  APK4(p0, 0, pa0); APK4(p0, 8, pa1); APK4(p1, 0, pa2); APK4(p1, 8, pa3);
#undef APK4
}
__device__ __forceinline__ void qkt(f32x16& p0, f32x16& p1, const char* Ks, const bf16x8* qr, int r32, int hi) {
  p0 = f32x16{}; p1 = f32x16{};
#pragma unroll
  for (int d0 = 0; d0 < 4; ++d0) { const int cb = d0 * 32 + hi * 16;
    const bf16x8 b0 = *reinterpret_cast<const bf16x8*>(Ks + AKSW(r32, cb));
    const bf16x8 b1 = *reinterpret_cast<const bf16x8*>(Ks + AKSW(32 + r32, cb));
    p0 = __builtin_amdgcn_mfma_f32_32x32x16_bf16(b0, qr[d0], p0, 0, 0, 0);
    p1 = __builtin_amdgcn_mfma_f32_32x32x16_bf16(b1, qr[d0], p1, 0, 0, 0); }
}
__device__ __forceinline__ int v_st(int k, int c) { const int kk = (k & ~0xC) | ((k & 4) << 1) | ((k & 8) >> 1); return ((kk >> 3) * 4 + (c >> 5)) * 512 + ((kk & 7) * 32 + (c & 31)) * 2; }
__device__ __forceinline__ int v_rd_base(int lane) { return ((lane & 3) << 3) | (((lane >> 2) & 3) << 6) | (((lane >> 4) & 1) << 5) | (((lane >> 5) & 1) << 8); }
constexpr int v_rd_off(int d0, int ks, int half) { return d0 * 512 + ks * 4096 + half * 2048; }
template <int OFF> __device__ __forceinline__ s16x4 tr_read(int vb) {
  s16x4 r; asm volatile("ds_read_b64_tr_b16 %0, %1 offset:%2" : "=&v"(r) : "v"(vb), "i"(OFF) : "memory"); return r;
}
template <int KS> __device__ __forceinline__ void pv_step(f32x16* o, int vb, bf16x8 pa) {
  const s16x4 l0 = tr_read<v_rd_off(0, KS, 0)>(vb), h0 = tr_read<v_rd_off(0, KS, 1)>(vb), l1 = tr_read<v_rd_off(1, KS, 0)>(vb), h1 = tr_read<v_rd_off(1, KS, 1)>(vb);
  const s16x4 l2 = tr_read<v_rd_off(2, KS, 0)>(vb), h2 = tr_read<v_rd_off(2, KS, 1)>(vb), l3 = tr_read<v_rd_off(3, KS, 0)>(vb), h3 = tr_read<v_rd_off(3, KS, 1)>(vb);
  asm volatile("s_waitcnt lgkmcnt(0)" ::: "memory"); ASBAR();
#define APK(L, H) (bf16x8){L[0], L[1], L[2], L[3], H[0], H[1], H[2], H[3]}
  o[0] = __builtin_amdgcn_mfma_f32_32x32x16_bf16(pa, APK(l0, h0), o[0], 0, 0, 0);
  o[1] = __builtin_amdgcn_mfma_f32_32x32x16_bf16(pa, APK(l1, h1), o[1], 0, 0, 0);
  o[2] = __builtin_amdgcn_mfma_f32_32x32x16_bf16(pa, APK(l2, h2), o[2], 0, 0, 0);
  o[3] = __builtin_amdgcn_mfma_f32_32x32x16_bf16(pa, APK(l3, h3), o[3], 0, 0, 0);
#undef APK
}
__device__ __forceinline__ void pv_d0(f32x16* o, int vb, bf16x8 pa0, bf16x8 pa1, bf16x8 pa2, bf16x8 pa3) {
  pv_step<0>(o, vb, pa0); pv_step<1>(o, vb, pa1); pv_step<2>(o, vb, pa2); pv_step<3>(o, vb, pa3);
}

__device__ __forceinline__ void glds16(const void* gsrc, unsigned lds_dst) { unsigned keep;
  asm volatile("s_mov_b32 %0, m0\n\ts_mov_b32 m0, %2\n\ts_nop 0\n\tglobal_load_lds_dwordx4 %1, off\n\ts_mov_b32 m0, %0" : "=&s"(keep) : "v"(gsrc), "s"(lds_dst) : "memory"); }
#define AWAIT_BAR(N) asm volatile("s_waitcnt vmcnt(" #N ") lgkmcnt(0)\n\ts_barrier" ::: "memory")
template <bool FAST> __device__ __forceinline__ void attn_pass(const bf16_t* __restrict__ Qb, const bf16_t* __restrict__ Kh, const bf16_t* __restrict__ Vh, int qcol, int kcol, int vcol, char* lds, f32x16 (&o)[4]) {
  int tid = threadIdx.x; asm volatile("" : "+v"(tid));
  const int wid = tid >> 6, lane = tid & 63, r32 = lane & 31, hi = lane >> 5;
  const int wids = __builtin_amdgcn_readfirstlane(wid);
  char* V_lds = lds + OFF_V; char* K_lds = lds + OFF_K;
  float* ws = (float*)(lds + OFF_WS) + wid * 64; float* li_l = ws; float* al_l = ws + 32;
  float m_reg = -1e30f, l_reg = 0; bf16x8 qr[4];
#pragma unroll
  for (int d = 0; d < 4; ++d) o[d] = f32x16{};
#pragma unroll
  for (int d0 = 0; d0 < 4; ++d0) qr[d0] = *reinterpret_cast<const bf16x8*>(Qb + tl(wid * QBLK + r32, qcol + d0 * 16 + hi * 8));
  const int vb0 = (int)(uintptr_t)V_lds + v_rd_base(lane);
  const int krow = 8 * wid + (lane >> 3), kof = tl(krow, kcol + 8 * ((lane & 7) ^ ((krow >> 1) & 7)));
  int vof[2];
#pragma unroll
  for (int i = 0; i < 2; ++i) { const int q = 2 * wid + i, kk = (q >> 1) * 8 + ((lane >> 2) & 7), key = (kk & ~0xC) | ((kk & 4) << 1) | ((kk & 8) >> 1);
    vof[i] = tl(key, vcol + (2 * (q & 1) + (lane >> 5)) * 32 + (lane & 3) * 8); }
  const unsigned kdst = (unsigned)(uintptr_t)K_lds + wids * 1024, vdst = (unsigned)(uintptr_t)V_lds + wids * 2048;
#define ADMA(t) do { const int t_ = (t) < NT ? (t) : NT - 1; const int bb = (t) & 3; \
    glds16(Kh + (long)t_ * (KVBLK * 1024) + kof, (unsigned)__builtin_amdgcn_readfirstlane(kdst + bb * SHM_K)); \
    glds16(Vh + (long)t_ * (KVBLK * 1024) + vof[0], (unsigned)__builtin_amdgcn_readfirstlane(vdst + bb * SHM_V)); \
    glds16(Vh + (long)t_ * (KVBLK * 1024) + vof[1], (unsigned)__builtin_amdgcn_readfirstlane(vdst + bb * SHM_V + 1024)); } while (0)
#define ARESC(a) do { if (!FAST && __any((a) < 1.f)) { if (hi == 0) al_l[r32] = (a); asm volatile("s_waitcnt lgkmcnt(0)" ::: "memory"); \
    _Pragma("unroll") for (int d = 0; d < 4; ++d) _Pragma("unroll") for (int r = 0; r < 16; ++r) o[d][r] *= al_l[crow(r, hi)]; } } while (0)
  f32x16 pA0, pA1, pB0, pB1; float mnA, mnB, alA, alB; bf16x8 pa0, pa1, pa2, pa3; constexpr int NT = SEQ / KVBLK;
  ADMA(0); ADMA(1);
  AWAIT_BAR(3);
  qkt(pA0, pA1, K_lds, qr, r32, hi); partialSM<FAST>(pA0, pA1, m_reg, mnA, alA);
  ADMA(2);
  AWAIT_BAR(3);
  for (int j = 1; j + 1 < NT; j += 2) {
    ASBAR(); qkt(pB0, pB1, K_lds + (j & 3) * SHM_K, qr, r32, hi);
    finishSM(pA0, pA1, alA, l_reg, pa0, pa1, pa2, pa3); ASBAR();
    ADMA(j + 2); ASBAR();
    pv_d0(o, vb0 + ((j - 1) & 3) * SHM_V, pa0, pa1, pa2, pa3); partialSM<FAST>(pB0, pB1, m_reg, mnB, alB);
    ARESC(alB); AWAIT_BAR(3);
    ASBAR(); qkt(pA0, pA1, K_lds + ((j + 1) & 3) * SHM_K, qr, r32, hi);
    finishSM(pB0, pB1, alB, l_reg, pa0, pa1, pa2, pa3); ASBAR();
    ADMA(j + 3); ASBAR();
    pv_d0(o, vb0 + (j & 3) * SHM_V, pa0, pa1, pa2, pa3); partialSM<FAST>(pA0, pA1, m_reg, mnA, alA);
    ARESC(alA); AWAIT_BAR(3);
  }
  ASBAR(); qkt(pB0, pB1, K_lds + ((NT - 1) & 3) * SHM_K, qr, r32, hi);
  finishSM(pA0, pA1, alA, l_reg, pa0, pa1, pa2, pa3); ASBAR();
  pv_d0(o, vb0 + ((NT - 2) & 3) * SHM_V, pa0, pa1, pa2, pa3); partialSM<FAST>(pB0, pB1, m_reg, mnB, alB);
  ARESC(alB);
  finishSM(pB0, pB1, alB, l_reg, pa0, pa1, pa2, pa3); ASBAR();
  pv_d0(o, vb0 + ((NT - 1) & 3) * SHM_V, pa0, pa1, pa2, pa3);
  if (hi == 0) li_l[r32] = l_reg; asm volatile("s_waitcnt lgkmcnt(0)" ::: "memory");
#pragma unroll
  for (int r = 0; r < 16; ++r) { const float rl = __builtin_amdgcn_rcpf(li_l[crow(r, hi)]);
#pragma unroll
    for (int d = 0; d < 4; ++d) o[d][r] *= rl; }
  AWAIT_BAR(0);
#undef ADMA
#undef ARESC
}

__device__ __forceinline__ void attn_unit(int b, int h, int qb, const bf16_t* Q, const bf16_t* K, const bf16_t* V, bf16_t* O, float* stash,
                                          float lam, const float* subg, float osc, char* lds) {
  const long rowbase = (long)b * SEQ, q0 = (long)qb * 256;
  const bf16_t* Qb = Q + (rowbase + q0) * 1024; const bf16_t* Kh = K + rowbase * 1024; const bf16_t* Vh = V + rowbase * 1024;
  unsigned keep[32];
#pragma unroll 1
  for (int c = 0; c < 2; ++c) {
    f32x16 o[4];
    attn_pass<false>(Qb, Kh, Vh, h * 128 + c * 64, h * 128 + c * 64, h * 128, lds, o);
    int zz = 0; asm volatile("" : "+v"(zz));
    const int tid = (int)threadIdx.x + zz, wid = tid >> 6, lane = tid & 63, r32 = lane & 31, hi = lane >> 5;
    (void)stash;
    if (c == 0) {
#pragma unroll
      for (int d = 0; d < 4; ++d)
#pragma unroll
        for (int q = 0; q < 8; ++q) keep[d * 8 + q] = cvtpk(o[d][2 * q], o[d][2 * q + 1]);
    } else {
      float g4[4];
#pragma unroll
      for (int d = 0; d < 4; ++d) g4[d] = subg[32 * d + r32] * osc;
      bf16_t* Ow = O + (rowbase + q0 + wid * QBLK) * 1024;
#pragma unroll
      for (int q = 0; q < 4; ++q) {
        f32x4a s4[4];
#pragma unroll
        for (int d = 0; d < 4; ++d) { const unsigned w0 = keep[d * 8 + 2 * q], w1 = keep[d * 8 + 2 * q + 1];
          s4[d] = (f32x4a){__uint_as_float(w0 << 16), __uint_as_float(w0 & 0xffff0000u), __uint_as_float(w1 << 16), __uint_as_float(w1 & 0xffff0000u)}; }
#pragma unroll
        for (int j = 0; j < 4; ++j) { const int r = 4 * q + j;
          float e[4];
#pragma unroll
          for (int d = 0; d < 4; ++d) e[d] = s4[d][j] - lam * o[d][r];
          float ss = (e[0] * e[0] + e[1] * e[1]) + (e[2] * e[2] + e[3] * e[3]);
          ss = lane_xor_add<1>(ss); ss = lane_xor_add<2>(ss); ss = lane_xor_add<4>(ss); ss = lane_xor_add<8>(ss); ss = lane_xor_add<16>(ss);
          const float rs = __builtin_amdgcn_rsqf(ss * (1.0f / 128.0f) + 1e-5f);
          const int orow = crow(r, hi);
#pragma unroll
          for (int d = 0; d < 4; ++d) Ow[tiled(orow, h * 128 + d * 32 + r32, 32)] = (bf16_t)(cvtpk(e[d] * rs * g4[d], 0.f) & 0xffffu);
        }
      }
    }
  }
}
#undef AKSW
#undef ASBAR
}
#ifndef LAS
#define LAS __attribute__((address_space(3)))
#endif
#define XB_TMO      128
#define XB_XCNT(j)  (256  + 64 * (j))
#define XB_XSUB(j)  (1280 + 64 * (j))
#define XB_XGEN(j)  (2304 + 64 * (j))
#define XB_TOP      3328
#define XB_TOPGEN   3392
#define XCD_BAR_WORDS 3456
#define XB_SPIN_CAP (1u << 18)

__device__ __forceinline__ unsigned xb_ld(unsigned* p)              { return __hip_atomic_load(p, __ATOMIC_RELAXED, __HIP_MEMORY_SCOPE_AGENT); }
__device__ __forceinline__ unsigned xb_add(unsigned* p, unsigned v) { return __hip_atomic_fetch_add(p, v, __ATOMIC_RELAXED, __HIP_MEMORY_SCOPE_AGENT); }
__device__ __forceinline__ unsigned xb_xcc_id() { return (unsigned)__builtin_amdgcn_s_getreg((3 << 11) | 20) & 0xFu; }
#define XB_SPIN(cond, bar) do { unsigned _sp = 0; while (cond) { __builtin_amdgcn_s_sleep(1); \
    if ((++_sp & 255u) == 0u) { if (xb_ld(&(bar)[XB_TMO])) break; if (_sp > XB_SPIN_CAP) { atomicAdd(&(bar)[XB_TMO], 1u); break; } } } } while (0)

struct XcdBarrier {
    unsigned* bar; unsigned x;
    volatile LAS unsigned* st;
};

__device__ __forceinline__ XcdBarrier xcd_barrier_post(unsigned* bar, volatile LAS unsigned* st) {
    XcdBarrier b; b.bar = bar; b.x = xb_xcc_id(); b.st = st;
    if (threadIdx.x == 0) (void)xb_add(&bar[XB_XCNT(b.x)], 1u);
    return b;
}
__device__ __forceinline__ void xcd_barrier_complete(unsigned* bar, unsigned x, unsigned& nloc, unsigned& nx) {
    const unsigned G = gridDim.x * gridDim.y * gridDim.z;
    unsigned sum, cnt, mine, sp = 0u;
    for (;;) {
        sum = 0u; cnt = 0u; mine = 0u;
#pragma unroll
        for (unsigned j = 0; j < 16; ++j) { const unsigned c = xb_ld(&bar[XB_XCNT(j)]); sum += c; cnt += (c > 0u) ? 1u : 0u; mine = (j == x) ? c : mine; }
        if (sum == G) break;
        __builtin_amdgcn_s_sleep(1);
        if ((++sp & 255u) == 0u) { if (xb_ld(&bar[XB_TMO])) break; if (sp > XB_SPIN_CAP) { atomicAdd(&bar[XB_TMO], 1u); break; } }
    }
    nloc = mine > 0u ? mine : 1u; nx = cnt > 0u ? cnt : 1u;
}

__device__ __forceinline__ void xcd_barrier(const XcdBarrier& b) {
    asm volatile("s_waitcnt vmcnt(0)" ::: "memory");
    __syncthreads();
    if (threadIdx.x == 0) {
        unsigned* bar = b.bar;
        __builtin_amdgcn_s_waitcnt(0);
        unsigned nloc = b.st[0], nx = b.st[1];
        if (nloc == 0u) { xcd_barrier_complete(bar, b.x, nloc, nx); b.st[0] = nloc; b.st[1] = nx; }
        const unsigned old = xb_add(&bar[XB_XSUB(b.x)], 1u);
        const unsigned gen = old / nloc;
        if (old + 1u == (gen + 1u) * nloc) {
            __builtin_amdgcn_fence(__ATOMIC_RELEASE, "agent");
            asm volatile("s_waitcnt vmcnt(0)" ::: "memory");
            const unsigned og = xb_add(&bar[XB_TOP], 1u);
            const unsigned tg = og / nx;
            if (og + 1u == (tg + 1u) * nx) xb_add(&bar[XB_TOPGEN], 1u);
            else XB_SPIN(xb_ld(&bar[XB_TOPGEN]) == tg, bar);
            __builtin_amdgcn_fence(__ATOMIC_ACQUIRE, "agent");
            xb_add(&bar[XB_XGEN(b.x)], 1u);
            asm volatile("s_waitcnt vmcnt(0)" ::: "memory");
        } else {
            XB_SPIN(xb_ld(&bar[XB_XGEN(b.x)]) == gen, bar);
            __builtin_amdgcn_fence(__ATOMIC_ACQUIRE, "agent");
            asm volatile("s_waitcnt vmcnt(0)" ::: "memory");
        }
    }
    __syncthreads();
}


namespace cg = cooperative_groups;
#define LAS __attribute__((address_space(3)))
typedef unsigned short bf16;
typedef unsigned v4u __attribute__((ext_vector_type(4)));
typedef float f32x4 __attribute__((ext_vector_type(4)));
typedef short bf16x8 __attribute__((ext_vector_type(8)));
constexpr int NWAVES = 8, NTHR = 512;
constexpr int BATCH = 32, SEQ = 2048, D = 1024, M = BATCH * SEQ, FF = 2816, FF2 = 2 * FF, NH = 8;
constexpr int MH = M / 2;
constexpr size_t MiB = 1u << 20;
constexpr size_t WS_WQKV = 0, WS_WO = 6 * MiB, WS_WIN = 8 * MiB, WS_WOUT = 14 * MiB, WS_WUP0 = 16 * MiB, WS_WUP1 = 27 * MiB, WS_WDN0 = 38 * MiB, WS_WDN1 = 44 * MiB;
constexpr size_t WS_COS = 64 * MiB, WS_SIN = 72 * MiB;
constexpr size_t WS_SSQ = 80 * MiB, SSQ_BYTES = 4 * MiB;
constexpr size_t WS_CTL = 100 * MiB, CTL_BYTES = 16384;
constexpr size_t WS_XB = 104 * MiB;
constexpr size_t WS_R = 232 * MiB;
constexpr size_t WS_Q = WS_R, WS_K = WS_R + 128 * MiB, WS_V = WS_R + 256 * MiB, WS_O = WS_R + 384 * MiB;
constexpr size_t WS_G = WS_R, WS_U = WS_R + 352 * MiB;
constexpr size_t WS_HU = WS_R + 352 * MiB, WS_HP = WS_HU + 16 * MiB;
constexpr size_t WS_STASH = 936 * MiB;
constexpr size_t WS_END = 1000 * MiB;
constexpr int LDS_BYTES = 147456;
static_assert(att::SHM_TOTAL <= 131072, "attention LDS");

__device__ __forceinline__ unsigned f2bf(float f) { unsigned u = __builtin_bit_cast(unsigned, f); return (u + 0x7fffu + ((u >> 16) & 1u)) >> 16; }
__device__ __forceinline__ unsigned pk2(float lo, float hi) { return f2bf(lo) | (f2bf(hi) << 16); }
__device__ __forceinline__ float bflo(unsigned w) { return __builtin_bit_cast(float, w << 16); }
__device__ __forceinline__ float bfhi(unsigned w) { return __builtin_bit_cast(float, w & 0xffff0000u); }
__device__ __forceinline__ float wave_sum(float v) {
    v = lane_xor_add<1>(v); v = lane_xor_add<2>(v); v = lane_xor_add<4>(v); v = lane_xor_add<8>(v); v = lane_xor_add<16>(v); v = lane_xor_add<32>(v);
    return v;
}
__device__ __forceinline__ int dest_row(int mode, int n) {
    if (mode == 1 && n < 2048) { const int d = n & 63, dd = d & 31; return (n & ~63) + 8 * (dd >> 2) + (dd & 3) + ((d >> 5) << 2); }
    if (mode == 3) { if (n < D) return 2 * D + n; const int isu = n >= 2 * D ? 1 : 0, ff = n - D - isu * D, fl = ff & 127; return (ff >> 7) * 256 + 128 * ((fl >> 2) & 1) + 8 * (fl >> 3) + 4 * isu + (fl & 3); }
    if (mode == 2) { const int isval = n >= FF ? 1 : 0, ff = n - isval * FF, fl = ff & 127; return (ff >> 7) * 256 + 128 * ((fl >> 2) & 1) + 8 * (fl >> 3) + 4 * isval + (fl & 3); }
    return n;
}
__device__ __forceinline__ void transpose_item(const float* W, int K, int N, bf16* WT, const float* gk, int mode, LAS float* scr, int item, int lane) {
    const int nblk = N / 32, kb = item / nblk, nb = item % nblk, k0 = 64 * kb, n0 = 32 * nb;
    f32x4 v[8]; float g[8];
#pragma unroll
    for (int i = 0; i < 8; ++i) { const int kk = 8 * i + (lane >> 3); v[i] = *(const f32x4*)(W + (size_t)(k0 + kk) * N + n0 + 4 * (lane & 7)); g[i] = gk ? gk[k0 + kk] : 1.f; }
#pragma unroll
    for (int i = 0; i < 8; ++i) { const int kk = 8 * i + (lane >> 3); LAS float* d = scr + kk * 33 + 4 * (lane & 7);
        d[0] = v[i][0] * g[i]; d[1] = v[i][1] * g[i]; d[2] = v[i][2] * g[i]; d[3] = v[i][3] * g[i]; }
    asm volatile("s_waitcnt lgkmcnt(0)" ::: "memory");
    const int c = lane & 7;
#pragma unroll
    for (int j = 0; j < 4; ++j) { const int n = (lane >> 3) + 8 * j; const LAS float* s = scr + (8 * c) * 33 + n;
        v4u o; o.x = pk2(s[0 * 33], s[1 * 33]); o.y = pk2(s[2 * 33], s[3 * 33]); o.z = pk2(s[4 * 33], s[5 * 33]); o.w = pk2(s[6 * 33], s[7 * 33]);
        *(v4u*)(WT + (size_t)dest_row(mode, n0 + n) * K + k0 + 8 * c) = o; }
    asm volatile("s_waitcnt lgkmcnt(0)" ::: "memory");
}
__device__ __forceinline__ void sincos_cw(float a, float& s, float& c) {
    const float kf = rintf(a * 0.63661977236758134f); const int k = (int)kf;
    float r = fmaf(kf, -1.5703125f, a); r = fmaf(kf, -4.837512969970703125e-4f, r); r = fmaf(kf, -7.54978995489188216e-8f, r);
    const float z = r * r;
    const float sp = fmaf(r * z, fmaf(z, fmaf(z, -1.9515295891e-4f, 8.3321608736e-3f), -1.6666654611e-1f), r);
    const float cp = fmaf(z * z, fmaf(z, fmaf(z, 2.443315711809948e-5f, -1.388731625493765e-3f), 4.166664568298827e-2f), fmaf(z, -0.5f, 1.0f));
    const float ss = (k & 1) ? cp : sp, cc = (k & 1) ? sp : cp;
    s = (k & 2) ? -ss : ss; c = ((k + 1) & 2) ? -cc : cc;
}

struct Args {
    const float* x; const int* pos;
    const float *attn_g, *w_qkv, *lq1, *lk1, *lq2, *lk2, *subg, *w_o, *conv_g, *w_in, *conv_w, *w_out, *ffn_g, *w_up, *ffn_cw, *ffn_cb, *w_dn, *fin_g;
    float* out; unsigned char* ws;
};

__device__ __forceinline__ void ffn_fix_rows(int pm, bf16* Gm, const float* HU, const float* HP, const float* cw, int tid) {
    for (int it = tid; it < 2 * 22 * 32; it += NTHR) {
        const int q = it & 31, pn = (it >> 5) % 22, which = it / (32 * 22);
        if (which == 0 ? ((pm & 7) == 0) : ((pm & 7) == 7)) continue;
        const int j0 = 128 * (q & 1) + 8 * (q >> 1), f0 = 128 * pn + 4 * q, nb = which == 0 ? pm - 1 : pm + 1;
        const size_t hb = ((size_t)pm * 2 + which) * FF2 + pn * 256 + j0, nbb = ((size_t)nb * 2 + (1 - which)) * FF2 + pn * 256 + j0;
        const f32x4 pg = *(const f32x4*)(HP + hb), pv = *(const f32x4*)(HP + hb + 4), ug = *(const f32x4*)(HU + nbb), uv = *(const f32x4*)(HU + nbb + 4);
        const int jw = which == 0 ? 0 : 2;
        const f32x4 wg = *(const f32x4*)(cw + (size_t)jw * FF2 + f0), wv = *(const f32x4*)(cw + (size_t)jw * FF2 + FF + f0);
        const f32x4 yg = pg + wg * ug, yv = pv + wv * uv;
        unsigned long long o = (unsigned long long)pk2(pg8::silu_f(yg[0]) * yv[0], pg8::silu_f(yg[1]) * yv[1]) | ((unsigned long long)pk2(pg8::silu_f(yg[2]) * yv[2], pg8::silu_f(yg[3]) * yv[3]) << 32);
        *(unsigned long long*)(Gm + tiled(pm * 256 + (which ? 255 : 0), f0, FF >> 5)) = o;
    }
}
__device__ __forceinline__ void mixer_ew_phase(const bf16* CU, const bf16* Bq, bf16* Y, const float* cw, int gtid, int nthreads) {
    constexpr int TC = 32, NFC = D / 8, NITEM = (M / TC) * NFC, NCT = D >> 5;
    for (int it = gtid; it < NITEM; it += nthreads) {
        const int fc = it % NFC, tc = it / NFC, t0 = tc * TC, f0 = fc * 8;
        float w[3][8];
#pragma unroll
        for (int j = 0; j < 3; ++j)
#pragma unroll
            for (int h = 0; h < 2; ++h) { const f32x4 a = *(const f32x4*)(cw + (size_t)j * D + f0 + 4 * h);
#pragma unroll
                for (int e = 0; e < 4; ++e) w[j][4 * h + e] = a[e]; }
        const v4u zero = {0u, 0u, 0u, 0u};
        v4u p = (t0 % SEQ == 0) ? zero : *(const v4u*)(CU + tiled(t0 - 1, f0, NCT));
        v4u c = *(const v4u*)(CU + tiled(t0, f0, NCT));
#pragma unroll 4
        for (int i = 0; i < TC; ++i) {
            const v4u n = (i == TC - 1 && (t0 + TC) % SEQ == 0) ? zero : *(const v4u*)(CU + tiled(t0 + i + 1, f0, NCT));
            const v4u b_ = *(const v4u*)(Bq + tiled(t0 + i, f0, NCT));
            v4u o;
#pragma unroll
            for (int q = 0; q < 4; ++q) {
                const float y0 = bflo(b_[q]) * fmaf(w[0][2 * q], bflo(p[q]), fmaf(w[1][2 * q], bflo(c[q]), w[2][2 * q] * bflo(n[q])));
                const float y1 = bfhi(b_[q]) * fmaf(w[0][2 * q + 1], bfhi(p[q]), fmaf(w[1][2 * q + 1], bfhi(c[q]), w[2][2 * q + 1] * bfhi(n[q])));
                o[q] = pk2(y0, y1);
            }
            *(v4u*)(Y + tiled(t0 + i, f0, NCT)) = o;
            p = c; c = n;
        }
    }
}

#ifndef PROBE_ATTN
#define PROBE_ATTN 1
#endif
#ifndef PROBE_EW
#define PROBE_EW 1
#endif
#ifndef PROBE_QKV
#define PROBE_QKV 1
#endif
__device__ __forceinline__ int opaque_bx() { int b = blockIdx.x; asm volatile("" : "+s"(b)); return b; }
#ifndef PROBE_UP
#define PROBE_UP 1
#endif
#ifndef STAGGER_TICKS
#define STAGGER_TICKS 0
#endif
__device__ __forceinline__ void stagger_start(int ticks) {
    if (ticks <= 0) return;
    const unsigned long long t0 = __builtin_amdgcn_s_memrealtime(); const unsigned long long d = (unsigned long long)(((blockIdx.x >> 3) & 3) * ticks);
    while (__builtin_amdgcn_s_memrealtime() - t0 < d) __builtin_amdgcn_s_sleep(16);
}
typedef const __attribute__((address_space(4))) Args* CArgs;
__device__ __forceinline__ CArgs get_args() { CArgs p = (CArgs)__builtin_amdgcn_kernarg_segment_ptr(); asm volatile("" : "+s"(p)); return p; }
#define WSP(off) (a->ws + (off))
#define WUP_T(l) ((bf16*)WSP(WS_WUP0 + (size_t)(l) * (WS_WUP1 - WS_WUP0)))
#define WDN_T(l) ((bf16*)WSP(WS_WDN0 + (size_t)(l) * (WS_WDN1 - WS_WDN0)))
#define SSQ(i) ((float*)WSP(WS_SSQ + (size_t)(i) * SSQ_BYTES))
#define GEO() int tid = threadIdx.x; asm volatile("" : "+v"(tid)); const int lane = tid & 63, wave = __builtin_amdgcn_readfirstlane(tid >> 6); const int G = gridDim.x, bx = blockIdx.x; \
    const int vcu = (G % 8 == 0) ? (bx % 8) * (G / 8) + bx / 8 : bx; const int gw = vcu * NWAVES + wave, NGW = G * NWAVES, gtid = bx * NTHR + tid, NT = G * NTHR; \
    (void)lane; (void)gw; (void)NGW; (void)gtid; (void)NT; (void)vcu

__global__ void __launch_bounds__(NTHR, 2) mega_fwd(Args a_unused) {
    extern __shared__ __attribute__((aligned(16))) unsigned char lds[];
    cg::grid_group grid = cg::this_grid();
    LAS unsigned char* ldsl = (LAS unsigned char*)lds;
    volatile LAS unsigned* bst = (volatile LAS unsigned*)(ldsl + 147456 - 64);
    if (threadIdx.x < 2) bst[threadIdx.x] = 0u;
    __syncthreads();
    if (blockIdx.x == 0) { unsigned* cw0 = (unsigned*)(get_args()->ws + WS_CTL); for (int i = threadIdx.x; i < (int)(CTL_BYTES / 4); i += NTHR) cw0[i] = 0u; }
#define GRID_SYNC() xcd_barrier(bar)

#ifndef PROBE_PRO
#define PROBE_PRO 1
#endif
    for (int prep = 0; prep < PROBE_PRO; ++prep)
    {
        CArgs a = get_args(); GEO();
        bf16* Wqkv_t = (bf16*)WSP(WS_WQKV); bf16* Wo_t = (bf16*)WSP(WS_WO); bf16* Win_t = (bf16*)WSP(WS_WIN); bf16* Wout_t = (bf16*)WSP(WS_WOUT);
        float* tcos = (float*)WSP(WS_COS); float* tsin = (float*)WSP(WS_SIN); bf16* XB = (bf16*)WSP(WS_XB);
        LAS float* scr = (LAS float*)(ldsl + wave * 16384);
        constexpr int I_QKV = (D / 64) * (3 * D / 32), I_O = (D / 64) * (D / 32), I_UP = (D / 64) * (FF2 / 32), I_DN = (FF / 64) * (D / 32);
        constexpr int NITEMS = 2 * I_QKV + 2 * I_O + 2 * I_UP + 2 * I_DN;
        for (int it = gw; it < NITEMS; it += NGW) {
            int r = it;
            if (r < I_QKV) { transpose_item(a->w_qkv, D, 3 * D, Wqkv_t, a->attn_g, 1, scr, r, lane); continue; } r -= I_QKV;
            if (r < I_QKV) { transpose_item(a->w_in, D, 3 * D, Win_t, a->conv_g, 3, scr, r, lane); continue; } r -= I_QKV;
            if (r < I_O) { transpose_item(a->w_o, D, D, Wo_t, nullptr, 0, scr, r, lane); continue; } r -= I_O;
            if (r < I_O) { transpose_item(a->w_out, D, D, Wout_t, nullptr, 0, scr, r, lane); continue; } r -= I_O;
            if (r < I_UP) { transpose_item(a->w_up, D, FF2, WUP_T(0), a->ffn_g, 2, scr, r, lane); continue; } r -= I_UP;
            if (r < I_UP) { transpose_item(a->w_up + (size_t)D * FF2, D, FF2, WUP_T(1), a->ffn_g + D, 2, scr, r, lane); continue; } r -= I_UP;
            if (r < I_DN) { transpose_item(a->w_dn, FF, D, WDN_T(0), nullptr, 0, scr, r, lane); continue; } r -= I_DN;
            transpose_item(a->w_dn + (size_t)FF * D, FF, D, WDN_T(1), nullptr, 0, scr, r, lane);
        }
        const int* pos = a->pos;
        for (int i = gtid; i < M * 32; i += NT) {
            const int d = i & 31; const float inv = __builtin_amdgcn_exp2f(-(float)d * (13.287712379549449f / 32.0f));
            float s, c; sincos_cw((float)pos[i >> 5] * inv, s, c); tcos[i] = c; tsin[i] = s;
        }
        const float* x = a->x; float* ssq0 = SSQ(0);
        for (int rg = gw; rg < M / 16; rg += NGW) {
            const int row = rg * 16 + (lane >> 2); const float* xr = x + (size_t)row * D + (lane & 3) * 8; bf16* tb = XB + (size_t)rg * (32 * 512) + lane * 8; float s = 0.f;
#pragma unroll 8
            for (int ct = 0; ct < 32; ++ct) { const f32x4 p = __builtin_nontemporal_load((const f32x4*)(xr + ct * 32)), q = __builtin_nontemporal_load((const f32x4*)(xr + ct * 32 + 4));
                s += ((p.x * p.x + p.y * p.y) + (p.z * p.z + p.w * p.w)) + ((q.x * q.x + q.y * q.y) + (q.z * q.z + q.w * q.w));
                v4u o; o.x = pk2(p.x, p.y); o.y = pk2(p.z, p.w); o.z = pk2(q.x, q.y); o.w = pk2(q.z, q.w); *(v4u*)(tb + ct * 512) = o; }
            s = lane_xor_add<1>(s); s = lane_xor_add<2>(s);
            *(f32x4*)(ssq0 + (size_t)row * 16 + 4 * (lane & 3)) = (f32x4){(lane & 3) == 0 ? s : 0.f, 0.f, 0.f, 0.f};
        }
    }
    grid.sync();
    XcdBarrier bar = xcd_barrier_post((unsigned*)(get_args()->ws + WS_CTL), bst);

#ifdef PROBE_SYNC
    for (int rep = 0; rep < PROBE_SYNC; ++rep) GRID_SYNC();
#endif
    {
        CArgs a = get_args();
        pg8::Gemm g{(bf16*)WSP(WS_XB), (bf16*)WSP(WS_WQKV), M, 3 * D, D}; pg8::StaticOrder S; S.init(M, 3 * D, gridDim.x, opaque_bx());
        pg8::EpiRope E{(bf16*)WSP(WS_Q), (bf16*)WSP(WS_K), (bf16*)WSP(WS_V), SSQ(0), (float*)WSP(WS_COS), (float*)WSP(WS_SIN), 0.125f * 1.4426950408889634f};
        stagger_start(STAGGER_TICKS);
        for (int rep = 0; rep < PROBE_QKV; ++rep) pg8::gemm_phase<pg8::EpiRope, pg8::StaticOrder, true, true>(ldsl, g, S, E);
#ifdef PROBE_STORE
        { pg8::EpiStoreOnly EN{(bf16*)WSP(WS_O), 2048, 8}; pg8::gemm_phase<pg8::EpiStoreOnly, pg8::StaticOrder, true, true>(ldsl, g, S, EN); }
#endif
#ifdef PROBE_LOAD
        { pg8::EpiLoadOnly EN{(float*)WSP(WS_STASH), SSQ(0), (float*)WSP(WS_COS), (float*)WSP(WS_SIN)}; pg8::gemm_phase<pg8::EpiLoadOnly, pg8::StaticOrder, true, true>(ldsl, g, S, EN); }
#endif
#ifdef PROBE_KLOOP
        { pg8::EpiNull EN{(float*)WSP(WS_STASH)}; pg8::gemm_phase<pg8::EpiNull, pg8::StaticOrder, true, true>(ldsl, g, S, EN); }
#endif
    }
    GRID_SYNC();
    {
        CArgs a = get_args(); GEO();
        const float lambda_init = 0.8f - 0.6f * 1.0f;
        const float s1 = wave_sum(a->lq1[lane] * a->lk1[lane]), s2 = wave_sum(a->lq2[lane] * a->lk2[lane]);
        const float lam = __expf(s1) - __expf(s2) + lambda_init;
        const bf16* Qb = (const bf16*)WSP(WS_Q); const bf16* Kb = (const bf16*)WSP(WS_K); const bf16* Vb = (const bf16*)WSP(WS_V); bf16* Ob = (bf16*)WSP(WS_O);
        float* stash = (float*)WSP(WS_STASH); const float* subg = a->subg;
#pragma unroll 1
        for (int rep = 0; rep < PROBE_ATTN; ++rep)
#pragma unroll 1
        for (int i = 0;; ++i) {
            const int id = i * G + vcu; if (id >= BATCH * NH * (SEQ / 256)) break;
            const int bh = id >> 3, qb = id & 7;
            att::attn_unit(bh >> 3, bh & 7, qb, Qb, Kb, Vb, Ob, stash, lam, subg, 1.0f - lambda_init, (char*)lds);
        }
    }
    GRID_SYNC();
    {
        CArgs a = get_args();
        pg8::Gemm g{(bf16*)WSP(WS_O), (bf16*)WSP(WS_WO), M, D, D}; pg8::StaticOrder S; S.init(M, D, gridDim.x, opaque_bx());
        pg8::EpiRes<false> E{nullptr, (bf16*)WSP(WS_XB), SSQ(1)};
        pg8::gemm_phase<pg8::EpiRes<false>, pg8::StaticOrder, true, true>(ldsl, g, S, E);
    }
    GRID_SYNC();
#pragma unroll 1
    for (int layer = 0; layer < 2; ++layer) {
        if (layer == 1) {
            {   CArgs a = get_args();
                pg8::Gemm g{(bf16*)WSP(WS_XB), (bf16*)WSP(WS_WIN), M, 3 * D, D}; pg8::StaticOrder S; S.init(M, 3 * D, gridDim.x, opaque_bx());
                pg8::EpiMix E{(bf16*)WSP(WS_Q), (bf16*)WSP(WS_K), SSQ(2)};
                pg8::gemm_phase<pg8::EpiMix, pg8::StaticOrder, true, true>(ldsl, g, S, E); }
            GRID_SYNC();
            {   CArgs a = get_args(); GEO();
                mixer_ew_phase((const bf16*)WSP(WS_Q), (const bf16*)WSP(WS_K), (bf16*)WSP(WS_O), a->conv_w, gtid, NT); }
            GRID_SYNC();
            {   CArgs a = get_args();
                pg8::Gemm g{(bf16*)WSP(WS_O), (bf16*)WSP(WS_WOUT), M, D, D}; pg8::StaticOrder S; S.init(M, D, gridDim.x, opaque_bx());
                pg8::EpiRes<false> E{nullptr, (bf16*)WSP(WS_XB), SSQ(3)};
                pg8::gemm_phase<pg8::EpiRes<false>, pg8::StaticOrder, true, true>(ldsl, g, S, E); }
            GRID_SYNC();
        }
        {   CArgs a = get_args();
            pg8::Gemm g{(bf16*)WSP(WS_XB), WUP_T(layer), M, FF2, D}; pg8::StaticOrder S; S.init(M, FF2, gridDim.x, opaque_bx());
            pg8::EpiFfn E{(bf16*)WSP(WS_G), SSQ(layer == 0 ? 1 : 3), a->ffn_cw + (size_t)layer * 3 * FF2, a->ffn_cb + (size_t)layer * FF2, (float*)WSP(WS_HU), (float*)WSP(WS_HP), ldsl + 131072};
            stagger_start(STAGGER_TICKS);
            for (int rep = 0; rep < PROBE_UP; ++rep) pg8::gemm_phase<pg8::EpiFfn, pg8::StaticOrder, true, true>(ldsl, g, S, E); }
        GRID_SYNC();
        {   CArgs a = get_args();
            pg8::Gemm g{(bf16*)WSP(WS_G), WDN_T(layer), M, D, FF}; pg8::StaticOrder S; S.init(M, D, gridDim.x, opaque_bx());
            {   int tid = threadIdx.x; asm volatile("" : "+v"(tid));
                const float* cwl = a->ffn_cw + (size_t)layer * 3 * FF2;
#pragma unroll 1
                for (int i = 0;; ++i) { pg8::Unit u; if (!S.next(i, u)) break; ffn_fix_rows(u.pm, (bf16*)WSP(WS_G), (const float*)WSP(WS_HU), (const float*)WSP(WS_HP), cwl, tid); }
                __threadfence(); __syncthreads(); }
#ifdef PROBE_DOWN
            { pg8::EpiNull EN{(float*)WSP(WS_STASH)}; pg8::gemm_phase<pg8::EpiNull, pg8::StaticOrder, true, true>(ldsl, g, S, EN); }
#endif
            pg8::EpiRes<false> E{nullptr, (bf16*)WSP(WS_XB), SSQ(layer == 0 ? 2 : 4)};
            pg8::gemm_phase<pg8::EpiRes<false>, pg8::StaticOrder, true, true>(ldsl, g, S, E); }
        GRID_SYNC();
    }
    {   CArgs a = get_args(); GEO();
        float* out = a->out; const float* fg = a->fin_g; const float* ssq4 = SSQ(4); const bf16* XB = (const bf16*)WSP(WS_XB);
        for (int rg = gw; rg < M / 16; rg += NGW) {
            const int row = rg * 16 + (lane >> 2); const float rs = pg8::row_rstd(ssq4, row);
            const bf16* tb = XB + (size_t)rg * (32 * 512) + lane * 8; float* ob = out + (size_t)row * D + (lane & 3) * 8; const float* gp = fg + (lane & 3) * 8;
#pragma unroll 8
            for (int ct = 0; ct < 32; ++ct) { const v4u q = *(const v4u*)(tb + ct * 512); const f32x4 g0 = *(const f32x4*)(gp + ct * 32), g1 = *(const f32x4*)(gp + ct * 32 + 4);
                __builtin_nontemporal_store((f32x4){bflo(q.x), bfhi(q.x), bflo(q.y), bfhi(q.y)} * rs * g0, (f32x4*)(ob + ct * 32)); __builtin_nontemporal_store((f32x4){bflo(q.z), bfhi(q.z), bflo(q.w), bfhi(q.w)} * rs * g1, (f32x4*)(ob + ct * 32 + 4)); }
        }
    }
}

extern "C" void kernel_launch(void* const* d_in, const int* in_sizes, int n_in, void* d_out, int out_size, void* d_ws, size_t ws_size, hipStream_t stream) {
    static int grid = 0;
    if (grid == 0) {
        if (n_in != 20 || in_sizes[0] != M * D || out_size != M * D || ws_size < WS_END) { fprintf(stderr, "kernel_launch: shape mismatch n_in %d in0 %d out %d ws %zu\n", n_in, n_in > 0 ? in_sizes[0] : -1, out_size, ws_size); grid = -1; return; }
        int dev = 0, cus = 0, per_cu = 0;
        if (hipGetDevice(&dev) != hipSuccess || hipDeviceGetAttribute(&cus, hipDeviceAttributeMultiprocessorCount, dev) != hipSuccess) { grid = -1; return; }
        if (hipFuncSetAttribute((const void*)mega_fwd, hipFuncAttributeMaxDynamicSharedMemorySize, LDS_BYTES) != hipSuccess) { fprintf(stderr, "kernel_launch: hipFuncSetAttribute failed\n"); grid = -1; return; }
        if (hipOccupancyMaxActiveBlocksPerMultiprocessor(&per_cu, (const void*)mega_fwd, NTHR, LDS_BYTES) != hipSuccess || per_cu < 1) { fprintf(stderr, "kernel_launch: occupancy query says %d\n", per_cu); per_cu = 1; }
        (void)hipGetLastError();
        grid = cus;
    }
    if (grid < 0) return;
    Args a{};
    a.x = (const float*)d_in[0]; a.pos = (const int*)d_in[1];
    a.attn_g = (const float*)d_in[2]; a.w_qkv = (const float*)d_in[3]; a.lq1 = (const float*)d_in[4]; a.lk1 = (const float*)d_in[5]; a.lq2 = (const float*)d_in[6]; a.lk2 = (const float*)d_in[7];
    a.subg = (const float*)d_in[8]; a.w_o = (const float*)d_in[9]; a.conv_g = (const float*)d_in[10]; a.w_in = (const float*)d_in[11]; a.conv_w = (const float*)d_in[12]; a.w_out = (const float*)d_in[13];
    a.ffn_g = (const float*)d_in[14]; a.w_up = (const float*)d_in[15]; a.ffn_cw = (const float*)d_in[16]; a.ffn_cb = (const float*)d_in[17]; a.w_dn = (const float*)d_in[18]; a.fin_g = (const float*)d_in[19];
    a.out = (float*)d_out; a.ws = (unsigned char*)d_ws;
    void* args[] = {&a};
    const hipError_t e = hipLaunchCooperativeKernel((const void*)mega_fwd, dim3(grid), dim3(NTHR), args, LDS_BYTES, stream);
    if (e != hipSuccess) fprintf(stderr, "kernel_launch: cooperative launch failed: %s (grid %d)\n", hipGetErrorString(e), grid);
}
```

```cpp
#include <hip/hip_runtime.h>
#include <hip/hip_cooperative_groups.h>
#include <cstdio>
#include <cstdint>

template <int MASK> __device__ __forceinline__ float lane_xor_add(float x) {
    if constexpr (MASK == 32) {
        int l = (int)__builtin_amdgcn_mbcnt_hi(~0u, __builtin_amdgcn_mbcnt_lo(~0u, 0u)); asm volatile("" : "+v"(l));
        return x + __builtin_bit_cast(float, __builtin_amdgcn_ds_bpermute((l ^ 32) << 2, __builtin_bit_cast(int, x))); }
    else return x + __builtin_bit_cast(float, __builtin_amdgcn_ds_swizzle(__builtin_bit_cast(int, x), (MASK << 10) | 0x1F));
}
#ifndef DPP_PREV
#define DPP_PREV 0x121
#define DPP_NEXT 0x12F
#endif
#ifndef USE_NT
#define USE_NT 0
#endif
#if USE_NT
#define NT_STORE(v, p) __builtin_nontemporal_store((v), (p))
#else
#define NT_STORE(v, p) (*(p) = (v))
#endif
#ifndef QKV_LD
#define QKV_LD 1088
#endif
__device__ __forceinline__ size_t tiled(int row, int col, int nct) { return (((size_t)(row >> 4) * nct + (col >> 5)) << 9) + ((row & 15) << 5) + (col & 31); }
namespace pg8 {
#define PG8_LAS __attribute__((address_space(3)))
typedef unsigned short bf16_t;
typedef short bf16x8 __attribute__((ext_vector_type(8)));
typedef float f32x4 __attribute__((ext_vector_type(4)));
typedef unsigned u32x4 __attribute__((ext_vector_type(4)));
constexpr int BM = 256, BK = 64, HALF = 128, HTB = HALF * BK * 2  , STAGE_BYTES = 8 * HTB, NXCD = 8, WGM = 8;

__host__ __device__ __forceinline__ int lds_byte(int r, int c) { const int st = (r >> 4) * 2 + (c >> 5), rr = r & 15, cc = c & 31, ob = rr * 64 + cc * 2; return st * 1024 + (ob ^ (((ob >> 9) & 1) << 5)); }
__host__ __device__ __forceinline__ void stage_rc(int b, int& R, int& C) { const int st = b / 1024, sb = b % 1024, swz = sb ^ (((sb >> 9) & 1) << 5); R = (st >> 1) * 16 + swz / 64; C = (st & 1) * 32 + (swz % 64) / 2; }
__host__ __device__ __forceinline__ int perm32(int rho) { const int n = rho >> 4, i = rho & 15; return 8 * (i >> 2) + 4 * n + (i & 3); }

struct Unit { int pm, pn; };
struct Gemm { const bf16_t* A; const bf16_t* Bt; int M, N, K; };

struct StaticOrder {
    int nM, nN, nwg, G, c; bool rev = false;
    __host__ __device__ void init(int M, int N, int G_, int c_) { nM = M / BM; nN = N / BM; nwg = nM * nN; G = G_; c = c_; }
    __host__ __device__ bool next(int i, Unit& u) const {
        const long L = (long)i * G + c; if (L >= nwg) return false;
        int wgid = (int)L; { const int q = nwg / NXCD, r = nwg % NXCD, xcd = wgid % NXCD, off = wgid / NXCD; wgid = (xcd < r ? xcd * (q + 1) : r * (q + 1) + (xcd - r) * q) + off; }
        const int nig = WGM * nN, gid = wgid / nig, fm = gid * WGM, gsz = (nM - fm) < WGM ? (nM - fm) : WGM;
        u.pm = fm + ((wgid % nig) % gsz); u.pn = (wgid % nig) / gsz; if (rev) u.pm = nM - 1 - u.pm; return true;
    }
    __device__ __forceinline__ void a_ready(const Unit&) const {}
    __device__ __forceinline__ void done(const Unit&) const {}
};

__device__ __forceinline__ unsigned cvt_pk_bf16(float lo, float hi) { unsigned r; asm volatile("v_cvt_pk_bf16_f32 %0, %1, %2" : "=v"(r) : "v"(lo), "v"(hi)); return r; }
typedef float f32x2 __attribute__((ext_vector_type(2)));

__device__ __forceinline__ float row_rstd(const float* ssq, int row) {
    const f32x4* p = (const f32x4*)(ssq + (size_t)row * 16);
    const f32x4 a = p[0], b = p[1], c = p[2], d = p[3];
    const float s = (((a[0] + a[1]) + (a[2] + a[3])) + ((b[0] + b[1]) + (b[2] + b[3]))) + (((c[0] + c[1]) + (c[2] + c[3])) + ((d[0] + d[1]) + (d[2] + d[3])));
    return __builtin_amdgcn_rsqf(s * (1.0f / 1024.0f) + 1e-5f);
}
__device__ __forceinline__ void rows_rstd(const float* ssq, int row0, int fq, float (&rs)[2][4]) {
    f32x4 p[2][4];
#pragma unroll
    for (int ai = 0; ai < 2; ++ai)
#pragma unroll
        for (int m = 0; m < 4; ++m) p[ai][m] = *(const f32x4*)(ssq + (size_t)(row0 + ai * HALF + m * 16) * 16 + 4 * fq);
#pragma unroll
    for (int ai = 0; ai < 2; ++ai)
#pragma unroll
        for (int m = 0; m < 4; ++m) { float s = (p[ai][m][0] + p[ai][m][1]) + (p[ai][m][2] + p[ai][m][3]); s = lane_xor_add<16>(s); s = lane_xor_add<32>(s);
            rs[ai][m] = __builtin_amdgcn_rsqf(s * (1.0f / 1024.0f) + 1e-5f); }
}
struct EpiRope {
    static constexpr bool PERM = true, AFTER_DRAIN = false;
    bf16_t* Q; bf16_t* K; bf16_t* V; const float* ssq; const float* tcos; const float* tsin; float qscale;
    __device__ __forceinline__ void operator()(const f32x4 (&acc)[2][2][4][2], const Unit& u, int wr, int wc, int fr, int fq) const {
        const int t = u.pn >> 2;
        const int colt = (u.pn & 3) * BM + wc * 32 + 8 * fq;
        const int row0 = u.pm * BM + wr * 64 + fr;
        const int fi = 4 * ((wc & 1) * 4 + fq);
        float rs[2][4]; rows_rstd(ssq, row0, fq, rs);
        if (t < 2) {
            bf16_t* base = (t == 0) ? Q : K; const float sc = (t == 0) ? qscale : 1.f;
#pragma unroll
            for (int ai = 0; ai < 2; ++ai) {
                f32x4 c4[4], s4[4];
#pragma unroll
                for (int m = 0; m < 4; ++m) { const int row = row0 + ai * HALF + m * 16; c4[m] = *(const f32x4*)(tcos + (size_t)row * 32 + fi); s4[m] = *(const f32x4*)(tsin + (size_t)row * 32 + fi); }
#pragma unroll
                for (int m = 0; m < 4; ++m) {
                    const int row = row0 + ai * HALF + m * 16;
                    const float k = rs[ai][m] * sc;
                    bf16_t* rowp = base + ((size_t)(row >> 4) * 32 + (colt >> 5)) * 512 + (row & 15) * 32 + (colt & 31);
#pragma unroll
                    for (int bj = 0; bj < 2; ++bj) {
                        const f32x4 x1 = acc[ai][bj][m][0] * k, x2 = acc[ai][bj][m][1] * k;
                        const f32x4 y1 = x1 * c4[m] - x2 * s4[m], y2 = x2 * c4[m] + x1 * s4[m];
                        u32x4 w; w.x = cvt_pk_bf16(y1[0], y1[1]); w.y = cvt_pk_bf16(y1[2], y1[3]); w.z = cvt_pk_bf16(y2[0], y2[1]); w.w = cvt_pk_bf16(y2[2], y2[3]);
                        NT_STORE(w, (u32x4*)(rowp + bj * 2048));
                    }
                }
                __builtin_amdgcn_sched_barrier(0);
            }
        } else {
#pragma unroll
            for (int ai = 0; ai < 2; ++ai)
#pragma unroll
                for (int m = 0; m < 4; ++m) {
                    const int row = row0 + ai * HALF + m * 16;
                    const float k = rs[ai][m];
                    bf16_t* rowp = V + ((size_t)(row >> 4) * 32 + (colt >> 5)) * 512 + (row & 15) * 32 + (colt & 31);
#pragma unroll
                    for (int bj = 0; bj < 2; ++bj) {
                        const f32x4 v0 = acc[ai][bj][m][0] * k, v1 = acc[ai][bj][m][1] * k;
                        u32x4 w; w.x = cvt_pk_bf16(v0[0], v0[1]); w.y = cvt_pk_bf16(v0[2], v0[3]); w.z = cvt_pk_bf16(v1[0], v1[1]); w.w = cvt_pk_bf16(v1[2], v1[3]);
                        NT_STORE(w, (u32x4*)(rowp + bj * 2048));
                    }
                }
        }
    }
};
struct EpiScale {
    static constexpr bool PERM = true, AFTER_DRAIN = false;
    bf16_t* O; int ldc; const float* ssq; int row_off;
    __device__ __forceinline__ void operator()(const f32x4 (&acc)[2][2][4][2], const Unit& u, int wr, int wc, int fr, int fq) const {
        const int row0 = u.pm * BM + wr * 64 + fr, col0 = u.pn * BM + wc * 32 + 8 * fq;
        float rs[2][4]; rows_rstd(ssq, row_off + row0, fq, rs);
#pragma unroll
        for (int ai = 0; ai < 2; ++ai)
#pragma unroll
            for (int m = 0; m < 4; ++m) {
                const int row = row0 + ai * HALF + m * 16;
                const float k = rs[ai][m];
                bf16_t* rowp = O + tiled(row, col0, ldc >> 5);
#pragma unroll
                for (int bj = 0; bj < 2; ++bj) {
                    const f32x4 v0 = acc[ai][bj][m][0] * k, v1 = acc[ai][bj][m][1] * k;
                    u32x4 w; w.x = cvt_pk_bf16(v0[0], v0[1]); w.y = cvt_pk_bf16(v0[2], v0[3]); w.z = cvt_pk_bf16(v1[0], v1[1]); w.w = cvt_pk_bf16(v1[2], v1[3]);
                    NT_STORE(w, (u32x4*)(rowp + bj * 2048));
                }
            }
    }
};
struct EpiMix {
    static constexpr bool PERM = true, AFTER_DRAIN = false;
    bf16_t* CU; bf16_t* Bq; const float* ssq;
    __device__ __forceinline__ void operator()(const f32x4 (&acc)[2][2][4][2], const Unit& u, int wr, int wc, int fr, int fq) const {
        typedef unsigned u32x2m __attribute__((ext_vector_type(2)));
        const int row0 = u.pm * BM + wr * 64 + fr;
        float rs[2][4]; rows_rstd(ssq, row0, fq, rs);
        if (u.pn < 8) {
            const int f0 = u.pn * 128 + wc * 32 + 8 * fq;
#pragma unroll
            for (int ai = 0; ai < 2; ++ai)
#pragma unroll
                for (int m = 0; m < 4; ++m) { const int row = row0 + ai * HALF + m * 16; const float r2 = rs[ai][m] * rs[ai][m];
                    const f32x4 p0 = acc[ai][0][m][0] * acc[ai][0][m][1] * r2, p1 = acc[ai][1][m][0] * acc[ai][1][m][1] * r2;
                    u32x4 w; w.x = cvt_pk_bf16(p0[0], p0[1]); w.y = cvt_pk_bf16(p0[2], p0[3]); w.z = cvt_pk_bf16(p1[0], p1[1]); w.w = cvt_pk_bf16(p1[2], p1[3]);
                    *(u32x4*)(CU + tiled(row, f0, 32)) = w; }
        } else {
            const int col0 = (u.pn - 8) * BM + wc * 32 + 8 * fq;
#pragma unroll
            for (int ai = 0; ai < 2; ++ai)
#pragma unroll
                for (int m = 0; m < 4; ++m) { const int row = row0 + ai * HALF + m * 16; const float k = rs[ai][m]; bf16_t* rowp = Bq + tiled(row, col0, 32);
#pragma unroll
                    for (int bj = 0; bj < 2; ++bj) { const f32x4 v0 = acc[ai][bj][m][0] * k, v1 = acc[ai][bj][m][1] * k;
                        u32x4 w; w.x = cvt_pk_bf16(v0[0], v0[1]); w.y = cvt_pk_bf16(v0[2], v0[3]); w.z = cvt_pk_bf16(v1[0], v1[1]); w.w = cvt_pk_bf16(v1[2], v1[3]);
                        *(u32x4*)(rowp + bj * 2048) = w; } }
        }
    }
};
template <bool BASE_F32> struct EpiRes {
    static constexpr bool PERM = true, AFTER_DRAIN = false;
    const float* basef; bf16_t* xb; float* ssq_out;
    __device__ __forceinline__ void operator()(const f32x4 (&acc)[2][2][4][2], const Unit& u, int wr, int wc, int fr, int fq) const {
        const int row0 = u.pm * BM + wr * 64 + fr, col0 = u.pn * BM + wc * 32 + 8 * fq;
#pragma unroll
        for (int ai = 0; ai < 2; ++ai) {
            f32x4 bf[BASE_F32 ? 4 : 1][2][2]; u32x4 bb[BASE_F32 ? 1 : 4][2];
#pragma unroll
            for (int m = 0; m < 4; ++m) { const size_t off = (size_t)(row0 + ai * HALF + m * 16) * 1024 + col0, toff = tiled(row0 + ai * HALF + m * 16, col0, 32);
#pragma unroll
                for (int bj = 0; bj < 2; ++bj) {
                    if constexpr (BASE_F32) { bf[m][bj][0] = *(const f32x4*)(basef + off + bj * HALF); bf[m][bj][1] = *(const f32x4*)(basef + off + bj * HALF + 4); }
                    else bb[m][bj] = *(const u32x4*)(xb + toff + bj * 2048); } }
#pragma unroll
            for (int m = 0; m < 4; ++m) {
                const int row = row0 + ai * HALF + m * 16; const size_t toff = tiled(row, col0, 32); float ss = 0.f;
#pragma unroll
                for (int bj = 0; bj < 2; ++bj) {
                    f32x4 b0, b1;
                    if constexpr (BASE_F32) { b0 = bf[m][bj][0]; b1 = bf[m][bj][1]; }
                    else { const u32x4 w = bb[m][bj];
                        b0 = (f32x4){__builtin_bit_cast(float, w.x << 16), __builtin_bit_cast(float, w.x & 0xffff0000u), __builtin_bit_cast(float, w.y << 16), __builtin_bit_cast(float, w.y & 0xffff0000u)};
                        b1 = (f32x4){__builtin_bit_cast(float, w.z << 16), __builtin_bit_cast(float, w.z & 0xffff0000u), __builtin_bit_cast(float, w.w << 16), __builtin_bit_cast(float, w.w & 0xffff0000u)}; }
                    const f32x4 o0 = b0 + acc[ai][bj][m][0], o1 = b1 + acc[ai][bj][m][1];
                    ss += ((o0[0] * o0[0] + o0[1] * o0[1]) + (o0[2] * o0[2] + o0[3] * o0[3])) + ((o1[0] * o1[0] + o1[1] * o1[1]) + (o1[2] * o1[2] + o1[3] * o1[3]));
                    u32x4 w; w.x = cvt_pk_bf16(o0[0], o0[1]); w.y = cvt_pk_bf16(o0[2], o0[3]); w.z = cvt_pk_bf16(o1[0], o1[1]); w.w = cvt_pk_bf16(o1[2], o1[3]);
                    NT_STORE(w, (u32x4*)(xb + toff + bj * 2048));
                }
                ss = lane_xor_add<16>(ss); ss = lane_xor_add<32>(ss);
                if (fq == 0) ssq_out[(size_t)row * 16 + u.pn * 4 + wc] = ss;
            }
        }
    }
};
__device__ __forceinline__ float dpp_ror1_f(float x) { return __builtin_bit_cast(float, __builtin_amdgcn_update_dpp(0, __builtin_bit_cast(int, x), DPP_PREV, 0xF, 0xF, true)); }
__device__ __forceinline__ float dpp_ror15_f(float x) { return __builtin_bit_cast(float, __builtin_amdgcn_update_dpp(0, __builtin_bit_cast(int, x), DPP_NEXT, 0xF, 0xF, true)); }
__device__ __forceinline__ f32x4 dpp_ror1(f32x4 v) { f32x4 r; r.x = dpp_ror1_f(v.x); r.y = dpp_ror1_f(v.y); r.z = dpp_ror1_f(v.z); r.w = dpp_ror1_f(v.w); return r; }
__device__ __forceinline__ f32x4 dpp_ror15(f32x4 v) { f32x4 r; r.x = dpp_ror15_f(v.x); r.y = dpp_ror15_f(v.y); r.z = dpp_ror15_f(v.z); r.w = dpp_ror15_f(v.w); return r; }
__device__ __forceinline__ f32x4 sel4(bool c, f32x4 a, f32x4 b) { return (f32x4){c ? a[0] : b[0], c ? a[1] : b[1], c ? a[2] : b[2], c ? a[3] : b[3]}; }
__device__ __forceinline__ float silu_f(float g) { return g * __builtin_amdgcn_rcpf(1.f + __builtin_amdgcn_exp2f(-1.4426950408889634f * g)); }
struct EpiFfn {
    static constexpr bool PERM = true, AFTER_DRAIN = false;
    bf16_t* G; const float* ssq; const float* cw; const float* cb; float* HU; float* HP; PG8_LAS unsigned char* ex;
    __device__ __forceinline__ void operator()(f32x4 (&acc)[2][2][4][2], const Unit& u, int wr, int wc, int fr_in, int fq_in) const {
        typedef unsigned u32x2e __attribute__((ext_vector_type(2)));
        int t_ = threadIdx.x; asm volatile("" : "+v"(t_)); const int fr = t_ & 15, fq = (t_ >> 4) & 3; (void)fr_in; (void)fq_in;
        constexpr int FFc = 2816, FF2c = 5632;
        const int row0 = u.pm * BM + wr * 64 + fr;
        const bool is_first = (fr == 0), is_last = (fr == 15);
        PG8_LAS float* RS = (PG8_LAS float*)(ex + 8192); PG8_LAS float* CWL = (PG8_LAS float*)(ex + 8192 + 1024);
        {
            const int t = t_ & 511;
            if (t < 256) {
                const f32x4* p = (const f32x4*)(ssq + (size_t)(u.pm * BM + t) * 16);
                const f32x4 a = p[0], b = p[1], c = p[2], d = p[3];
                const float s = (((a[0] + a[1]) + (a[2] + a[3])) + ((b[0] + b[1]) + (b[2] + b[3]))) + (((c[0] + c[1]) + (c[2] + c[3])) + ((d[0] + d[1]) + (d[2] + d[3])));
                RS[t] = __builtin_amdgcn_rsqf(s * (1.0f / 1024.0f) + 1e-5f);
            } else {
                const int q = t - 256, p = q >> 6, jq = q & 63, n = jq & 1, wq = (jq >> 1) & 15, bjj = jq >> 5;
                const float* src = (p < 3) ? (cw + (size_t)p * FF2c) : cb;
                *(PG8_LAS f32x4*)(CWL + p * 256 + 4 * jq) = *(const f32x4*)(src + n * FFc + u.pn * 128 + 8 * wq + 4 * bjj);
            }
        }
        asm volatile("s_waitcnt lgkmcnt(0)" ::: "memory"); __builtin_amdgcn_s_barrier(); asm volatile("" ::: "memory");
#pragma unroll
        for (int ai = 0; ai < 2; ++ai)
#pragma unroll
            for (int m = 0; m < 4; ++m) { const float r = RS[wr * 64 + fr + ai * HALF + m * 16];
#pragma unroll
                for (int bj = 0; bj < 2; ++bj)
#pragma unroll
                    for (int n = 0; n < 2; ++n) acc[ai][bj][m][n] = acc[ai][bj][m][n] * r; }
        PG8_LAS float* EX = (PG8_LAS float*)ex;
        const int cj = wc * 32 + 8 * fq;
#pragma unroll
        for (int ai = 0; ai < 2; ++ai)
#pragma unroll
            for (int bj = 0; bj < 2; ++bj)
#pragma unroll
                for (int n = 0; n < 2; ++n) {
                    if (is_first) *(PG8_LAS f32x4*)(EX + ((ai * 2 + wr) * 2 + 0) * 256 + bj * 128 + cj + 4 * n) = acc[ai][bj][0][n];
                    if (is_last)  *(PG8_LAS f32x4*)(EX + ((ai * 2 + wr) * 2 + 1) * 256 + bj * 128 + cj + 4 * n) = acc[ai][bj][3][n];
                }
        asm volatile("s_waitcnt lgkmcnt(0)" ::: "memory"); __builtin_amdgcn_s_barrier(); asm volatile("" ::: "memory");
        const int f0 = u.pn * 128 + wc * 32 + 8 * fq;
        const f32x4 zero4 = {0.f, 0.f, 0.f, 0.f};
#pragma unroll
        for (int ai = 0; ai < 2; ++ai) {
            const int g = ai * 2 + wr;
            unsigned park[4][2];
#pragma unroll
            for (int bj = 0; bj < 2; ++bj) {
#pragma unroll
                for (int n = 0; n < 2; ++n) {
                    f32x4 wgt[4];
#pragma unroll
                    for (int j = 0; j < 4; ++j) wgt[j] = *(const PG8_LAS f32x4*)(CWL + j * 256 + bj * 128 + cj + 4 * n);
                    const f32x4 hp = (g == 0) ? zero4 : *(const PG8_LAS f32x4*)(EX + ((g - 1) * 2 + 1) * 256 + bj * 128 + cj + 4 * n);
                    const f32x4 hn = (g == 3) ? zero4 : *(const PG8_LAS f32x4*)(EX + ((g + 1) * 2 + 0) * 256 + bj * 128 + cj + 4 * n);
                    f32x4 r1p = hp, r15c = dpp_ror15(acc[ai][bj][0][n]);
#pragma unroll
                    for (int m = 0; m < 4; ++m) {
                        const f32x4 X = acc[ai][bj][m][n];
                        const f32x4 r1m = dpp_ror1(X);
                        const f32x4 prev = sel4(is_first, r1p, r1m); r1p = r1m;
                        const f32x4 r15n = (m < 3) ? dpp_ror15(acc[ai][bj][m < 3 ? m + 1 : 3][n]) : hn;
                        const f32x4 next = sel4(is_last, r15n, r15c); r15c = r15n;
                        const f32x4 Y = wgt[0] * prev + (wgt[1] * X + (wgt[2] * next + wgt[3]));
                        if (m == 0) { if (g == 0 && is_first) { int co = cj; asm volatile("" : "+v"(co)); const size_t hb = ((size_t)u.pm * 2 + 0) * FF2c + u.pn * 256 + bj * 128 + co + 4 * n; *(f32x4*)(HU + hb) = X; *(f32x4*)(HP + hb) = Y; } }
                        if (m == 3) { if (g == 3 && is_last) { int co = cj; asm volatile("" : "+v"(co)); const size_t hb = ((size_t)u.pm * 2 + 1) * FF2c + u.pn * 256 + bj * 128 + co + 4 * n; *(f32x4*)(HU + hb) = X; *(f32x4*)(HP + hb) = Y; } }
                        if (n == 0) acc[ai][bj][m][0] = (f32x4){silu_f(Y[0]), silu_f(Y[1]), silu_f(Y[2]), silu_f(Y[3])};
                        else { const f32x4 o = acc[ai][bj][m][0] * Y; const unsigned wl = cvt_pk_bf16(o[0], o[1]), wh = cvt_pk_bf16(o[2], o[3]);
                            if (bj == 0) { park[m][0] = wl; park[m][1] = wh; }
                            else { u32x4 w; w.x = park[m][0]; w.y = park[m][1]; w.z = wl; w.w = wh; NT_STORE(w, (u32x4*)(G + tiled(row0 + ai * HALF + m * 16, f0, FFc >> 5))); } }
                    }
                    __builtin_amdgcn_sched_barrier(0);
                }
            }
        }
    }
};
struct EpiNull {
    static constexpr bool PERM = true, AFTER_DRAIN = false;
    float* sink;
    __device__ __forceinline__ void operator()(const f32x4 (&acc)[2][2][4][2], const Unit& u, int wr, int wc, int fr, int fq) const {
        float s = 0.f;
#pragma unroll
        for (int ai = 0; ai < 2; ++ai)
#pragma unroll
            for (int bj = 0; bj < 2; ++bj)
#pragma unroll
                for (int m = 0; m < 4; ++m)
#pragma unroll
                    for (int n = 0; n < 2; ++n) s += (acc[ai][bj][m][n][0] + acc[ai][bj][m][n][1]) + (acc[ai][bj][m][n][2] + acc[ai][bj][m][n][3]);
        if (s == 1.2345678e30f) sink[0] = s;
    }
};

struct EpiStoreOnly {
    static constexpr bool PERM = true, AFTER_DRAIN = false;
    bf16_t* O; int ldc; int pn_lim;
    __device__ __forceinline__ void operator()(const f32x4 (&acc)[2][2][4][2], const Unit& u, int wr, int wc, int fr, int fq) const {
        if (u.pn >= pn_lim) return;
        const int row0 = u.pm * BM + wr * 64 + fr, col0 = u.pn * BM + wc * 32 + 8 * fq;
#pragma unroll
        for (int ai = 0; ai < 2; ++ai)
#pragma unroll
            for (int m = 0; m < 4; ++m) {
                bf16_t* rowp = O + (size_t)(row0 + ai * HALF + m * 16) * ldc + col0;
#pragma unroll
                for (int bj = 0; bj < 2; ++bj) {
                    const f32x4 v0 = acc[ai][bj][m][0], v1 = acc[ai][bj][m][1];
                    u32x4 w; w.x = cvt_pk_bf16(v0[0], v0[1]); w.y = cvt_pk_bf16(v0[2], v0[3]); w.z = cvt_pk_bf16(v1[0], v1[1]); w.w = cvt_pk_bf16(v1[2], v1[3]);
                    *(u32x4*)(rowp + bj * HALF) = w;
                }
            }
    }
};
struct EpiLoadOnly {
    static constexpr bool PERM = true, AFTER_DRAIN = false;
    float* sink; const float* ssq; const float* tcos; const float* tsin;
    __device__ __forceinline__ void operator()(const f32x4 (&acc)[2][2][4][2], const Unit& u, int wr, int wc, int fr, int fq) const {
        const int row0 = u.pm * BM + wr * 64 + fr; const int fi = 4 * ((wc & 1) * 4 + fq);
        float rs[2][4]; rows_rstd(ssq, row0, fq, rs); float s = 0.f;
#pragma unroll
        for (int ai = 0; ai < 2; ++ai)
#pragma unroll
            for (int m = 0; m < 4; ++m) { const int row = row0 + ai * HALF + m * 16; const f32x4 c4 = *(const f32x4*)(tcos + (size_t)row * 32 + fi), s4 = *(const f32x4*)(tsin + (size_t)row * 32 + fi);
#pragma unroll
                for (int bj = 0; bj < 2; ++bj) { const f32x4 x1 = acc[ai][bj][m][0] * rs[ai][m], x2 = acc[ai][bj][m][1] * rs[ai][m]; const f32x4 y1 = x1 * c4 - x2 * s4, y2 = x2 * c4 + x1 * s4;
                    s += (y1[0] + y1[1]) + (y1[2] + y1[3]) + (y2[0] + y2[1]) + (y2[2] + y2[3]); } }
        if (s == 1.2345678e30f) sink[0] = s;
    }
};
template <class Epi, class Sched, bool ALIGN_EPI = false, bool SP2 = false>
__device__ __forceinline__ void gemm_phase(PG8_LAS unsigned char* lds, const Gemm g, const Sched& S, const Epi& E) {
    int tid = threadIdx.x; asm volatile("" : "+v"(tid));
    const int wid = __builtin_amdgcn_readfirstlane(tid >> 6), lane = tid & 63, wr = wid >> 2, wc = wid & 3, fr = lane & 15, fq = lane >> 4;
    const int K = g.K, nt = K / BK;
    unsigned voffA[2], voffB[2];
#pragma unroll
    for (int i = 0; i < 2; ++i) { int R, C; stage_rc(tid * 16 + i * 8192, R, C); const int Rb = Epi::PERM ? ((R & ~31) + perm32(R & 31)) : R;
        voffA[i] = (unsigned)((R >> 4) * 16 * K + (C >> 5) * 512 + (R & 15) * 32 + (C & 31)) * 2u;     voffB[i] = (unsigned)(Rb * K + C) * 2u; }
    const size_t kstep = (size_t)(BK * 2);
    const size_t kstepA = 2048;
    const size_t hstep = (size_t)HALF * K * 2;
    const size_t tstep = 2 * hstep;
    const unsigned ldsw = (unsigned)wid * 1024u;
    const int aoff = lds_byte(wr * 64 + fr, fq * 8), boff = lds_byte(wc * 32 + fr, fq * 8);
#define PG8_SA(b, h) (((b) * 2 + (h)) * HTB)
#define PG8_SB(b, h) ((4 + (b) * 2 + (h)) * HTB)
#define PG8_STAGE(bufoff, gbase, voff) do { _Pragma("unroll") for (int _i = 0; _i < 2; ++_i) \
        __builtin_amdgcn_global_load_lds((const unsigned*)((const char*)(gbase) + (voff)[_i]), (PG8_LAS unsigned*)(lds + (bufoff) + ldsw + _i * 8192), 16, 0, 0); } while (0)
#define PG8_LDA(dst, b, h) do { _Pragma("unroll") for (int m = 0; m < 4; ++m) _Pragma("unroll") for (int k = 0; k < 2; ++k) dst[m][k] = *(const PG8_LAS bf16x8*)(lds + PG8_SA(b, h) + aoff + m * 2048 + k * 1024); } while (0)
#define PG8_LDB(dst, b, h) do { _Pragma("unroll") for (int n = 0; n < 2; ++n) _Pragma("unroll") for (int k = 0; k < 2; ++k) dst[n][k] = *(const PG8_LAS bf16x8*)(lds + PG8_SB(b, h) + boff + n * 2048 + k * 1024); } while (0)
#define PG8_MMA(ai, bj, At, Bt) do { __builtin_amdgcn_s_setprio(1); _Pragma("unroll") for (int m = 0; m < 4; ++m) _Pragma("unroll") for (int n = 0; n < 2; ++n) _Pragma("unroll") for (int k = 0; k < 2; ++k) \
        acc[ai][bj][m][n] = __builtin_amdgcn_mfma_f32_16x16x32_bf16(Bt[n][k], At[m][k], acc[ai][bj][m][n], 0, 0, 0); __builtin_amdgcn_s_setprio(0); } while (0)
#define PG8_WAIT_V(n) asm volatile("s_waitcnt vmcnt(" #n ")" ::: "memory")
#define PG8_WAIT_L(n) asm volatile("s_waitcnt lgkmcnt(" #n ")" ::: "memory")
#define PG8_BAR __builtin_amdgcn_s_barrier()
#define PG8_SCHED __builtin_amdgcn_sched_barrier(0)
    Unit cur, nxt; int ui = 0;
    if (!S.next(0, cur)) return;
    f32x4 acc[2][2][4][2];
#pragma unroll
    for (int a = 0; a < 2; ++a)
#pragma unroll
        for (int b = 0; b < 2; ++b)
#pragma unroll
            for (int m = 0; m < 4; ++m)
#pragma unroll
                for (int n = 0; n < 2; ++n) acc[a][b][m][n] = (f32x4){0.f, 0.f, 0.f, 0.f};
    bf16x8 At[4][2], B0[2][2], B1[2][2];
    const char* cA = (const char*)g.A + (size_t)cur.pm * tstep; const char* cB = (const char*)g.Bt + (size_t)cur.pn * tstep;
    S.a_ready(cur);
    if constexpr (SP2) {
        PG8_STAGE(PG8_SB(0, 0), cB, voffB); PG8_STAGE(PG8_SB(0, 1), cB + hstep, voffB); PG8_STAGE(PG8_SA(0, 0), cA, voffA); PG8_STAGE(PG8_SA(0, 1), cA + hstep, voffA);
        if (wr == 1) PG8_BAR;
        PG8_WAIT_V(2); PG8_BAR;
        PG8_STAGE(PG8_SB(1, 0), cB + kstep, voffB); PG8_STAGE(PG8_SA(1, 0), cA + kstepA, voffA); PG8_STAGE(PG8_SB(1, 1), cB + hstep + kstep, voffB);
        PG8_WAIT_V(6); PG8_BAR;
    } else {
        PG8_STAGE(PG8_SB(0, 0), cB, voffB); PG8_STAGE(PG8_SA(0, 0), cA, voffA); PG8_STAGE(PG8_SB(0, 1), cB + hstep, voffB); PG8_STAGE(PG8_SA(0, 1), cA + hstep, voffA);
        if (wr == 1) PG8_BAR;
        PG8_WAIT_V(4); PG8_BAR;
        PG8_STAGE(PG8_SB(1, 0), cB + kstep, voffB); PG8_STAGE(PG8_SA(1, 0), cA + kstepA, voffA); PG8_STAGE(PG8_SB(1, 1), cB + hstep + kstep, voffB);
        PG8_WAIT_V(6); PG8_BAR;
    }
    for (;;) {
        const bool has_next = S.next(ui + 1, nxt);
        const char* nA = has_next ? (const char*)g.A + (size_t)nxt.pm * tstep : cA; const char* nB = has_next ? (const char*)g.Bt + (size_t)nxt.pn * tstep : cB;
        for (int t = 0; t < nt; t += 2) {
            const bool last = (t == nt - 2);
            const char* a1 = cA + (size_t)(t + 1) * kstepA;
            const char* a2 = last ? nA : cA + (size_t)(t + 2) * kstepA; const char* b2 = last ? nB : cB + (size_t)(t + 2) * kstep;
            const char* a3 = a2 + kstepA; const char* b3 = b2 + kstep;
            if (last && has_next) S.a_ready(nxt);
            if constexpr (SP2) {
            PG8_LDB(B0, 0, 0); PG8_LDB(B1, 0, 1); PG8_SCHED; PG8_LDA(At, 0, 0); PG8_STAGE(PG8_SA(1, 1), a1 + hstep, voffA);
            PG8_WAIT_V(8); PG8_WAIT_L(0); PG8_BAR; PG8_MMA(0, 0, At, B0); PG8_MMA(0, 1, At, B1); PG8_BAR; PG8_SCHED;
            PG8_LDA(At, 0, 1); PG8_STAGE(PG8_SB(0, 0), b2, voffB); PG8_STAGE(PG8_SB(0, 1), b2 + hstep, voffB); PG8_STAGE(PG8_SA(0, 0), a2, voffA);
            PG8_WAIT_V(8); PG8_WAIT_L(0); PG8_BAR; PG8_MMA(1, 0, At, B0); PG8_MMA(1, 1, At, B1); PG8_BAR; PG8_SCHED;
            PG8_LDB(B0, 1, 0); PG8_LDB(B1, 1, 1); PG8_SCHED; PG8_LDA(At, 1, 0); PG8_STAGE(PG8_SA(0, 1), a2 + hstep, voffA);
            PG8_WAIT_V(8); PG8_WAIT_L(0); PG8_BAR; PG8_MMA(0, 0, At, B0); PG8_MMA(0, 1, At, B1); PG8_BAR; PG8_SCHED;
            PG8_LDA(At, 1, 1); PG8_STAGE(PG8_SB(1, 0), b3, voffB); PG8_STAGE(PG8_SB(1, 1), b3 + hstep, voffB); PG8_STAGE(PG8_SA(1, 0), a3, voffA);
            PG8_WAIT_V(8); PG8_WAIT_L(0); PG8_BAR; PG8_MMA(1, 0, At, B0); PG8_MMA(1, 1, At, B1); PG8_BAR; PG8_SCHED;
            } else {
            PG8_LDB(B0, 0, 0); PG8_SCHED; PG8_LDA(At, 0, 0); PG8_STAGE(PG8_SA(1, 1), a1 + hstep, voffA);
            PG8_WAIT_L(8); PG8_BAR; PG8_WAIT_L(0); PG8_MMA(0, 0, At, B0); PG8_BAR; PG8_SCHED;
            PG8_LDB(B1, 0, 1); PG8_STAGE(PG8_SB(0, 0), b2, voffB);
            PG8_BAR; PG8_WAIT_L(0); PG8_MMA(0, 1, At, B1); PG8_BAR;
            PG8_LDA(At, 0, 1); PG8_STAGE(PG8_SA(0, 0), a2, voffA);
            PG8_BAR; PG8_WAIT_L(0); PG8_MMA(1, 0, At, B0); PG8_BAR; PG8_SCHED;
            PG8_STAGE(PG8_SB(0, 1), b2 + hstep, voffB);
            PG8_WAIT_V(6); PG8_BAR; PG8_MMA(1, 1, At, B1); PG8_BAR;
            PG8_LDB(B0, 1, 0); PG8_SCHED; PG8_LDA(At, 1, 0); PG8_STAGE(PG8_SA(0, 1), a2 + hstep, voffA);
            PG8_WAIT_L(8); PG8_BAR; PG8_WAIT_L(0); PG8_MMA(0, 0, At, B0); PG8_BAR; PG8_SCHED;
            PG8_LDB(B1, 1, 1); PG8_STAGE(PG8_SB(1, 0), b3, voffB);
            PG8_BAR; PG8_WAIT_L(0); PG8_MMA(0, 1, At, B1); PG8_BAR;
            PG8_LDA(At, 1, 1); PG8_STAGE(PG8_SA(1, 0), a3, voffA);
            PG8_BAR; PG8_WAIT_L(0); PG8_MMA(1, 0, At, B0); PG8_BAR; PG8_SCHED;
            PG8_STAGE(PG8_SB(1, 1), b3 + hstep, voffB);
            PG8_WAIT_V(6); PG8_BAR; PG8_MMA(1, 1, At, B1); PG8_BAR;
            }
        }
        if constexpr (ALIGN_EPI) { if (wr == 0) PG8_BAR; }
        if constexpr (!Epi::AFTER_DRAIN) { E(acc, cur, wr, wc, fr, fq); S.done(cur); }
        if (!has_next) break;
#pragma unroll
        for (int a = 0; a < 2; ++a)
#pragma unroll
            for (int b = 0; b < 2; ++b)
#pragma unroll
                for (int m = 0; m < 4; ++m)
#pragma unroll
                    for (int n = 0; n < 2; ++n) acc[a][b][m][n] = (f32x4){0.f, 0.f, 0.f, 0.f};
        cur = nxt; cA = nA; cB = nB; ++ui;
        if constexpr (ALIGN_EPI) { if (wr == 1) PG8_BAR; }
    }
    PG8_WAIT_V(0);
    if constexpr (!ALIGN_EPI) { if (wr == 0) PG8_BAR; }
    PG8_BAR;
    if constexpr (Epi::AFTER_DRAIN) { E.fused(acc, cur, wr, wc, fr, fq, lds, wid, lane); S.done(cur); }
#undef PG8_SA
#undef PG8_SB
#undef PG8_STAGE
#undef PG8_LDA
#undef PG8_LDB
#undef PG8_MMA
#undef PG8_WAIT_V
#undef PG8_WAIT_L
#undef PG8_BAR
#undef PG8_SCHED
}
}

namespace att {
typedef unsigned short bf16_t;
using bf16x8 = __attribute__((ext_vector_type(8))) short;
using s16x4  = __attribute__((ext_vector_type(4))) short;
using f32x16 = __attribute__((ext_vector_type(16))) float;
using u32x4  = __attribute__((ext_vector_type(4))) unsigned;
using f32x4a = __attribute__((ext_vector_type(4))) float;
constexpr int DV = 128, DQK = 64, NW = 8, QBLK = 32, KVBLK = 64, OLD = 1024, SEQ = 2048;
constexpr int NBUF = 4, SHM_V = KVBLK * DV * 2, SHM_K = KVBLK * DQK * 2, OFF_V = 0, OFF_K = NBUF * SHM_V, OFF_WS = OFF_K + NBUF * SHM_K, SHM_TOTAL = OFF_WS + NW * 64 * 4;
constexpr float THR2 = 11.5f;
__device__ __forceinline__ int tl(int row, int col) { return (((row >> 4) * 32 + (col >> 5)) << 9) + ((row & 15) << 5) + (col & 31); }
#define AKSW(row, colB) ((row) * 128 + ((colB) ^ ((((row) >> 1) & 7) << 4)))
#define ASBAR() __builtin_amdgcn_sched_barrier(0)
__device__ __forceinline__ int crow(int r, int hi) { return (r & 3) + 8 * (r >> 2) + 4 * hi; }
__device__ __forceinline__ unsigned cvtpk(float lo, float hi) { unsigned r; asm volatile("v_cvt_pk_bf16_f32 %0, %1, %2" : "=v"(r) : "v"(lo), "v"(hi)); return r; }

__device__ __forceinline__ float fadd_s(float a, float b) { float r; asm("v_add_f32_e32 %0, %1, %2" : "=v"(r) : "v"(a), "v"(b)); return r; }
__device__ __forceinline__ float fsub_s(float a, float b) { float r; asm("v_sub_f32_e32 %0, %1, %2" : "=v"(r) : "v"(a), "v"(b)); return r; }
template <bool FAST> __device__ __forceinline__ void partialSM(f32x16& p0, f32x16& p1, float& m_reg, float& mn, float& alpha) {
  if constexpr (FAST) {
#pragma unroll
    for (int r = 0; r < 16; ++r) p0[r] = __builtin_amdgcn_exp2f(p0[r]);
    alpha = 1.f; mn = 0.f; return;
  }
  float pmax = p0[0];
#pragma unroll
  for (int r = 1; r < 16; ++r) pmax = fmaxf(pmax, p0[r]);
#pragma unroll
  for (int r = 0; r < 16; ++r) pmax = fmaxf(pmax, p1[r]);
  { unsigned xa = __float_as_uint(pmax), xb; asm volatile("v_mov_b32 %0, %1" : "=v"(xb) : "v"(xa)); auto rr = __builtin_amdgcn_permlane32_swap(xa, xb, false, false);
    pmax = fmaxf(__uint_as_float(rr[0]), __uint_as_float(rr[1])); }
  if (__builtin_expect(__all(pmax - m_reg <= THR2), 1)) { mn = m_reg; alpha = 1.f; }
  else { mn = fmaxf(m_reg, pmax); alpha = __builtin_amdgcn_exp2f(m_reg - mn); m_reg = mn; }
#pragma unroll
  for (int r = 0; r < 16; ++r) p0[r] = fsub_s(p0[r], mn);
#pragma unroll
  for (int r = 0; r < 16; ++r) p1[r] = fsub_s(p1[r], mn);
#pragma unroll
  for (int r = 0; r < 16; ++r) p0[r] = __builtin_amdgcn_exp2f(p0[r]);
}
__device__ __forceinline__ void finishSM(f32x16& p0, f32x16& p1, float alpha, float& l_reg, bf16x8& pa0, bf16x8& pa1, bf16x8& pa2, bf16x8& pa3) {
#pragma unroll
  for (int r = 0; r < 16; ++r) p1[r] = __builtin_amdgcn_exp2f(p1[r]);
  float ps = fadd_s(p0[0], p1[0]), ps2 = fadd_s(p0[1], p1[1]);
#pragma unroll
  for (int r = 2; r < 16; r += 2) { ps = fadd_s(ps, p0[r]); ps2 = fadd_s(ps2, p0[r + 1]); }
#pragma unroll
  for (int r = 2; r < 16; r += 2) { ps = fadd_s(ps, p1[r]); ps2 = fadd_s(ps2, p1[r + 1]); }
  ps = fadd_s(ps, ps2);
  ps = lane_xor_add<32>(ps);
  l_reg = l_reg * alpha + ps;
#define APK4(P, BASE, OUT) do { unsigned a0 = cvtpk(P[BASE + 0], P[BASE + 1]), a1 = cvtpk(P[BASE + 2], P[BASE + 3]);   \
    unsigned b0 = cvtpk(P[BASE + 4], P[BASE + 5]), b1 = cvtpk(P[BASE + 6], P[BASE + 7]);                              \
    auto r0 = __builtin_amdgcn_permlane32_swap(a0, b0, false, false); auto r1 = __builtin_amdgcn_permlane32_swap(a1, b1, false, false); \
    u32x4 w = {r0[0], r1[0], r0[1], r1[1]}; OUT = *reinterpret_cast<bf16x8*>(&w); } while (0)
  APK4(p0, 0, pa0); APK4(p0, 8, pa1); APK4(p1, 0, pa2); APK4(p1, 8, pa3);
#undef APK4
}
__device__ __forceinline__ void qkt(f32x16& p0, f32x16& p1, const char* Ks, const bf16x8* qr, int r32, int hi) {
  p0 = f32x16{}; p1 = f32x16{};
#pragma unroll
  for (int d0 = 0; d0 < 4; ++d0) { const int cb = d0 * 32 + hi * 16;
    const bf16x8 b0 = *reinterpret_cast<const bf16x8*>(Ks + AKSW(r32, cb));
    const bf16x8 b1 = *reinterpret_cast<const bf16x8*>(Ks + AKSW(32 + r32, cb));
    p0 = __builtin_amdgcn_mfma_f32_32x32x16_bf16(b0, qr[d0], p0, 0, 0, 0);
    p1 = __builtin_amdgcn_mfma_f32_32x32x16_bf16(b1, qr[d0], p1, 0, 0, 0); }
}
__device__ __forceinline__ int v_st(int k, int c) { const int kk = (k & ~0xC) | ((k & 4) << 1) | ((k & 8) >> 1); return ((kk >> 3) * 4 + (c >> 5)) * 512 + ((kk & 7) * 32 + (c & 31)) * 2; }
__device__ __forceinline__ int v_rd_base(int lane) { return ((lane & 3) << 3) | (((lane >> 2) & 3) << 6) | (((lane >> 4) & 1) << 5) | (((lane >> 5) & 1) << 8); }
constexpr int v_rd_off(int d0, int ks, int half) { return d0 * 512 + ks * 4096 + half * 2048; }
template <int OFF> __device__ __forceinline__ s16x4 tr_read(int vb) {
  s16x4 r; asm volatile("ds_read_b64_tr_b16 %0, %1 offset:%2" : "=&v"(r) : "v"(vb), "i"(OFF) : "memory"); return r;
}
template <int KS> __device__ __forceinline__ void pv_step(f32x16* o, int vb, bf16x8 pa) {
  const s16x4 l0 = tr_read<v_rd_off(0, KS, 0)>(vb), h0 = tr_read<v_rd_off(0, KS, 1)>(vb), l1 = tr_read<v_rd_off(1, KS, 0)>(vb), h1 = tr_read<v_rd_off(1, KS, 1)>(vb);
  const s16x4 l2 = tr_read<v_rd_off(2, KS, 0)>(vb), h2 = tr_read<v_rd_off(2, KS, 1)>(vb), l3 = tr_read<v_rd_off(3, KS, 0)>(vb), h3 = tr_read<v_rd_off(3, KS, 1)>(vb);
  asm volatile("s_waitcnt lgkmcnt(0)" ::: "memory"); ASBAR();
#define APK(L, H) (bf16x8){L[0], L[1], L[2], L[3], H[0], H[1], H[2], H[3]}
  o[0] = __builtin_amdgcn_mfma_f32_32x32x16_bf16(pa, APK(l0, h0), o[0], 0, 0, 0);
  o[1] = __builtin_amdgcn_mfma_f32_32x32x16_bf16(pa, APK(l1, h1), o[1], 0, 0, 0);
  o[2] = __builtin_amdgcn_mfma_f32_32x32x16_bf16(pa, APK(l2, h2), o[2], 0, 0, 0);
  o[3] = __builtin_amdgcn_mfma_f32_32x32x16_bf16(pa, APK(l3, h3), o[3], 0, 0, 0);
#undef APK
}
__device__ __forceinline__ void pv_d0(f32x16* o, int vb, bf16x8 pa0, bf16x8 pa1, bf16x8 pa2, bf16x8 pa3) {
  pv_step<0>(o, vb, pa0); pv_step<1>(o, vb, pa1); pv_step<2>(o, vb, pa2); pv_step<3>(o, vb, pa3);
}

__device__ __forceinline__ void glds16(const void* gsrc, unsigned lds_dst) { unsigned keep;
  asm volatile("s_mov_b32 %0, m0\n\ts_mov_b32 m0, %2\n\ts_nop 0\n\tglobal_load_lds_dwordx4 %1, off\n\ts_mov_b32 m0, %0" : "=&s"(keep) : "v"(gsrc), "s"(lds_dst) : "memory"); }
#define AWAIT_BAR(N) asm volatile("s_waitcnt vmcnt(" #N ") lgkmcnt(0)\n\ts_barrier" ::: "memory")
template <bool FAST> __device__ __forceinline__ void attn_pass(const bf16_t* __restrict__ Qb, const bf16_t* __restrict__ Kh, const bf16_t* __restrict__ Vh, int qcol, int kcol, int vcol, char* lds, f32x16 (&o)[4]) {
  int tid = threadIdx.x; asm volatile("" : "+v"(tid));
  const int wid = tid >> 6, lane = tid & 63, r32 = lane & 31, hi = lane >> 5;
  const int wids = __builtin_amdgcn_readfirstlane(wid);
  char* V_lds = lds + OFF_V; char* K_lds = lds + OFF_K;
  float* ws = (float*)(lds + OFF_WS) + wid * 64; float* li_l = ws; float* al_l = ws + 32;
  float m_reg = -1e30f, l_reg = 0; bf16x8 qr[4];
#pragma unroll
  for (int d = 0; d < 4; ++d) o[d] = f32x16{};
#pragma unroll
  for (int d0 = 0; d0 < 4; ++d0) qr[d0] = *reinterpret_cast<const bf16x8*>(Qb + tl(wid * QBLK + r32, qcol + d0 * 16 + hi * 8));
  const int vb0 = (int)(uintptr_t)V_lds + v_rd_base(lane);
  const int krow = 8 * wid + (lane >> 3), kof = tl(krow, kcol + 8 * ((lane & 7) ^ ((krow >> 1) & 7)));
  int vof[2];
#pragma unroll
  for (int i = 0; i < 2; ++i) { const int q = 2 * wid + i, kk = (q >> 1) * 8 + ((lane >> 2) & 7), key = (kk & ~0xC) | ((kk & 4) << 1) | ((kk & 8) >> 1);
    vof[i] = tl(key, vcol + (2 * (q & 1) + (lane >> 5)) * 32 + (lane & 3) * 8); }
  const unsigned kdst = (unsigned)(uintptr_t)K_lds + wids * 1024, vdst = (unsigned)(uintptr_t)V_lds + wids * 2048;
#define ADMA(t) do { const int t_ = (t) < NT ? (t) : NT - 1; const int bb = (t) & 3; \
    glds16(Kh + (long)t_ * (KVBLK * 1024) + kof, (unsigned)__builtin_amdgcn_readfirstlane(kdst + bb * SHM_K)); \
    glds16(Vh + (long)t_ * (KVBLK * 1024) + vof[0], (unsigned)__builtin_amdgcn_readfirstlane(vdst + bb * SHM_V)); \
    glds16(Vh + (long)t_ * (KVBLK * 1024) + vof[1], (unsigned)__builtin_amdgcn_readfirstlane(vdst + bb * SHM_V + 1024)); } while (0)
#define ARESC(a) do { if (!FAST && __any((a) < 1.f)) { if (hi == 0) al_l[r32] = (a); asm volatile("s_waitcnt lgkmcnt(0)" ::: "memory"); \
    _Pragma("unroll") for (int d = 0; d < 4; ++d) _Pragma("unroll") for (int r = 0; r < 16; ++r) o[d][r] *= al_l[crow(r, hi)]; } } while (0)
  f32x16 pA0, pA1, pB0, pB1; float mnA, mnB, alA, alB; bf16x8 pa0, pa1, pa2, pa3; constexpr int NT = SEQ / KVBLK;
  ADMA(0); ADMA(1);
  AWAIT_BAR(3);
  qkt(pA0, pA1, K_lds, qr, r32, hi); partialSM<FAST>(pA0, pA1, m_reg, mnA, alA);
  ADMA(2);
  AWAIT_BAR(3);
  for (int j = 1; j + 1 < NT; j += 2) {
    ASBAR(); qkt(pB0, pB1, K_lds + (j & 3) * SHM_K, qr, r32, hi);
    finishSM(pA0, pA1, alA, l_reg, pa0, pa1, pa2, pa3); ASBAR();
    ADMA(j + 2); ASBAR();
    pv_d0(o, vb0 + ((j - 1) & 3) * SHM_V, pa0, pa1, pa2, pa3); partialSM<FAST>(pB0, pB1, m_reg, mnB, alB);
    ARESC(alB); AWAIT_BAR(3);
    ASBAR(); qkt(pA0, pA1, K_lds + ((j + 1) & 3) * SHM_K, qr, r32, hi);
    finishSM(pB0, pB1, alB, l_reg, pa0, pa1, pa2, pa3); ASBAR();
    ADMA(j + 3); ASBAR();
    pv_d0(o, vb0 + (j & 3) * SHM_V, pa0, pa1, pa2, pa3); partialSM<FAST>(pA0, pA1, m_reg, mnA, alA);
    ARESC(alA); AWAIT_BAR(3);
  }
  ASBAR(); qkt(pB0, pB1, K_lds + ((NT - 1) & 3) * SHM_K, qr, r32, hi);
  finishSM(pA0, pA1, alA, l_reg, pa0, pa1, pa2, pa3); ASBAR();
  pv_d0(o, vb0 + ((NT - 2) & 3) * SHM_V, pa0, pa1, pa2, pa3); partialSM<FAST>(pB0, pB1, m_reg, mnB, alB);
  ARESC(alB);
  finishSM(pB0, pB1, alB, l_reg, pa0, pa1, pa2, pa3); ASBAR();
  pv_d0(o, vb0 + ((NT - 1) & 3) * SHM_V, pa0, pa1, pa2, pa3);
  if (hi == 0) li_l[r32] = l_reg; asm volatile("s_waitcnt lgkmcnt(0)" ::: "memory");
#pragma unroll
  for (int r = 0; r < 16; ++r) { const float rl = __builtin_amdgcn_rcpf(li_l[crow(r, hi)]);
#pragma unroll
    for (int d = 0; d < 4; ++d) o[d][r] *= rl; }
  AWAIT_BAR(0);
#undef ADMA
#undef ARESC
}

__device__ __forceinline__ void attn_unit(int b, int h, int qb, const bf16_t* Q, const bf16_t* K, const bf16_t* V, bf16_t* O, float* stash,
                                          float lam, const float* subg, float osc, char* lds) {
  const long rowbase = (long)b * SEQ, q0 = (long)qb * 256;
  const bf16_t* Qb = Q + (rowbase + q0) * 1024; const bf16_t* Kh = K + rowbase * 1024; const bf16_t* Vh = V + rowbase * 1024;
  unsigned keep[32];
#pragma unroll 1
  for (int c = 0; c < 2; ++c) {
    f32x16 o[4];
    attn_pass<false>(Qb, Kh, Vh, h * 128 + c * 64, h * 128 + c * 64, h * 128, lds, o);
    int zz = 0; asm volatile("" : "+v"(zz));
    const int tid = (int)threadIdx.x + zz, wid = tid >> 6, lane = tid & 63, r32 = lane & 31, hi = lane >> 5;
    (void)stash;
    if (c == 0) {
#pragma unroll
      for (int d = 0; d < 4; ++d)
#pragma unroll
        for (int q = 0; q < 8; ++q) keep[d * 8 + q] = cvtpk(o[d][2 * q], o[d][2 * q + 1]);
    } else {
      float g4[4];
#pragma unroll
      for (int d = 0; d < 4; ++d) g4[d] = subg[32 * d + r32] * osc;
      bf16_t* Ow = O + (rowbase + q0 + wid * QBLK) * 1024;
#pragma unroll
      for (int q = 0; q < 4; ++q) {
        f32x4a s4[4];
#pragma unroll
        for (int d = 0; d < 4; ++d) { const unsigned w0 = keep[d * 8 + 2 * q], w1 = keep[d * 8 + 2 * q + 1];
          s4[d] = (f32x4a){__uint_as_float(w0 << 16), __uint_as_float(w0 & 0xffff0000u), __uint_as_float(w1 << 16), __uint_as_float(w1 & 0xffff0000u)}; }
#pragma unroll
        for (int j = 0; j < 4; ++j) { const int r = 4 * q + j;
          float e[4];
#pragma unroll
          for (int d = 0; d < 4; ++d) e[d] = s4[d][j] - lam * o[d][r];
          float ss = (e[0] * e[0] + e[1] * e[1]) + (e[2] * e[2] + e[3] * e[3]);
          ss = lane_xor_add<1>(ss); ss = lane_xor_add<2>(ss); ss = lane_xor_add<4>(ss); ss = lane_xor_add<8>(ss); ss = lane_xor_add<16>(ss);
          const float rs = __builtin_amdgcn_rsqf(ss * (1.0f / 128.0f) + 1e-5f);
          const int orow = crow(r, hi);
#pragma unroll
          for (int d = 0; d < 4; ++d) Ow[tiled(orow, h * 128 + d * 32 + r32, 32)] = (bf16_t)(cvtpk(e[d] * rs * g4[d], 0.f) & 0xffffu);
        }
      }
    }
  }
}
#undef AKSW
#undef ASBAR
}
#ifndef LAS
#define LAS __attribute__((address_space(3)))
#endif
#define XB_TMO      128
#define XB_XCNT(j)  (256  + 64 * (j))
#define XB_XSUB(j)  (1280 + 64 * (j))
#define XB_XGEN(j)  (2304 + 64 * (j))
#define XB_TOP      3328
#define XB_TOPGEN   3392
#define XCD_BAR_WORDS 3456
#define XB_SPIN_CAP (1u << 18)

__device__ __forceinline__ unsigned xb_ld(unsigned* p)              { return __hip_atomic_load(p, __ATOMIC_RELAXED, __HIP_MEMORY_SCOPE_AGENT); }
__device__ __forceinline__ unsigned xb_add(unsigned* p, unsigned v) { return __hip_atomic_fetch_add(p, v, __ATOMIC_RELAXED, __HIP_MEMORY_SCOPE_AGENT); }
__device__ __forceinline__ unsigned xb_xcc_id() { return (unsigned)__builtin_amdgcn_s_getreg((3 << 11) | 20) & 0xFu; }
#define XB_SPIN(cond, bar) do { unsigned _sp = 0; while (cond) { __builtin_amdgcn_s_sleep(1); \
    if ((++_sp & 255u) == 0u) { if (xb_ld(&(bar)[XB_TMO])) break; if (_sp > XB_SPIN_CAP) { atomicAdd(&(bar)[XB_TMO], 1u); break; } } } } while (0)

struct XcdBarrier {
    unsigned* bar; unsigned x;
    volatile LAS unsigned* st;
};

__device__ __forceinline__ XcdBarrier xcd_barrier_post(unsigned* bar, volatile LAS unsigned* st) {
    XcdBarrier b; b.bar = bar; b.x = xb_xcc_id(); b.st = st;
    if (threadIdx.x == 0) (void)xb_add(&bar[XB_XCNT(b.x)], 1u);
    return b;
}
__device__ __forceinline__ void xcd_barrier_complete(unsigned* bar, unsigned x, unsigned& nloc, unsigned& nx) {
    const unsigned G = gridDim.x * gridDim.y * gridDim.z;
    unsigned sum, cnt, mine, sp = 0u;
    for (;;) {
        sum = 0u; cnt = 0u; mine = 0u;
#pragma unroll
        for (unsigned j = 0; j < 16; ++j) { const unsigned c = xb_ld(&bar[XB_XCNT(j)]); sum += c; cnt += (c > 0u) ? 1u : 0u; mine = (j == x) ? c : mine; }
        if (sum == G) break;
        __builtin_amdgcn_s_sleep(1);
        if ((++sp & 255u) == 0u) { if (xb_ld(&bar[XB_TMO])) break; if (sp > XB_SPIN_CAP) { atomicAdd(&bar[XB_TMO], 1u); break; } }
    }
    nloc = mine > 0u ? mine : 1u; nx = cnt > 0u ? cnt : 1u;
}

__device__ __forceinline__ void xcd_barrier(const XcdBarrier& b) {
    asm volatile("s_waitcnt vmcnt(0)" ::: "memory");
    __syncthreads();
    if (threadIdx.x == 0) {
        unsigned* bar = b.bar;
        __builtin_amdgcn_s_waitcnt(0);
        unsigned nloc = b.st[0], nx = b.st[1];
        if (nloc == 0u) { xcd_barrier_complete(bar, b.x, nloc, nx); b.st[0] = nloc; b.st[1] = nx; }
        const unsigned old = xb_add(&bar[XB_XSUB(b.x)], 1u);
        const unsigned gen = old / nloc;
        if (old + 1u == (gen + 1u) * nloc) {
            __builtin_amdgcn_fence(__ATOMIC_RELEASE, "agent");
            asm volatile("s_waitcnt vmcnt(0)" ::: "memory");
            const unsigned og = xb_add(&bar[XB_TOP], 1u);
            const unsigned tg = og / nx;
            if (og + 1u == (tg + 1u) * nx) xb_add(&bar[XB_TOPGEN], 1u);
            else XB_SPIN(xb_ld(&bar[XB_TOPGEN]) == tg, bar);
            __builtin_amdgcn_fence(__ATOMIC_ACQUIRE, "agent");
            xb_add(&bar[XB_XGEN(b.x)], 1u);
            asm volatile("s_waitcnt vmcnt(0)" ::: "memory");
        } else {
            XB_SPIN(xb_ld(&bar[XB_XGEN(b.x)]) == gen, bar);
            __builtin_amdgcn_fence(__ATOMIC_ACQUIRE, "agent");
            asm volatile("s_waitcnt vmcnt(0)" ::: "memory");
        }
    }
    __syncthreads();
}


namespace cg = cooperative_groups;
#define LAS __attribute__((address_space(3)))
typedef unsigned short bf16;
typedef unsigned v4u __attribute__((ext_vector_type(4)));
typedef float f32x4 __attribute__((ext_vector_type(4)));
typedef short bf16x8 __attribute__((ext_vector_type(8)));
constexpr int NWAVES = 8, NTHR = 512;
constexpr int BATCH = 32, SEQ = 2048, D = 1024, M = BATCH * SEQ, FF = 2816, FF2 = 2 * FF, NH = 8;
constexpr int MH = M / 2;
constexpr size_t MiB = 1u << 20;
constexpr size_t WS_WQKV = 0, WS_WO = 6 * MiB, WS_WIN = 8 * MiB, WS_WOUT = 14 * MiB, WS_WUP0 = 16 * MiB, WS_WUP1 = 27 * MiB, WS_WDN0 = 38 * MiB, WS_WDN1 = 44 * MiB;
constexpr size_t WS_COS = 64 * MiB, WS_SIN = 72 * MiB;
constexpr size_t WS_SSQ = 80 * MiB, SSQ_BYTES = 4 * MiB;
constexpr size_t WS_CTL = 100 * MiB, CTL_BYTES = 16384;
constexpr size_t WS_XB = 104 * MiB;
constexpr size_t WS_R = 232 * MiB;
constexpr size_t WS_Q = WS_R, WS_K = WS_R + 128 * MiB, WS_V = WS_R + 256 * MiB, WS_O = WS_R + 384 * MiB;
constexpr size_t WS_G = WS_R, WS_U = WS_R + 352 * MiB;
constexpr size_t WS_HU = WS_R + 352 * MiB, WS_HP = WS_HU + 16 * MiB;
constexpr size_t WS_STASH = 936 * MiB;
constexpr size_t WS_END = 1000 * MiB;
constexpr int LDS_BYTES = 147456;
static_assert(att::SHM_TOTAL <= 131072, "attention LDS");

__device__ __forceinline__ unsigned f2bf(float f) { unsigned u = __builtin_bit_cast(unsigned, f); return (u + 0x7fffu + ((u >> 16) & 1u)) >> 16; }
__device__ __forceinline__ unsigned pk2(float lo, float hi) { return f2bf(lo) | (f2bf(hi) << 16); }
__device__ __forceinline__ float bflo(unsigned w) { return __builtin_bit_cast(float, w << 16); }
__device__ __forceinline__ float bfhi(unsigned w) { return __builtin_bit_cast(float, w & 0xffff0000u); }
__device__ __forceinline__ float wave_sum(float v) {
    v = lane_xor_add<1>(v); v = lane_xor_add<2>(v); v = lane_xor_add<4>(v); v = lane_xor_add<8>(v); v = lane_xor_add<16>(v); v = lane_xor_add<32>(v);
    return v;
}
__device__ __forceinline__ int dest_row(int mode, int n) {
    if (mode == 1 && n < 2048) { const int d = n & 63, dd = d & 31; return (n & ~63) + 8 * (dd >> 2) + (dd & 3) + ((d >> 5) << 2); }
    if (mode == 3) { if (n < D) return 2 * D + n; const int isu = n >= 2 * D ? 1 : 0, ff = n - D - isu * D, fl = ff & 127; return (ff >> 7) * 256 + 128 * ((fl >> 2) & 1) + 8 * (fl >> 3) + 4 * isu + (fl & 3); }
    if (mode == 2) { const int isval = n >= FF ? 1 : 0, ff = n - isval * FF, fl = ff & 127; return (ff >> 7) * 256 + 128 * ((fl >> 2) & 1) + 8 * (fl >> 3) + 4 * isval + (fl & 3); }
    return n;
}
__device__ __forceinline__ void transpose_item(const float* W, int K, int N, bf16* WT, const float* gk, int mode, LAS float* scr, int item, int lane) {
    const int nblk = N / 32, kb = item / nblk, nb = item % nblk, k0 = 64 * kb, n0 = 32 * nb;
    f32x4 v[8]; float g[8];
#pragma unroll
    for (int i = 0; i < 8; ++i) { const int kk = 8 * i + (lane >> 3); v[i] = *(const f32x4*)(W + (size_t)(k0 + kk) * N + n0 + 4 * (lane & 7)); g[i] = gk ? gk[k0 + kk] : 1.f; }
#pragma unroll
    for (int i = 0; i < 8; ++i) { const int kk = 8 * i + (lane >> 3); LAS float* d = scr + kk * 33 + 4 * (lane & 7);
        d[0] = v[i][0] * g[i]; d[1] = v[i][1] * g[i]; d[2] = v[i][2] * g[i]; d[3] = v[i][3] * g[i]; }
    asm volatile("s_waitcnt lgkmcnt(0)" ::: "memory");
    const int c = lane & 7;
#pragma unroll
    for (int j = 0; j < 4; ++j) { const int n = (lane >> 3) + 8 * j; const LAS float* s = scr + (8 * c) * 33 + n;
        v4u o; o.x = pk2(s[0 * 33], s[1 * 33]); o.y = pk2(s[2 * 33], s[3 * 33]); o.z = pk2(s[4 * 33], s[5 * 33]); o.w = pk2(s[6 * 33], s[7 * 33]);
        *(v4u*)(WT + (size_t)dest_row(mode, n0 + n) * K + k0 + 8 * c) = o; }
    asm volatile("s_waitcnt lgkmcnt(0)" ::: "memory");
}
__device__ __forceinline__ void sincos_cw(float a, float& s, float& c) {
    const float kf = rintf(a * 0.63661977236758134f); const int k = (int)kf;
    float r = fmaf(kf, -1.5703125f, a); r = fmaf(kf, -4.837512969970703125e-4f, r); r = fmaf(kf, -7.54978995489188216e-8f, r);
    const float z = r * r;
    const float sp = fmaf(r * z, fmaf(z, fmaf(z, -1.9515295891e-4f, 8.3321608736e-3f), -1.6666654611e-1f), r);
    const float cp = fmaf(z * z, fmaf(z, fmaf(z, 2.443315711809948e-5f, -1.388731625493765e-3f), 4.166664568298827e-2f), fmaf(z, -0.5f, 1.0f));
    const float ss = (k & 1) ? cp : sp, cc = (k & 1) ? sp : cp;
    s = (k & 2) ? -ss : ss; c = ((k + 1) & 2) ? -cc : cc;
}

struct Args {
    const float* x; const int* pos;
    const float *attn_g, *w_qkv, *lq1, *lk1, *lq2, *lk2, *subg, *w_o, *conv_g, *w_in, *conv_w, *w_out, *ffn_g, *w_up, *ffn_cw, *ffn_cb, *w_dn, *fin_g;
    float* out; unsigned char* ws;
};

__device__ __forceinline__ void ffn_fix_rows(int pm, bf16* Gm, const float* HU, const float* HP, const float* cw, int tid) {
    for (int it = tid; it < 2 * 22 * 32; it += NTHR) {
        const int q = it & 31, pn = (it >> 5) % 22, which = it / (32 * 22);
        if (which == 0 ? ((pm & 7) == 0) : ((pm & 7) == 7)) continue;
        const int j0 = 128 * (q & 1) + 8 * (q >> 1), f0 = 128 * pn + 4 * q, nb = which == 0 ? pm - 1 : pm + 1;
        const size_t hb = ((size_t)pm * 2 + which) * FF2 + pn * 256 + j0, nbb = ((size_t)nb * 2 + (1 - which)) * FF2 + pn * 256 + j0;
        const f32x4 pg = *(const f32x4*)(HP + hb), pv = *(const f32x4*)(HP + hb + 4), ug = *(const f32x4*)(HU + nbb), uv = *(const f32x4*)(HU + nbb + 4);
        const int jw = which == 0 ? 0 : 2;
        const f32x4 wg = *(const f32x4*)(cw + (size_t)jw * FF2 + f0), wv = *(const f32x4*)(cw + (size_t)jw * FF2 + FF + f0);
        const f32x4 yg = pg + wg * ug, yv = pv + wv * uv;
        unsigned long long o = (unsigned long long)pk2(pg8::silu_f(yg[0]) * yv[0], pg8::silu_f(yg[1]) * yv[1]) | ((unsigned long long)pk2(pg8::silu_f(yg[2]) * yv[2], pg8::silu_f(yg[3]) * yv[3]) << 32);
        *(unsigned long long*)(Gm + tiled(pm * 256 + (which ? 255 : 0), f0, FF >> 5)) = o;
    }
}
__device__ __forceinline__ void mixer_ew_phase(const bf16* CU, const bf16* Bq, bf16* Y, const float* cw, int gtid, int nthreads) {
    constexpr int TC = 32, NFC = D / 8, NITEM = (M / TC) * NFC, NCT = D >> 5;
    for (int it = gtid; it < NITEM; it += nthreads) {
        const int fc = it % NFC, tc = it / NFC, t0 = tc * TC, f0 = fc * 8;
        float w[3][8];
#pragma unroll
        for (int j = 0; j < 3; ++j)
#pragma unroll
            for (int h = 0; h < 2; ++h) { const f32x4 a = *(const f32x4*)(cw + (size_t)j * D + f0 + 4 * h);
#pragma unroll
                for (int e = 0; e < 4; ++e) w[j][4 * h + e] = a[e]; }
        const v4u zero = {0u, 0u, 0u, 0u};
        v4u p = (t0 % SEQ == 0) ? zero : *(const v4u*)(CU + tiled(t0 - 1, f0, NCT));
        v4u c = *(const v4u*)(CU + tiled(t0, f0, NCT));
#pragma unroll 4
        for (int i = 0; i < TC; ++i) {
            const v4u n = (i == TC - 1 && (t0 + TC) % SEQ == 0) ? zero : *(const v4u*)(CU + tiled(t0 + i + 1, f0, NCT));
            const v4u b_ = *(const v4u*)(Bq + tiled(t0 + i, f0, NCT));
            v4u o;
#pragma unroll
            for (int q = 0; q < 4; ++q) {
                const float y0 = bflo(b_[q]) * fmaf(w[0][2 * q], bflo(p[q]), fmaf(w[1][2 * q], bflo(c[q]), w[2][2 * q] * bflo(n[q])));
                const float y1 = bfhi(b_[q]) * fmaf(w[0][2 * q + 1], bfhi(p[q]), fmaf(w[1][2 * q + 1], bfhi(c[q]), w[2][2 * q + 1] * bfhi(n[q])));
                o[q] = pk2(y0, y1);
            }
            *(v4u*)(Y + tiled(t0 + i, f0, NCT)) = o;
            p = c; c = n;
        }
    }
}

#ifndef PROBE_ATTN
#define PROBE_ATTN 1
#endif
#ifndef PROBE_EW
#define PROBE_EW 1
#endif
#ifndef PROBE_QKV
#define PROBE_QKV 1
#endif
__device__ __forceinline__ int opaque_bx() { int b = blockIdx.x; asm volatile("" : "+s"(b)); return b; }
#ifndef PROBE_UP
#define PROBE_UP 1
#endif
#ifndef STAGGER_TICKS
#define STAGGER_TICKS 0
#endif
__device__ __forceinline__ void stagger_start(int ticks) {
    if (ticks <= 0) return;
    const unsigned long long t0 = __builtin_amdgcn_s_memrealtime(); const unsigned long long d = (unsigned long long)(((blockIdx.x >> 3) & 3) * ticks);
    while (__builtin_amdgcn_s_memrealtime() - t0 < d) __builtin_amdgcn_s_sleep(16);
}
typedef const __attribute__((address_space(4))) Args* CArgs;
__device__ __forceinline__ CArgs get_args() { CArgs p = (CArgs)__builtin_amdgcn_kernarg_segment_ptr(); asm volatile("" : "+s"(p)); return p; }
#define WSP(off) (a->ws + (off))
#define WUP_T(l) ((bf16*)WSP(WS_WUP0 + (size_t)(l) * (WS_WUP1 - WS_WUP0)))
#define WDN_T(l) ((bf16*)WSP(WS_WDN0 + (size_t)(l) * (WS_WDN1 - WS_WDN0)))
#define SSQ(i) ((float*)WSP(WS_SSQ + (size_t)(i) * SSQ_BYTES))
#define GEO() int tid = threadIdx.x; asm volatile("" : "+v"(tid)); const int lane = tid & 63, wave = __builtin_amdgcn_readfirstlane(tid >> 6); const int G = gridDim.x, bx = blockIdx.x; \
    const int vcu = (G % 8 == 0) ? (bx % 8) * (G / 8) + bx / 8 : bx; const int gw = vcu * NWAVES + wave, NGW = G * NWAVES, gtid = bx * NTHR + tid, NT = G * NTHR; \
    (void)lane; (void)gw; (void)NGW; (void)gtid; (void)NT; (void)vcu

__global__ void __launch_bounds__(NTHR, 2) mega_fwd(Args a_unused) {
    extern __shared__ __attribute__((aligned(16))) unsigned char lds[];
    cg::grid_group grid = cg::this_grid();
    LAS unsigned char* ldsl = (LAS unsigned char*)lds;
    volatile LAS unsigned* bst = (volatile LAS unsigned*)(ldsl + 147456 - 64);
    if (threadIdx.x < 2) bst[threadIdx.x] = 0u;
    __syncthreads();
    if (blockIdx.x == 0) { unsigned* cw0 = (unsigned*)(get_args()->ws + WS_CTL); for (int i = threadIdx.x; i < (int)(CTL_BYTES / 4); i += NTHR) cw0[i] = 0u; }
#define GRID_SYNC() xcd_barrier(bar)

#ifndef PROBE_PRO
#define PROBE_PRO 1
#endif
    for (int prep = 0; prep < PROBE_PRO; ++prep)
    {
        CArgs a = get_args(); GEO();
        bf16* Wqkv_t = (bf16*)WSP(WS_WQKV); bf16* Wo_t = (bf16*)WSP(WS_WO); bf16* Win_t = (bf16*)WSP(WS_WIN); bf16* Wout_t = (bf16*)WSP(WS_WOUT);
        float* tcos = (float*)WSP(WS_COS); float* tsin = (float*)WSP(WS_SIN); bf16* XB = (bf16*)WSP(WS_XB);
        LAS float* scr = (LAS float*)(ldsl + wave * 16384);
        constexpr int I_QKV = (D / 64) * (3 * D / 32), I_O = (D / 64) * (D / 32), I_UP = (D / 64) * (FF2 / 32), I_DN = (FF / 64) * (D / 32);
        constexpr int NITEMS = 2 * I_QKV + 2 * I_O + 2 * I_UP + 2 * I_DN;
        for (int it = gw; it < NITEMS; it += NGW) {
            int r = it;
            if (r < I_QKV) { transpose_item(a->w_qkv, D, 3 * D, Wqkv_t, a->attn_g, 1, scr, r, lane); continue; } r -= I_QKV;
            if (r < I_QKV) { transpose_item(a->w_in, D, 3 * D, Win_t, a->conv_g, 3, scr, r, lane); continue; } r -= I_QKV;
            if (r < I_O) { transpose_item(a->w_o, D, D, Wo_t, nullptr, 0, scr, r, lane); continue; } r -= I_O;
            if (r < I_O) { transpose_item(a->w_out, D, D, Wout_t, nullptr, 0, scr, r, lane); continue; } r -= I_O;
            if (r < I_UP) { transpose_item(a->w_up, D, FF2, WUP_T(0), a->ffn_g, 2, scr, r, lane); continue; } r -= I_UP;
            if (r < I_UP) { transpose_item(a->w_up + (size_t)D * FF2, D, FF2, WUP_T(1), a->ffn_g + D, 2, scr, r, lane); continue; } r -= I_UP;
            if (r < I_DN) { transpose_item(a->w_dn, FF, D, WDN_T(0), nullptr, 0, scr, r, lane); continue; } r -= I_DN;
            transpose_item(a->w_dn + (size_t)FF * D, FF, D, WDN_T(1), nullptr, 0, scr, r, lane);
        }
        const int* pos = a->pos;
        for (int i = gtid; i < M * 32; i += NT) {
            const int d = i & 31; const float inv = __builtin_amdgcn_exp2f(-(float)d * (13.287712379549449f / 32.0f));
            float s, c; sincos_cw((float)pos[i >> 5] * inv, s, c); tcos[i] = c; tsin[i] = s;
        }
        const float* x = a->x; float* ssq0 = SSQ(0);
        for (int rg = gw; rg < M / 16; rg += NGW) {
            const int row = rg * 16 + (lane >> 2); const float* xr = x + (size_t)row * D + (lane & 3) * 8; bf16* tb = XB + (size_t)rg * (32 * 512) + lane * 8; float s = 0.f;
#pragma unroll 8
            for (int ct = 0; ct < 32; ++ct) { const f32x4 p = __builtin_nontemporal_load((const f32x4*)(xr + ct * 32)), q = __builtin_nontemporal_load((const f32x4*)(xr + ct * 32 + 4));
                s += ((p.x * p.x + p.y * p.y) + (p.z * p.z + p.w * p.w)) + ((q.x * q.x + q.y * q.y) + (q.z * q.z + q.w * q.w));
                v4u o; o.x = pk2(p.x, p.y); o.y = pk2(p.z, p.w); o.z = pk2(q.x, q.y); o.w = pk2(q.z, q.w); *(v4u*)(tb + ct * 512) = o; }
            s = lane_xor_add<1>(s); s = lane_xor_add<2>(s);
            *(f32x4*)(ssq0 + (size_t)row * 16 + 4 * (lane & 3)) = (f32x4){(lane & 3) == 0 ? s : 0.f, 0.f, 0.f, 0.f};
        }
    }
    grid.sync();
    XcdBarrier bar = xcd_barrier_post((unsigned*)(get_args()->ws + WS_CTL), bst);

#ifdef PROBE_SYNC
    for (int rep = 0; rep < PROBE_SYNC; ++rep) GRID_SYNC();
#endif
    {
        CArgs a = get_args();
        pg8::Gemm g{(bf16*)WSP(WS_XB), (bf16*)WSP(WS_WQKV), M, 3 * D, D}; pg8::StaticOrder S; S.init(M, 3 * D, gridDim.x, opaque_bx());
        pg8::EpiRope E{(bf16*)WSP(WS_Q), (bf16*)WSP(WS_K), (bf16*)WSP(WS_V), SSQ(0), (float*)WSP(WS_COS), (float*)WSP(WS_SIN), 0.125f * 1.4426950408889634f};
        stagger_start(STAGGER_TICKS);
        for (int rep = 0; rep < PROBE_QKV; ++rep) pg8::gemm_phase<pg8::EpiRope, pg8::StaticOrder, true, true>(ldsl, g, S, E);
#ifdef PROBE_STORE
        { pg8::EpiStoreOnly EN{(bf16*)WSP(WS_O), 2048, 8}; pg8::gemm_phase<pg8::EpiStoreOnly, pg8::StaticOrder, true, true>(ldsl, g, S, EN); }
#endif
#ifdef PROBE_LOAD
        { pg8::EpiLoadOnly EN{(float*)WSP(WS_STASH), SSQ(0), (float*)WSP(WS_COS), (float*)WSP(WS_SIN)}; pg8::gemm_phase<pg8::EpiLoadOnly, pg8::StaticOrder, true, true>(ldsl, g, S, EN); }
#endif
#ifdef PROBE_KLOOP
        { pg8::EpiNull EN{(float*)WSP(WS_STASH)}; pg8::gemm_phase<pg8::EpiNull, pg8::StaticOrder, true, true>(ldsl, g, S, EN); }
#endif
    }
    GRID_SYNC();
    {
        CArgs a = get_args(); GEO();
        const float lambda_init = 0.8f - 0.6f * 1.0f;
        const float s1 = wave_sum(a->lq1[lane] * a->lk1[lane]), s2 = wave_sum(a->lq2[lane] * a->lk2[lane]);
        const float lam = __expf(s1) - __expf(s2) + lambda_init;
        const bf16* Qb = (const bf16*)WSP(WS_Q); const bf16* Kb = (const bf16*)WSP(WS_K); const bf16* Vb = (const bf16*)WSP(WS_V); bf16* Ob = (bf16*)WSP(WS_O);
        float* stash = (float*)WSP(WS_STASH); const float* subg = a->subg;
#pragma unroll 1
        for (int rep = 0; rep < PROBE_ATTN; ++rep)
#pragma unroll 1
        for (int i = 0;; ++i) {
            const int idf = i * G + vcu; if (idf >= BATCH * NH * (SEQ / 256)) break;
            const int id = BATCH * NH * (SEQ / 256) - 1 - idf;
            const int bh = id >> 3, qb = id & 7;
            att::attn_unit(bh >> 3, bh & 7, qb, Qb, Kb, Vb, Ob, stash, lam, subg, 1.0f - lambda_init, (char*)lds);
        }
    }
    GRID_SYNC();
    {
        CArgs a = get_args();
        pg8::Gemm g{(bf16*)WSP(WS_O), (bf16*)WSP(WS_WO), M, D, D}; pg8::StaticOrder S; S.init(M, D, gridDim.x, opaque_bx());
        pg8::EpiRes<false> E{nullptr, (bf16*)WSP(WS_XB), SSQ(1)};
        pg8::gemm_phase<pg8::EpiRes<false>, pg8::StaticOrder, true, true>(ldsl, g, S, E);
    }
    GRID_SYNC();
#pragma unroll 1
    for (int layer = 0; layer < 2; ++layer) {
        if (layer == 1) {
            {   CArgs a = get_args();
                pg8::Gemm g{(bf16*)WSP(WS_XB), (bf16*)WSP(WS_WIN), M, 3 * D, D}; pg8::StaticOrder S; S.init(M, 3 * D, gridDim.x, opaque_bx());
                pg8::EpiMix E{(bf16*)WSP(WS_Q), (bf16*)WSP(WS_K), SSQ(2)};
                pg8::gemm_phase<pg8::EpiMix, pg8::StaticOrder, true, true>(ldsl, g, S, E); }
            GRID_SYNC();
            {   CArgs a = get_args(); GEO();
                mixer_ew_phase((const bf16*)WSP(WS_Q), (const bf16*)WSP(WS_K), (bf16*)WSP(WS_O), a->conv_w, gtid, NT); }
            GRID_SYNC();
            {   CArgs a = get_args();
                pg8::Gemm g{(bf16*)WSP(WS_O), (bf16*)WSP(WS_WOUT), M, D, D}; pg8::StaticOrder S; S.init(M, D, gridDim.x, opaque_bx());
                pg8::EpiRes<false> E{nullptr, (bf16*)WSP(WS_XB), SSQ(3)};
                pg8::gemm_phase<pg8::EpiRes<false>, pg8::StaticOrder, true, true>(ldsl, g, S, E); }
            GRID_SYNC();
        }
        {   CArgs a = get_args();
            pg8::Gemm g{(bf16*)WSP(WS_XB), WUP_T(layer), M, FF2, D}; pg8::StaticOrder S; S.init(M, FF2, gridDim.x, opaque_bx());
            pg8::EpiFfn E{(bf16*)WSP(WS_G), SSQ(layer == 0 ? 1 : 3), a->ffn_cw + (size_t)layer * 3 * FF2, a->ffn_cb + (size_t)layer * FF2, (float*)WSP(WS_HU), (float*)WSP(WS_HP), ldsl + 131072};
            stagger_start(STAGGER_TICKS);
            for (int rep = 0; rep < PROBE_UP; ++rep) pg8::gemm_phase<pg8::EpiFfn, pg8::StaticOrder, true, true>(ldsl, g, S, E); }
        GRID_SYNC();
        {   CArgs a = get_args();
            pg8::Gemm g{(bf16*)WSP(WS_G), WDN_T(layer), M, D, FF}; pg8::StaticOrder S; S.init(M, D, gridDim.x, opaque_bx()); S.rev = true;
            {   int tid = threadIdx.x; asm volatile("" : "+v"(tid));
                const float* cwl = a->ffn_cw + (size_t)layer * 3 * FF2;
#pragma unroll 1
                for (int i = 0;; ++i) { pg8::Unit u; if (!S.next(i, u)) break; ffn_fix_rows(u.pm, (bf16*)WSP(WS_G), (const float*)WSP(WS_HU), (const float*)WSP(WS_HP), cwl, tid); }
                __threadfence(); __syncthreads(); }
#ifdef PROBE_DOWN
            { pg8::EpiNull EN{(float*)WSP(WS_STASH)}; pg8::gemm_phase<pg8::EpiNull, pg8::StaticOrder, true, true>(ldsl, g, S, EN); }
#endif
            pg8::EpiRes<false> E{nullptr, (bf16*)WSP(WS_XB), SSQ(layer == 0 ? 2 : 4)};
            pg8::gemm_phase<pg8::EpiRes<false>, pg8::StaticOrder, true, true>(ldsl, g, S, E); }
        GRID_SYNC();
    }
    {   CArgs a = get_args(); GEO();
        float* out = a->out; const float* fg = a->fin_g; const float* ssq4 = SSQ(4); const bf16* XB = (const bf16*)WSP(WS_XB);
        for (int rg = gw; rg < M / 16; rg += NGW) {
            const int row = rg * 16 + (lane >> 2); const float rs = pg8::row_rstd(ssq4, row);
            const bf16* tb = XB + (size_t)rg * (32 * 512) + lane * 8; float* ob = out + (size_t)row * D + (lane & 3) * 8; const float* gp = fg + (lane & 3) * 8;
#pragma unroll 8
            for (int ct = 0; ct < 32; ++ct) { const v4u q = *(const v4u*)(tb + ct * 512); const f32x4 g0 = *(const f32x4*)(gp + ct * 32), g1 = *(const f32x4*)(gp + ct * 32 + 4);
                __builtin_nontemporal_store((f32x4){bflo(q.x), bfhi(q.x), bflo(q.y), bfhi(q.y)} * rs * g0, (f32x4*)(ob + ct * 32)); __builtin_nontemporal_store((f32x4){bflo(q.z), bfhi(q.z), bflo(q.w), bfhi(q.w)} * rs * g1, (f32x4*)(ob + ct * 32 + 4)); }
        }
    }
}

extern "C" void kernel_launch(void* const* d_in, const int* in_sizes, int n_in, void* d_out, int out_size, void* d_ws, size_t ws_size, hipStream_t stream) {
    static int grid = 0;
    if (grid == 0) {
        if (n_in != 20 || in_sizes[0] != M * D || out_size != M * D || ws_size < WS_END) { fprintf(stderr, "kernel_launch: shape mismatch n_in %d in0 %d out %d ws %zu\n", n_in, n_in > 0 ? in_sizes[0] : -1, out_size, ws_size); grid = -1; return; }
        int dev = 0, cus = 0, per_cu = 0;
        if (hipGetDevice(&dev) != hipSuccess || hipDeviceGetAttribute(&cus, hipDeviceAttributeMultiprocessorCount, dev) != hipSuccess) { grid = -1; return; }
        if (hipFuncSetAttribute((const void*)mega_fwd, hipFuncAttributeMaxDynamicSharedMemorySize, LDS_BYTES) != hipSuccess) { fprintf(stderr, "kernel_launch: hipFuncSetAttribute failed\n"); grid = -1; return; }
        if (hipOccupancyMaxActiveBlocksPerMultiprocessor(&per_cu, (const void*)mega_fwd, NTHR, LDS_BYTES) != hipSuccess || per_cu < 1) { fprintf(stderr, "kernel_launch: occupancy query says %d\n", per_cu); per_cu = 1; }
        (void)hipGetLastError();
        grid = cus;
    }
    if (grid < 0) return;
    Args a{};
    a.x = (const float*)d_in[0]; a.pos = (const int*)d_in[1];
    a.attn_g = (const float*)d_in[2]; a.w_qkv = (const float*)d_in[3]; a.lq1 = (const float*)d_in[4]; a.lk1 = (const float*)d_in[5]; a.lq2 = (const float*)d_in[6]; a.lk2 = (const float*)d_in[7];
    a.subg = (const float*)d_in[8]; a.w_o = (const float*)d_in[9]; a.conv_g = (const float*)d_in[10]; a.w_in = (const float*)d_in[11]; a.conv_w = (const float*)d_in[12]; a.w_out = (const float*)d_in[13];
    a.ffn_g = (const float*)d_in[14]; a.w_up = (const float*)d_in[15]; a.ffn_cw = (const float*)d_in[16]; a.ffn_cb = (const float*)d_in[17]; a.w_dn = (const float*)d_in[18]; a.fin_g = (const float*)d_in[19];
    a.out = (float*)d_out; a.ws = (unsigned char*)d_ws;
    void* args[] = {&a};
    const hipError_t e = hipLaunchCooperativeKernel((const void*)mega_fwd, dim3(grid), dim3(NTHR), args, LDS_BYTES, stream);
    if (e != hipSuccess) fprintf(stderr, "kernel_launch: cooperative launch failed: %s (grid %d)\n", hipGetErrorString(e), grid);
}
```

```cpp
#include <hip/hip_runtime.h>
#include <hip/hip_cooperative_groups.h>
#include <cstdio>
#include <cstdint>

template <int MASK> __device__ __forceinline__ float lane_xor_add(float x) {
    if constexpr (MASK == 32) {
        int l = (int)__builtin_amdgcn_mbcnt_hi(~0u, __builtin_amdgcn_mbcnt_lo(~0u, 0u)); asm volatile("" : "+v"(l));
        return x + __builtin_bit_cast(float, __builtin_amdgcn_ds_bpermute((l ^ 32) << 2, __builtin_bit_cast(int, x))); }
    else return x + __builtin_bit_cast(float, __builtin_amdgcn_ds_swizzle(__builtin_bit_cast(int, x), (MASK << 10) | 0x1F));
}
#ifndef DPP_PREV
#define DPP_PREV 0x121
#define DPP_NEXT 0x12F
#endif
#ifndef USE_NT
#define USE_NT 0
#endif
#if USE_NT
#define NT_STORE(v, p) __builtin_nontemporal_store((v), (p))
#else
#define NT_STORE(v, p) (*(p) = (v))
#endif
#ifndef QKV_LD
#define QKV_LD 1088
#endif
__device__ __forceinline__ size_t tiled(int row, int col, int nct) { return (((size_t)(row >> 4) * nct + (col >> 5)) << 9) + ((row & 15) << 5) + (col & 31); }
namespace pg8 {
#define PG8_LAS __attribute__((address_space(3)))
typedef unsigned short bf16_t;
typedef short bf16x8 __attribute__((ext_vector_type(8)));
typedef float f32x4 __attribute__((ext_vector_type(4)));
typedef unsigned u32x4 __attribute__((ext_vector_type(4)));
constexpr int BM = 256, BK = 64, HALF = 128, HTB = HALF * BK * 2  , STAGE_BYTES = 8 * HTB, NXCD = 8, WGM = 8;

__host__ __device__ __forceinline__ int lds_byte(int r, int c) { const int st = (r >> 4) * 2 + (c >> 5), rr = r & 15, cc = c & 31, ob = rr * 64 + cc * 2; return st * 1024 + (ob ^ (((ob >> 9) & 1) << 5)); }
__host__ __device__ __forceinline__ void stage_rc(int b, int& R, int& C) { const int st = b / 1024, sb = b % 1024, swz = sb ^ (((sb >> 9) & 1) << 5); R = (st >> 1) * 16 + swz / 64; C = (st & 1) * 32 + (swz % 64) / 2; }
__host__ __device__ __forceinline__ int perm32(int rho) { const int n = rho >> 4, i = rho & 15; return 8 * (i >> 2) + 4 * n + (i & 3); }

struct Unit { int pm, pn; };
struct Gemm { const bf16_t* A; const bf16_t* Bt; int M, N, K; };

struct StaticOrder {
    int nM, nN, nwg, G, c; bool rev = false;
    __host__ __device__ void init(int M, int N, int G_, int c_) { nM = M / BM; nN = N / BM; nwg = nM * nN; G = G_; c = c_; }
    __host__ __device__ bool next(int i, Unit& u) const {
        const long L = (long)i * G + c; if (L >= nwg) return false;
        int wgid = (int)L; { const int q = nwg / NXCD, r = nwg % NXCD, xcd = wgid % NXCD, off = wgid / NXCD; wgid = (xcd < r ? xcd * (q + 1) : r * (q + 1) + (xcd - r) * q) + off; }
        const int nig = WGM * nN, gid = wgid / nig, fm = gid * WGM, gsz = (nM - fm) < WGM ? (nM - fm) : WGM;
        u.pm = fm + ((wgid % nig) % gsz); u.pn = (wgid % nig) / gsz; if (rev) u.pm = nM - 1 - u.pm; return true;
    }
    __device__ __forceinline__ void a_ready(const Unit&) const {}
    __device__ __forceinline__ void done(const Unit&) const {}
};

__device__ __forceinline__ unsigned cvt_pk_bf16(float lo, float hi) { unsigned r; asm volatile("v_cvt_pk_bf16_f32 %0, %1, %2" : "=v"(r) : "v"(lo), "v"(hi)); return r; }
typedef float f32x2 __attribute__((ext_vector_type(2)));

__device__ __forceinline__ float row_rstd(const float* ssq, int row) {
    const f32x4* p = (const f32x4*)(ssq + (size_t)row * 16);
    const f32x4 a = p[0], b = p[1], c = p[2], d = p[3];
    const float s = (((a[0] + a[1]) + (a[2] + a[3])) + ((b[0] + b[1]) + (b[2] + b[3]))) + (((c[0] + c[1]) + (c[2] + c[3])) + ((d[0] + d[1]) + (d[2] + d[3])));
    return __builtin_amdgcn_rsqf(s * (1.0f / 1024.0f) + 1e-5f);
}
__device__ __forceinline__ void rows_rstd(const float* ssq, int row0, int fq, float (&rs)[2][4]) {
    f32x4 p[2][4];
#pragma unroll
    for (int ai = 0; ai < 2; ++ai)
#pragma unroll
        for (int m = 0; m < 4; ++m) p[ai][m] = *(const f32x4*)(ssq + (size_t)(row0 + ai * HALF + m * 16) * 16 + 4 * fq);
#pragma unroll
    for (int ai = 0; ai < 2; ++ai)
#pragma unroll
        for (int m = 0; m < 4; ++m) { float s = (p[ai][m][0] + p[ai][m][1]) + (p[ai][m][2] + p[ai][m][3]); s = lane_xor_add<16>(s); s = lane_xor_add<32>(s);
            rs[ai][m] = __builtin_amdgcn_rsqf(s * (1.0f / 1024.0f) + 1e-5f); }
}
struct EpiRope {
    static constexpr bool PERM = true, AFTER_DRAIN = false;
    bf16_t* Q; bf16_t* K; bf16_t* V; const float* ssq; const float* tcos; const float* tsin; float qscale;
    __device__ __forceinline__ void operator()(const f32x4 (&acc)[2][2][4][2], const Unit& u, int wr, int wc, int fr, int fq) const {
        const int t = u.pn >> 2;
        const int colt = (u.pn & 3) * BM + wc * 32 + 8 * fq;
        const int row0 = u.pm * BM + wr * 64 + fr;
        const int fi = 4 * ((wc & 1) * 4 + fq);
        float rs[2][4]; rows_rstd(ssq, row0, fq, rs);
        if (t < 2) {
            bf16_t* base = (t == 0) ? Q : K; const float sc = (t == 0) ? qscale : 1.f;
#pragma unroll
            for (int ai = 0; ai < 2; ++ai) {
                f32x4 c4[4], s4[4];
#pragma unroll
                for (int m = 0; m < 4; ++m) { const int row = row0 + ai * HALF + m * 16; c4[m] = *(const f32x4*)(tcos + (size_t)row * 32 + fi); s4[m] = *(const f32x4*)(tsin + (size_t)row * 32 + fi); }
#pragma unroll
                for (int m = 0; m < 4; ++m) {
                    const int row = row0 + ai * HALF + m * 16;
                    const float k = rs[ai][m] * sc;
                    bf16_t* rowp = base + ((size_t)(row >> 4) * 32 + (colt >> 5)) * 512 + (row & 15) * 32 + (colt & 31);
#pragma unroll
                    for (int bj = 0; bj < 2; ++bj) {
                        const f32x4 x1 = acc[ai][bj][m][0] * k, x2 = acc[ai][bj][m][1] * k;
                        const f32x4 y1 = x1 * c4[m] - x2 * s4[m], y2 = x2 * c4[m] + x1 * s4[m];
                        u32x4 w; w.x = cvt_pk_bf16(y1[0], y1[1]); w.y = cvt_pk_bf16(y1[2], y1[3]); w.z = cvt_pk_bf16(y2[0], y2[1]); w.w = cvt_pk_bf16(y2[2], y2[3]);
                        NT_STORE(w, (u32x4*)(rowp + bj * 2048));
                    }
                }
                __builtin_amdgcn_sched_barrier(0);
            }
        } else {
#pragma unroll
            for (int ai = 0; ai < 2; ++ai)
#pragma unroll
                for (int m = 0; m < 4; ++m) {
                    const int row = row0 + ai * HALF + m * 16;
                    const float k = rs[ai][m];
                    bf16_t* rowp = V + ((size_t)(row >> 4) * 32 + (colt >> 5)) * 512 + (row & 15) * 32 + (colt & 31);
#pragma unroll
                    for (int bj = 0; bj < 2; ++bj) {
                        const f32x4 v0 = acc[ai][bj][m][0] * k, v1 = acc[ai][bj][m][1] * k;
                        u32x4 w; w.x = cvt_pk_bf16(v0[0], v0[1]); w.y = cvt_pk_bf16(v0[2], v0[3]); w.z = cvt_pk_bf16(v1[0], v1[1]); w.w = cvt_pk_bf16(v1[2], v1[3]);
                        NT_STORE(w, (u32x4*)(rowp + bj * 2048));
                    }
                }
        }
    }
};
struct EpiScale {
    static constexpr bool PERM = true, AFTER_DRAIN = false;
    bf16_t* O; int ldc; const float* ssq; int row_off;
    __device__ __forceinline__ void operator()(const f32x4 (&acc)[2][2][4][2], const Unit& u, int wr, int wc, int fr, int fq) const {
        const int row0 = u.pm * BM + wr * 64 + fr, col0 = u.pn * BM + wc * 32 + 8 * fq;
        float rs[2][4]; rows_rstd(ssq, row_off + row0, fq, rs);
#pragma unroll
        for (int ai = 0; ai < 2; ++ai)
#pragma unroll
            for (int m = 0; m < 4; ++m) {
                const int row = row0 + ai * HALF + m * 16;
                const float k = rs[ai][m];
                bf16_t* rowp = O + tiled(row, col0, ldc >> 5);
#pragma unroll
                for (int bj = 0; bj < 2; ++bj) {
                    const f32x4 v0 = acc[ai][bj][m][0] * k, v1 = acc[ai][bj][m][1] * k;
                    u32x4 w; w.x = cvt_pk_bf16(v0[0], v0[1]); w.y = cvt_pk_bf16(v0[2], v0[3]); w.z = cvt_pk_bf16(v1[0], v1[1]); w.w = cvt_pk_bf16(v1[2], v1[3]);
                    NT_STORE(w, (u32x4*)(rowp + bj * 2048));
                }
            }
    }
};
struct EpiMix {
    static constexpr bool PERM = true, AFTER_DRAIN = false;
    bf16_t* CU; bf16_t* Bq; const float* ssq;
    __device__ __forceinline__ void operator()(const f32x4 (&acc)[2][2][4][2], const Unit& u, int wr, int wc, int fr, int fq) const {
        typedef unsigned u32x2m __attribute__((ext_vector_type(2)));
        const int row0 = u.pm * BM + wr * 64 + fr;
        float rs[2][4]; rows_rstd(ssq, row0, fq, rs);
        if (u.pn < 8) {
            const int f0 = u.pn * 128 + wc * 32 + 8 * fq;
#pragma unroll
            for (int ai = 0; ai < 2; ++ai)
#pragma unroll
                for (int m = 0; m < 4; ++m) { const int row = row0 + ai * HALF + m * 16; const float r2 = rs[ai][m] * rs[ai][m];
                    const f32x4 p0 = acc[ai][0][m][0] * acc[ai][0][m][1] * r2, p1 = acc[ai][1][m][0] * acc[ai][1][m][1] * r2;
                    u32x4 w; w.x = cvt_pk_bf16(p0[0], p0[1]); w.y = cvt_pk_bf16(p0[2], p0[3]); w.z = cvt_pk_bf16(p1[0], p1[1]); w.w = cvt_pk_bf16(p1[2], p1[3]);
                    *(u32x4*)(CU + tiled(row, f0, 32)) = w; }
        } else {
            const int col0 = (u.pn - 8) * BM + wc * 32 + 8 * fq;
#pragma unroll
            for (int ai = 0; ai < 2; ++ai)
#pragma unroll
                for (int m = 0; m < 4; ++m) { const int row = row0 + ai * HALF + m * 16; const float k = rs[ai][m]; bf16_t* rowp = Bq + tiled(row, col0, 32);
#pragma unroll
                    for (int bj = 0; bj < 2; ++bj) { const f32x4 v0 = acc[ai][bj][m][0] * k, v1 = acc[ai][bj][m][1] * k;
                        u32x4 w; w.x = cvt_pk_bf16(v0[0], v0[1]); w.y = cvt_pk_bf16(v0[2], v0[3]); w.z = cvt_pk_bf16(v1[0], v1[1]); w.w = cvt_pk_bf16(v1[2], v1[3]);
                        *(u32x4*)(rowp + bj * 2048) = w; } }
        }
    }
};
template <bool BASE_F32> struct EpiRes {
    static constexpr bool PERM = true, AFTER_DRAIN = false;
    const float* basef; bf16_t* xb; float* ssq_out;
    __device__ __forceinline__ void operator()(const f32x4 (&acc)[2][2][4][2], const Unit& u, int wr, int wc, int fr, int fq) const {
        const int row0 = u.pm * BM + wr * 64 + fr, col0 = u.pn * BM + wc * 32 + 8 * fq;
#pragma unroll
        for (int ai = 0; ai < 2; ++ai) {
            f32x4 bf[BASE_F32 ? 4 : 1][2][2]; u32x4 bb[BASE_F32 ? 1 : 4][2];
#pragma unroll
            for (int m = 0; m < 4; ++m) { const size_t off = (size_t)(row0 + ai * HALF + m * 16) * 1024 + col0, toff = tiled(row0 + ai * HALF + m * 16, col0, 32);
#pragma unroll
                for (int bj = 0; bj < 2; ++bj) {
                    if constexpr (BASE_F32) { bf[m][bj][0] = *(const f32x4*)(basef + off + bj * HALF); bf[m][bj][1] = *(const f32x4*)(basef + off + bj * HALF + 4); }
                    else bb[m][bj] = *(const u32x4*)(xb + toff + bj * 2048); } }
#pragma unroll
            for (int m = 0; m < 4; ++m) {
                const int row = row0 + ai * HALF + m * 16; const size_t toff = tiled(row, col0, 32); float ss = 0.f;
#pragma unroll
                for (int bj = 0; bj < 2; ++bj) {
                    f32x4 b0, b1;
                    if constexpr (BASE_F32) { b0 = bf[m][bj][0]; b1 = bf[m][bj][1]; }
                    else { const u32x4 w = bb[m][bj];
                        b0 = (f32x4){__builtin_bit_cast(float, w.x << 16), __builtin_bit_cast(float, w.x & 0xffff0000u), __builtin_bit_cast(float, w.y << 16), __builtin_bit_cast(float, w.y & 0xffff0000u)};
                        b1 = (f32x4){__builtin_bit_cast(float, w.z << 16), __builtin_bit_cast(float, w.z & 0xffff0000u), __builtin_bit_cast(float, w.w << 16), __builtin_bit_cast(float, w.w & 0xffff0000u)}; }
                    const f32x4 o0 = b0 + acc[ai][bj][m][0], o1 = b1 + acc[ai][bj][m][1];
                    ss += ((o0[0] * o0[0] + o0[1] * o0[1]) + (o0[2] * o0[2] + o0[3] * o0[3])) + ((o1[0] * o1[0] + o1[1] * o1[1]) + (o1[2] * o1[2] + o1[3] * o1[3]));
                    u32x4 w; w.x = cvt_pk_bf16(o0[0], o0[1]); w.y = cvt_pk_bf16(o0[2], o0[3]); w.z = cvt_pk_bf16(o1[0], o1[1]); w.w = cvt_pk_bf16(o1[2], o1[3]);
                    NT_STORE(w, (u32x4*)(xb + toff + bj * 2048));
                }
                ss = lane_xor_add<16>(ss); ss = lane_xor_add<32>(ss);
                if (fq == 0) ssq_out[(size_t)row * 16 + u.pn * 4 + wc] = ss;
            }
        }
    }
};
__device__ __forceinline__ float dpp_ror1_f(float x) { return __builtin_bit_cast(float, __builtin_amdgcn_update_dpp(0, __builtin_bit_cast(int, x), DPP_PREV, 0xF, 0xF, true)); }
__device__ __forceinline__ float dpp_ror15_f(float x) { return __builtin_bit_cast(float, __builtin_amdgcn_update_dpp(0, __builtin_bit_cast(int, x), DPP_NEXT, 0xF, 0xF, true)); }
__device__ __forceinline__ f32x4 dpp_ror1(f32x4 v) { f32x4 r; r.x = dpp_ror1_f(v.x); r.y = dpp_ror1_f(v.y); r.z = dpp_ror1_f(v.z); r.w = dpp_ror1_f(v.w); return r; }
__device__ __forceinline__ f32x4 dpp_ror15(f32x4 v) { f32x4 r; r.x = dpp_ror15_f(v.x); r.y = dpp_ror15_f(v.y); r.z = dpp_ror15_f(v.z); r.w = dpp_ror15_f(v.w); return r; }
__device__ __forceinline__ f32x4 sel4(bool c, f32x4 a, f32x4 b) { return (f32x4){c ? a[0] : b[0], c ? a[1] : b[1], c ? a[2] : b[2], c ? a[3] : b[3]}; }
__device__ __forceinline__ float silu_f(float g) { return g * __builtin_amdgcn_rcpf(1.f + __builtin_amdgcn_exp2f(-1.4426950408889634f * g)); }
struct EpiFfn {
    static constexpr bool PERM = true, AFTER_DRAIN = false;
    bf16_t* G; const float* ssq; const float* cw; const float* cb; float* HU; float* HP; PG8_LAS unsigned char* ex;
    __device__ __forceinline__ void operator()(f32x4 (&acc)[2][2][4][2], const Unit& u, int wr, int wc, int fr_in, int fq_in) const {
        typedef unsigned u32x2e __attribute__((ext_vector_type(2)));
        int t_ = threadIdx.x; asm volatile("" : "+v"(t_)); const int fr = t_ & 15, fq = (t_ >> 4) & 3; (void)fr_in; (void)fq_in;
        constexpr int FFc = 2816, FF2c = 5632;
        const int row0 = u.pm * BM + wr * 64 + fr;
        const bool is_first = (fr == 0), is_last = (fr == 15);
        PG8_LAS float* RS = (PG8_LAS float*)(ex + 8192); PG8_LAS float* CWL = (PG8_LAS float*)(ex + 8192 + 1024);
        {
            const int t = t_ & 511;
            if (t < 256) {
                const f32x4* p = (const f32x4*)(ssq + (size_t)(u.pm * BM + t) * 16);
                const f32x4 a = p[0], b = p[1], c = p[2], d = p[3];
                const float s = (((a[0] + a[1]) + (a[2] + a[3])) + ((b[0] + b[1]) + (b[2] + b[3]))) + (((c[0] + c[1]) + (c[2] + c[3])) + ((d[0] + d[1]) + (d[2] + d[3])));
                RS[t] = __builtin_amdgcn_rsqf(s * (1.0f / 1024.0f) + 1e-5f);
            } else {
                const int q = t - 256, p = q >> 6, jq = q & 63, n = jq & 1, wq = (jq >> 1) & 15, bjj = jq >> 5;
                const float* src = (p < 3) ? (cw + (size_t)p * FF2c) : cb;
                *(PG8_LAS f32x4*)(CWL + p * 256 + 4 * jq) = *(const f32x4*)(src + n * FFc + u.pn * 128 + 8 * wq + 4 * bjj);
            }
        }
        asm volatile("s_waitcnt lgkmcnt(0)" ::: "memory"); __builtin_amdgcn_s_barrier(); asm volatile("" ::: "memory");
#pragma unroll
        for (int ai = 0; ai < 2; ++ai)
#pragma unroll
            for (int m = 0; m < 4; ++m) { const float r = RS[wr * 64 + fr + ai * HALF + m * 16];
#pragma unroll
                for (int bj = 0; bj < 2; ++bj)
#pragma unroll
                    for (int n = 0; n < 2; ++n) acc[ai][bj][m][n] = acc[ai][bj][m][n] * r; }
        PG8_LAS float* EX = (PG8_LAS float*)ex;
        const int cj = wc * 32 + 8 * fq;
#pragma unroll
        for (int ai = 0; ai < 2; ++ai)
#pragma unroll
            for (int bj = 0; bj < 2; ++bj)
#pragma unroll
                for (int n = 0; n < 2; ++n) {
                    if (is_first) *(PG8_LAS f32x4*)(EX + ((ai * 2 + wr) * 2 + 0) * 256 + bj * 128 + cj + 4 * n) = acc[ai][bj][0][n];
                    if (is_last)  *(PG8_LAS f32x4*)(EX + ((ai * 2 + wr) * 2 + 1) * 256 + bj * 128 + cj + 4 * n) = acc[ai][bj][3][n];
                }
        asm volatile("s_waitcnt lgkmcnt(0)" ::: "memory"); __builtin_amdgcn_s_barrier(); asm volatile("" ::: "memory");
        const int f0 = u.pn * 128 + wc * 32 + 8 * fq;
        const f32x4 zero4 = {0.f, 0.f, 0.f, 0.f};
#pragma unroll
        for (int ai = 0; ai < 2; ++ai) {
            const int g = ai * 2 + wr;
            unsigned park[4][2];
#pragma unroll
            for (int bj = 0; bj < 2; ++bj) {
#pragma unroll
                for (int n = 0; n < 2; ++n) {
                    f32x4 wgt[4];
#pragma unroll
                    for (int j = 0; j < 4; ++j) wgt[j] = *(const PG8_LAS f32x4*)(CWL + j * 256 + bj * 128 + cj + 4 * n);
                    const f32x4 hp = (g == 0) ? zero4 : *(const PG8_LAS f32x4*)(EX + ((g - 1) * 2 + 1) * 256 + bj * 128 + cj + 4 * n);
                    const f32x4 hn = (g == 3) ? zero4 : *(const PG8_LAS f32x4*)(EX + ((g + 1) * 2 + 0) * 256 + bj * 128 + cj + 4 * n);
                    f32x4 r1p = hp, r15c = dpp_ror15(acc[ai][bj][0][n]);
#pragma unroll
                    for (int m = 0; m < 4; ++m) {
                        const f32x4 X = acc[ai][bj][m][n];
                        const f32x4 r1m = dpp_ror1(X);
                        const f32x4 prev = sel4(is_first, r1p, r1m); r1p = r1m;
                        const f32x4 r15n = (m < 3) ? dpp_ror15(acc[ai][bj][m < 3 ? m + 1 : 3][n]) : hn;
                        const f32x4 next = sel4(is_last, r15n, r15c); r15c = r15n;
                        const f32x4 Y = wgt[0] * prev + (wgt[1] * X + (wgt[2] * next + wgt[3]));
                        if (m == 0) { if (g == 0 && is_first) { int co = cj; asm volatile("" : "+v"(co)); const size_t hb = ((size_t)u.pm * 2 + 0) * FF2c + u.pn * 256 + bj * 128 + co + 4 * n; *(f32x4*)(HU + hb) = X; *(f32x4*)(HP + hb) = Y; } }
                        if (m == 3) { if (g == 3 && is_last) { int co = cj; asm volatile("" : "+v"(co)); const size_t hb = ((size_t)u.pm * 2 + 1) * FF2c + u.pn * 256 + bj * 128 + co + 4 * n; *(f32x4*)(HU + hb) = X; *(f32x4*)(HP + hb) = Y; } }
                        if (n == 0) acc[ai][bj][m][0] = (f32x4){silu_f(Y[0]), silu_f(Y[1]), silu_f(Y[2]), silu_f(Y[3])};
                        else { const f32x4 o = acc[ai][bj][m][0] * Y; const unsigned wl = cvt_pk_bf16(o[0], o[1]), wh = cvt_pk_bf16(o[2], o[3]);
                            if (bj == 0) { park[m][0] = wl; park[m][1] = wh; }
                            else { u32x4 w; w.x = park[m][0]; w.y = park[m][1]; w.z = wl; w.w = wh; NT_STORE(w, (u32x4*)(G + tiled(row0 + ai * HALF + m * 16, f0, FFc >> 5))); } }
                    }
                    __builtin_amdgcn_sched_barrier(0);
                }
            }
        }
    }
};
struct EpiNull {
    static constexpr bool PERM = true, AFTER_DRAIN = false;
    float* sink;
    __device__ __forceinline__ void operator()(const f32x4 (&acc)[2][2][4][2], const Unit& u, int wr, int wc, int fr, int fq) const {
        float s = 0.f;
#pragma unroll
        for (int ai = 0; ai < 2; ++ai)
#pragma unroll
            for (int bj = 0; bj < 2; ++bj)
#pragma unroll
                for (int m = 0; m < 4; ++m)
#pragma unroll
                    for (int n = 0; n < 2; ++n) s += (acc[ai][bj][m][n][0] + acc[ai][bj][m][n][1]) + (acc[ai][bj][m][n][2] + acc[ai][bj][m][n][3]);
        if (s == 1.2345678e30f) sink[0] = s;
    }
};

struct EpiStoreOnly {
    static constexpr bool PERM = true, AFTER_DRAIN = false;
    bf16_t* O; int ldc; int pn_lim;
    __device__ __forceinline__ void operator()(const f32x4 (&acc)[2][2][4][2], const Unit& u, int wr, int wc, int fr, int fq) const {
        if (u.pn >= pn_lim) return;
        const int row0 = u.pm * BM + wr * 64 + fr, col0 = u.pn * BM + wc * 32 + 8 * fq;
#pragma unroll
        for (int ai = 0; ai < 2; ++ai)
#pragma unroll
            for (int m = 0; m < 4; ++m) {
                bf16_t* rowp = O + (size_t)(row0 + ai * HALF + m * 16) * ldc + col0;
#pragma unroll
                for (int bj = 0; bj < 2; ++bj) {
                    const f32x4 v0 = acc[ai][bj][m][0], v1 = acc[ai][bj][m][1];
                    u32x4 w; w.x = cvt_pk_bf16(v0[0], v0[1]); w.y = cvt_pk_bf16(v0[2], v0[3]); w.z = cvt_pk_bf16(v1[0], v1[1]); w.w = cvt_pk_bf16(v1[2], v1[3]);
                    *(u32x4*)(rowp + bj * HALF) = w;
                }
            }
    }
};
struct EpiLoadOnly {
    static constexpr bool PERM = true, AFTER_DRAIN = false;
    float* sink; const float* ssq; const float* tcos; const float* tsin;
    __device__ __forceinline__ void operator()(const f32x4 (&acc)[2][2][4][2], const Unit& u, int wr, int wc, int fr, int fq) const {
        const int row0 = u.pm * BM + wr * 64 + fr; const int fi = 4 * ((wc & 1) * 4 + fq);
        float rs[2][4]; rows_rstd(ssq, row0, fq, rs); float s = 0.f;
#pragma unroll
        for (int ai = 0; ai < 2; ++ai)
#pragma unroll
            for (int m = 0; m < 4; ++m) { const int row = row0 + ai * HALF + m * 16; const f32x4 c4 = *(const f32x4*)(tcos + (size_t)row * 32 + fi), s4 = *(const f32x4*)(tsin + (size_t)row * 32 + fi);
#pragma unroll
                for (int bj = 0; bj < 2; ++bj) { const f32x4 x1 = acc[ai][bj][m][0] * rs[ai][m], x2 = acc[ai][bj][m][1] * rs[ai][m]; const f32x4 y1 = x1 * c4 - x2 * s4, y2 = x2 * c4 + x1 * s4;
                    s += (y1[0] + y1[1]) + (y1[2] + y1[3]) + (y2[0] + y2[1]) + (y2[2] + y2[3]); } }
        if (s == 1.2345678e30f) sink[0] = s;
    }
};
template <class Epi, class Sched, bool ALIGN_EPI = false, bool SP2 = false>
__device__ __forceinline__ void gemm_phase(PG8_LAS unsigned char* lds, const Gemm g, const Sched& S, const Epi& E) {
    int tid = threadIdx.x; asm volatile("" : "+v"(tid));
    const int wid = __builtin_amdgcn_readfirstlane(tid >> 6), lane = tid & 63, wr = wid >> 2, wc = wid & 3, fr = lane & 15, fq = lane >> 4;
    const int K = g.K, nt = K / BK;
    unsigned voffA[2], voffB[2];
#pragma unroll
    for (int i = 0; i < 2; ++i) { int R, C; stage_rc(tid * 16 + i * 8192, R, C); const int Rb = Epi::PERM ? ((R & ~31) + perm32(R & 31)) : R;
        voffA[i] = (unsigned)((R >> 4) * 16 * K + (C >> 5) * 512 + (R & 15) * 32 + (C & 31)) * 2u;     voffB[i] = (unsigned)(Rb * K + C) * 2u; }
    const size_t kstep = (size_t)(BK * 2);
    const size_t kstepA = 2048;
    const size_t hstep = (size_t)HALF * K * 2;
    const size_t tstep = 2 * hstep;
    const unsigned ldsw = (unsigned)wid * 1024u;
    const int aoff = lds_byte(wr * 64 + fr, fq * 8), boff = lds_byte(wc * 32 + fr, fq * 8);
#define PG8_SA(b, h) (((b) * 2 + (h)) * HTB)
#define PG8_SB(b, h) ((4 + (b) * 2 + (h)) * HTB)
#define PG8_STAGE(bufoff, gbase, voff) do { _Pragma("unroll") for (int _i = 0; _i < 2; ++_i) \
        __builtin_amdgcn_global_load_lds((const unsigned*)((const char*)(gbase) + (voff)[_i]), (PG8_LAS unsigned*)(lds + (bufoff) + ldsw + _i * 8192), 16, 0, 0); } while (0)
#define PG8_LDA(dst, b, h) do { _Pragma("unroll") for (int m = 0; m < 4; ++m) _Pragma("unroll") for (int k = 0; k < 2; ++k) dst[m][k] = *(const PG8_LAS bf16x8*)(lds + PG8_SA(b, h) + aoff + m * 2048 + k * 1024); } while (0)
#define PG8_LDB(dst, b, h) do { _Pragma("unroll") for (int n = 0; n < 2; ++n) _Pragma("unroll") for (int k = 0; k < 2; ++k) dst[n][k] = *(const PG8_LAS bf16x8*)(lds + PG8_SB(b, h) + boff + n * 2048 + k * 1024); } while (0)
#define PG8_MMA(ai, bj, At, Bt) do { __builtin_amdgcn_s_setprio(1); _Pragma("unroll") for (int m = 0; m < 4; ++m) _Pragma("unroll") for (int n = 0; n < 2; ++n) _Pragma("unroll") for (int k = 0; k < 2; ++k) \
        acc[ai][bj][m][n] = __builtin_amdgcn_mfma_f32_16x16x32_bf16(Bt[n][k], At[m][k], acc[ai][bj][m][n], 0, 0, 0); __builtin_amdgcn_s_setprio(0); } while (0)
#define PG8_WAIT_V(n) asm volatile("s_waitcnt vmcnt(" #n ")" ::: "memory")
#define PG8_WAIT_L(n) asm volatile("s_waitcnt lgkmcnt(" #n ")" ::: "memory")
#define PG8_BAR __builtin_amdgcn_s_barrier()
#define PG8_SCHED __builtin_amdgcn_sched_barrier(0)
    Unit cur, nxt; int ui = 0;
    if (!S.next(0, cur)) return;
    f32x4 acc[2][2][4][2];
#pragma unroll
    for (int a = 0; a < 2; ++a)
#pragma unroll
        for (int b = 0; b < 2; ++b)
#pragma unroll
            for (int m = 0; m < 4; ++m)
#pragma unroll
                for (int n = 0; n < 2; ++n) acc[a][b][m][n] = (f32x4){0.f, 0.f, 0.f, 0.f};
    bf16x8 At[4][2], B0[2][2], B1[2][2];
    const char* cA = (const char*)g.A + (size_t)cur.pm * tstep; const char* cB = (const char*)g.Bt + (size_t)cur.pn * tstep;
    S.a_ready(cur);
    if constexpr (SP2) {
        PG8_STAGE(PG8_SB(0, 0), cB, voffB); PG8_STAGE(PG8_SB(0, 1), cB + hstep, voffB); PG8_STAGE(PG8_SA(0, 0), cA, voffA); PG8_STAGE(PG8_SA(0, 1), cA + hstep, voffA);
        if (wr == 1) PG8_BAR;
        PG8_WAIT_V(2); PG8_BAR;
        PG8_STAGE(PG8_SB(1, 0), cB + kstep, voffB); PG8_STAGE(PG8_SA(1, 0), cA + kstepA, voffA); PG8_STAGE(PG8_SB(1, 1), cB + hstep + kstep, voffB);
        PG8_WAIT_V(6); PG8_BAR;
    } else {
        PG8_STAGE(PG8_SB(0, 0), cB, voffB); PG8_STAGE(PG8_SA(0, 0), cA, voffA); PG8_STAGE(PG8_SB(0, 1), cB + hstep, voffB); PG8_STAGE(PG8_SA(0, 1), cA + hstep, voffA);
        if (wr == 1) PG8_BAR;
        PG8_WAIT_V(4); PG8_BAR;
        PG8_STAGE(PG8_SB(1, 0), cB + kstep, voffB); PG8_STAGE(PG8_SA(1, 0), cA + kstepA, voffA); PG8_STAGE(PG8_SB(1, 1), cB + hstep + kstep, voffB);
        PG8_WAIT_V(6); PG8_BAR;
    }
    for (;;) {
        const bool has_next = S.next(ui + 1, nxt);
        const char* nA = has_next ? (const char*)g.A + (size_t)nxt.pm * tstep : cA; const char* nB = has_next ? (const char*)g.Bt + (size_t)nxt.pn * tstep : cB;
        for (int t = 0; t < nt; t += 2) {
            const bool last = (t == nt - 2);
            const char* a1 = cA + (size_t)(t + 1) * kstepA;
            const char* a2 = last ? nA : cA + (size_t)(t + 2) * kstepA; const char* b2 = last ? nB : cB + (size_t)(t + 2) * kstep;
            const char* a3 = a2 + kstepA; const char* b3 = b2 + kstep;
            if (last && has_next) S.a_ready(nxt);
            if constexpr (SP2) {
            PG8_LDB(B0, 0, 0); PG8_LDB(B1, 0, 1); PG8_SCHED; PG8_LDA(At, 0, 0); PG8_STAGE(PG8_SA(1, 1), a1 + hstep, voffA);
            PG8_WAIT_V(8); PG8_WAIT_L(0); PG8_BAR; PG8_MMA(0, 0, At, B0); PG8_MMA(0, 1, At, B1); PG8_BAR; PG8_SCHED;
            PG8_LDA(At, 0, 1); PG8_STAGE(PG8_SB(0, 0), b2, voffB); PG8_STAGE(PG8_SB(0, 1), b2 + hstep, voffB); PG8_STAGE(PG8_SA(0, 0), a2, voffA);
            PG8_WAIT_V(8); PG8_WAIT_L(0); PG8_BAR; PG8_MMA(1, 0, At, B0); PG8_MMA(1, 1, At, B1); PG8_BAR; PG8_SCHED;
            PG8_LDB(B0, 1, 0); PG8_LDB(B1, 1, 1); PG8_SCHED; PG8_LDA(At, 1, 0); PG8_STAGE(PG8_SA(0, 1), a2 + hstep, voffA);
            PG8_WAIT_V(8); PG8_WAIT_L(0); PG8_BAR; PG8_MMA(0, 0, At, B0); PG8_MMA(0, 1, At, B1); PG8_BAR; PG8_SCHED;
            PG8_LDA(At, 1, 1); PG8_STAGE(PG8_SB(1, 0), b3, voffB); PG8_STAGE(PG8_SB(1, 1), b3 + hstep, voffB); PG8_STAGE(PG8_SA(1, 0), a3, voffA);
            PG8_WAIT_V(8); PG8_WAIT_L(0); PG8_BAR; PG8_MMA(1, 0, At, B0); PG8_MMA(1, 1, At, B1); PG8_BAR; PG8_SCHED;
            } else {
            PG8_LDB(B0, 0, 0); PG8_SCHED; PG8_LDA(At, 0, 0); PG8_STAGE(PG8_SA(1, 1), a1 + hstep, voffA);
            PG8_WAIT_L(8); PG8_BAR; PG8_WAIT_L(0); PG8_MMA(0, 0, At, B0); PG8_BAR; PG8_SCHED;
            PG8_LDB(B1, 0, 1); PG8_STAGE(PG8_SB(0, 0), b2, voffB);
            PG8_BAR; PG8_WAIT_L(0); PG8_MMA(0, 1, At, B1); PG8_BAR;
            PG8_LDA(At, 0, 1); PG8_STAGE(PG8_SA(0, 0), a2, voffA);
            PG8_BAR; PG8_WAIT_L(0); PG8_MMA(1, 0, At, B0); PG8_BAR; PG8_SCHED;
            PG8_STAGE(PG8_SB(0, 1), b2 + hstep, voffB);
            PG8_WAIT_V(6); PG8_BAR; PG8_MMA(1, 1, At, B1); PG8_BAR;
            PG8_LDB(B0, 1, 0); PG8_SCHED; PG8_LDA(At, 1, 0); PG8_STAGE(PG8_SA(0, 1), a2 + hstep, voffA);
            PG8_WAIT_L(8); PG8_BAR; PG8_WAIT_L(0); PG8_MMA(0, 0, At, B0); PG8_BAR; PG8_SCHED;
            PG8_LDB(B1, 1, 1); PG8_STAGE(PG8_SB(1, 0), b3, voffB);
            PG8_BAR; PG8_WAIT_L(0); PG8_MMA(0, 1, At, B1); PG8_BAR;
            PG8_LDA(At, 1, 1); PG8_STAGE(PG8_SA(1, 0), a3, voffA);
            PG8_BAR; PG8_WAIT_L(0); PG8_MMA(1, 0, At, B0); PG8_BAR; PG8_SCHED;
            PG8_STAGE(PG8_SB(1, 1), b3 + hstep, voffB);
            PG8_WAIT_V(6); PG8_BAR; PG8_MMA(1, 1, At, B1); PG8_BAR;
            }
        }
        if constexpr (ALIGN_EPI) { if (wr == 0) PG8_BAR; }
        if constexpr (!Epi::AFTER_DRAIN) { E(acc, cur, wr, wc, fr, fq); S.done(cur); }
        if (!has_next) break;
#pragma unroll
        for (int a = 0; a < 2; ++a)
#pragma unroll
            for (int b = 0; b < 2; ++b)
#pragma unroll
                for (int m = 0; m < 4; ++m)
#pragma unroll
                    for (int n = 0; n < 2; ++n) acc[a][b][m][n] = (f32x4){0.f, 0.f, 0.f, 0.f};
        cur = nxt; cA = nA; cB = nB; ++ui;
        if constexpr (ALIGN_EPI) { if (wr == 1) PG8_BAR; }
    }
    PG8_WAIT_V(0);
    if constexpr (!ALIGN_EPI) { if (wr == 0) PG8_BAR; }
    PG8_BAR;
    if constexpr (Epi::AFTER_DRAIN) { E.fused(acc, cur, wr, wc, fr, fq, lds, wid, lane); S.done(cur); }
#undef PG8_SA
#undef PG8_SB
#undef PG8_STAGE
#undef PG8_LDA
#undef PG8_LDB
#undef PG8_MMA
#undef PG8_WAIT_V
#undef PG8_WAIT_L
#undef PG8_BAR
#undef PG8_SCHED
}
}

namespace att {
typedef unsigned short bf16_t;
using bf16x8 = __attribute__((ext_vector_type(8))) short;
using s16x4  = __attribute__((ext_vector_type(4))) short;
using f32x16 = __attribute__((ext_vector_type(16))) float;
using u32x4  = __attribute__((ext_vector_type(4))) unsigned;
using f32x4a = __attribute__((ext_vector_type(4))) float;
constexpr int DV = 128, DQK = 64, NW = 8, QBLK = 32, KVBLK = 64, OLD = 1024, SEQ = 2048;
constexpr int NBUF = 4, SHM_V = KVBLK * DV * 2, SHM_K = KVBLK * DQK * 2, OFF_V = 0, OFF_K = NBUF * SHM_V, OFF_WS = OFF_K + NBUF * SHM_K, SHM_TOTAL = OFF_WS + NW * 64 * 4;
constexpr float THR2 = 11.5f;
__device__ __forceinline__ int tl(int row, int col) { return (((row >> 4) * 32 + (col >> 5)) << 9) + ((row & 15) << 5) + (col & 31); }
#define AKSW(row, colB) ((row) * 128 + ((colB) ^ ((((row) >> 1) & 7) << 4)))
#define ASBAR() __builtin_amdgcn_sched_barrier(0)
__device__ __forceinline__ int crow(int r, int hi) { return (r & 3) + 8 * (r >> 2) + 4 * hi; }
__device__ __forceinline__ unsigned cvtpk(float lo, float hi) { unsigned r; asm volatile("v_cvt_pk_bf16_f32 %0, %1, %2" : "=v"(r) : "v"(lo), "v"(hi)); return r; }

__device__ __forceinline__ float fadd_s(float a, float b) { float r; asm("v_add_f32_e32 %0, %1, %2" : "=v"(r) : "v"(a), "v"(b)); return r; }
__device__ __forceinline__ float fsub_s(float a, float b) { float r; asm("v_sub_f32_e32 %0, %1, %2" : "=v"(r) : "v"(a), "v"(b)); return r; }
template <bool FAST> __device__ __forceinline__ void partialSM(f32x16& p0, f32x16& p1, float& m_reg, float& mn, float& alpha) {
  if constexpr (FAST) {
#pragma unroll
    for (int r = 0; r < 16; ++r) p0[r] = __builtin_amdgcn_exp2f(p0[r]);
    alpha = 1.f; mn = 0.f; return;
  }
  float pmax = p0[0];
#pragma unroll
  for (int r = 1; r < 16; ++r) pmax = fmaxf(pmax, p0[r]);
#pragma unroll
  for (int r = 0; r < 16; ++r) pmax = fmaxf(pmax, p1[r]);
  { unsigned xa = __float_as_uint(pmax), xb; asm volatile("v_mov_b32 %0, %1" : "=v"(xb) : "v"(xa)); auto rr = __builtin_amdgcn_permlane32_swap(xa, xb, false, false);
    pmax = fmaxf(__uint_as_float(rr[0]), __uint_as_float(rr[1])); }
  if (__builtin_expect(__all(pmax - m_reg <= THR2), 1)) { mn = m_reg; alpha = 1.f; }
  else { mn = fmaxf(m_reg, pmax); alpha = __builtin_amdgcn_exp2f(m_reg - mn); m_reg = mn; }
#pragma unroll
  for (int r = 0; r < 16; ++r) p0[r] = fsub_s(p0[r], mn);
#pragma unroll
  for (int r = 0; r < 16; ++r) p1[r] = fsub_s(p1[r], mn);
#pragma unroll
  for (int r = 0; r < 16; ++r) p0[r] = __builtin_amdgcn_exp2f(p0[r]);
}
__device__ __forceinline__ void finishSM(f32x16& p0, f32x16& p1, float alpha, float& l_reg, bf16x8& pa0, bf16x8& pa1, bf16x8& pa2, bf16x8& pa3) {
#pragma unroll
  for (int r = 0; r < 16; ++r) p1[r] = __builtin_amdgcn_exp2f(p1[r]);
  float ps = fadd_s(p0[0], p1[0]), ps2 = fadd_s(p0[1], p1[1]);
#pragma unroll
  for (int r = 2; r < 16; r += 2) { ps = fadd_s(ps, p0[r]); ps2 = fadd_s(ps2, p0[r + 1]); }
#pragma unroll
  for (int r = 2; r < 16; r += 2) { ps = fadd_s(ps, p1[r]); ps2 = fadd_s(ps2, p1[r + 1]); }
  ps = fadd_s(ps, ps2);
  ps = lane_xor_add<32>(ps);
  l_reg = l_reg * alpha + ps;
#define APK4(P, BASE, OUT) do { unsigned a0 = cvtpk(P[BASE + 0], P[BASE + 1]), a1 = cvtpk(P[BASE + 2], P[BASE + 3]);   \
    unsigned b0 = cvtpk(P[BASE + 4], P[BASE + 5]), b1 = cvtpk(P[BASE + 6], P[BASE + 7]);                              \
    auto r0 = __builtin_amdgcn_permlane32_swap(a0, b0, false, false); auto r1 = __builtin_amdgcn_permlane32_swap(a1, b1, false, false); \
    u32x4 w = {r0[0], r1[0], r0[1], r1[1]}; OUT = *reinterpret_cast<bf16x8*>(&w); } while (0)
  APK4(p0, 0, pa0); APK4(p0, 8, pa1); APK4(p1, 0, pa2); APK4(p1, 8, pa3);
#undef APK4
}
__device__ __forceinline__ void qkt(f32x16& p0, f32x16& p1, const char* Ks, const bf16x8* qr, int r32, int hi) {
  p0 = f32x16{}; p1 = f32x16{};
#pragma unroll
  for (int d0 = 0; d0 < 4; ++d0) { const int cb = d0 * 32 + hi * 16;
    const bf16x8 b0 = *reinterpret_cast<const bf16x8*>(Ks + AKSW(r32, cb));
    const bf16x8 b1 = *reinterpret_cast<const bf16x8*>(Ks + AKSW(32 + r32, cb));
    p0 = __builtin_amdgcn_mfma_f32_32x32x16_bf16(b0, qr[d0], p0, 0, 0, 0);
    p1 = __builtin_amdgcn_mfma_f32_32x32x16_bf16(b1, qr[d0], p1, 0, 0, 0); }
}
__device__ __forceinline__ int v_st(int k, int c) { const int kk = (k & ~0xC) | ((k & 4) << 1) | ((k & 8) >> 1); return ((kk >> 3) * 4 + (c >> 5)) * 512 + ((kk & 7) * 32 + (c & 31)) * 2; }
__device__ __forceinline__ int v_rd_base(int lane) { return ((lane & 3) << 3) | (((lane >> 2) & 3) << 6) | (((lane >> 4) & 1) << 5) | (((lane >> 5) & 1) << 8); }
constexpr int v_rd_off(int d0, int ks, int half) { return d0 * 512 + ks * 4096 + half * 2048; }
template <int OFF> __device__ __forceinline__ s16x4 tr_read(int vb) {
  s16x4 r; asm volatile("ds_read_b64_tr_b16 %0, %1 offset:%2" : "=&v"(r) : "v"(vb), "i"(OFF) : "memory"); return r;
}
template <int KS> __device__ __forceinline__ void pv_step(f32x16* o, int vb, bf16x8 pa) {
  const s16x4 l0 = tr_read<v_rd_off(0, KS, 0)>(vb), h0 = tr_read<v_rd_off(0, KS, 1)>(vb), l1 = tr_read<v_rd_off(1, KS, 0)>(vb), h1 = tr_read<v_rd_off(1, KS, 1)>(vb);
  const s16x4 l2 = tr_read<v_rd_off(2, KS, 0)>(vb), h2 = tr_read<v_rd_off(2, KS, 1)>(vb), l3 = tr_read<v_rd_off(3, KS, 0)>(vb), h3 = tr_read<v_rd_off(3, KS, 1)>(vb);
  asm volatile("s_waitcnt lgkmcnt(0)" ::: "memory"); ASBAR();
#define APK(L, H) (bf16x8){L[0], L[1], L[2], L[3], H[0], H[1], H[2], H[3]}
  o[0] = __builtin_amdgcn_mfma_f32_32x32x16_bf16(pa, APK(l0, h0), o[0], 0, 0, 0);
  o[1] = __builtin_amdgcn_mfma_f32_32x32x16_bf16(pa, APK(l1, h1), o[1], 0, 0, 0);
  o[2] = __builtin_amdgcn_mfma_f32_32x32x16_bf16(pa, APK(l2, h2), o[2], 0, 0, 0);
  o[3] = __builtin_amdgcn_mfma_f32_32x32x16_bf16(pa, APK(l3, h3), o[3], 0, 0, 0);
#undef APK
}
__device__ __forceinline__ void pv_d0(f32x16* o, int vb, bf16x8 pa0, bf16x8 pa1, bf16x8 pa2, bf16x8 pa3) {
  pv_step<0>(o, vb, pa0); pv_step<1>(o, vb, pa1); pv_step<2>(o, vb, pa2); pv_step<3>(o, vb, pa3);
}

__device__ __forceinline__ void glds16(const void* gsrc, unsigned lds_dst) { unsigned keep;
  asm volatile("s_mov_b32 %0, m0\n\ts_mov_b32 m0, %2\n\ts_nop 0\n\tglobal_load_lds_dwordx4 %1, off\n\ts_mov_b32 m0, %0" : "=&s"(keep) : "v"(gsrc), "s"(lds_dst) : "memory"); }
#define AWAIT_BAR(N) asm volatile("s_waitcnt vmcnt(" #N ") lgkmcnt(0)\n\ts_barrier" ::: "memory")
template <bool FAST> __device__ __forceinline__ void attn_pass(const bf16_t* __restrict__ Qb, const bf16_t* __restrict__ Kh, const bf16_t* __restrict__ Vh, int qcol, int kcol, int vcol, char* lds, f32x16 (&o)[4]) {
  int tid = threadIdx.x; asm volatile("" : "+v"(tid));
  const int wid = tid >> 6, lane = tid & 63, r32 = lane & 31, hi = lane >> 5;
  const int wids = __builtin_amdgcn_readfirstlane(wid);
  char* V_lds = lds + OFF_V; char* K_lds = lds + OFF_K;
  float* ws = (float*)(lds + OFF_WS) + wid * 64; float* li_l = ws; float* al_l = ws + 32;
  float m_reg = -1e30f, l_reg = 0; bf16x8 qr[4];
#pragma unroll
  for (int d = 0; d < 4; ++d) o[d] = f32x16{};
#pragma unroll
  for (int d0 = 0; d0 < 4; ++d0) qr[d0] = *reinterpret_cast<const bf16x8*>(Qb + tl(wid * QBLK + r32, qcol + d0 * 16 + hi * 8));
  const int vb0 = (int)(uintptr_t)V_lds + v_rd_base(lane);
  const int krow = 8 * wid + (lane >> 3), kof = tl(krow, kcol + 8 * ((lane & 7) ^ ((krow >> 1) & 7)));
  int vof[2];
#pragma unroll
  for (int i = 0; i < 2; ++i) { const int q = 2 * wid + i, kk = (q >> 1) * 8 + ((lane >> 2) & 7), key = (kk & ~0xC) | ((kk & 4) << 1) | ((kk & 8) >> 1);
    vof[i] = tl(key, vcol + (2 * (q & 1) + (lane >> 5)) * 32 + (lane & 3) * 8); }
  const unsigned kdst = (unsigned)(uintptr_t)K_lds + wids * 1024, vdst = (unsigned)(uintptr_t)V_lds + wids * 2048;
#define ADMA(t) do { const int t_ = (t) < NT ? (t) : NT - 1; const int bb = (t) & 3; \
    glds16(Kh + (long)t_ * (KVBLK * 1024) + kof, (unsigned)__builtin_amdgcn_readfirstlane(kdst + bb * SHM_K)); \
    glds16(Vh + (long)t_ * (KVBLK * 1024) + vof[0], (unsigned)__builtin_amdgcn_readfirstlane(vdst + bb * SHM_V)); \
    glds16(Vh + (long)t_ * (KVBLK * 1024) + vof[1], (unsigned)__builtin_amdgcn_readfirstlane(vdst + bb * SHM_V + 1024)); } while (0)
#define ARESC(a) do { if (!FAST && __any((a) < 1.f)) { if (hi == 0) al_l[r32] = (a); asm volatile("s_waitcnt lgkmcnt(0)" ::: "memory"); \
    _Pragma("unroll") for (int d = 0; d < 4; ++d) _Pragma("unroll") for (int r = 0; r < 16; ++r) o[d][r] *= al_l[crow(r, hi)]; } } while (0)
  f32x16 pA0, pA1, pB0, pB1; float mnA, mnB, alA, alB; bf16x8 pa0, pa1, pa2, pa3; constexpr int NT = SEQ / KVBLK;
  ADMA(0); ADMA(1);
  AWAIT_BAR(3);
  qkt(pA0, pA1, K_lds, qr, r32, hi); partialSM<FAST>(pA0, pA1, m_reg, mnA, alA);
  ADMA(2);
  AWAIT_BAR(3);
  for (int j = 1; j + 1 < NT; j += 2) {
    ASBAR(); qkt(pB0, pB1, K_lds + (j & 3) * SHM_K, qr, r32, hi);
    finishSM(pA0, pA1, alA, l_reg, pa0, pa1, pa2, pa3); ASBAR();
    ADMA(j + 2); ASBAR();
    pv_d0(o, vb0 + ((j - 1) & 3) * SHM_V, pa0, pa1, pa2, pa3); partialSM<FAST>(pB0, pB1, m_reg, mnB, alB);
    ARESC(alB); AWAIT_BAR(3);
    ASBAR(); qkt(pA0, pA1, K_lds + ((j + 1) & 3) * SHM_K, qr, r32, hi);
    finishSM(pB0, pB1, alB, l_reg, pa0, pa1, pa2, pa3); ASBAR();
    ADMA(j + 3); ASBAR();
    pv_d0(o, vb0 + (j & 3) * SHM_V, pa0, pa1, pa2, pa3); partialSM<FAST>(pA0, pA1, m_reg, mnA, alA);
    ARESC(alA); AWAIT_BAR(3);
  }
  ASBAR(); qkt(pB0, pB1, K_lds + ((NT - 1) & 3) * SHM_K, qr, r32, hi);
  finishSM(pA0, pA1, alA, l_reg, pa0, pa1, pa2, pa3); ASBAR();
  pv_d0(o, vb0 + ((NT - 2) & 3) * SHM_V, pa0, pa1, pa2, pa3); partialSM<FAST>(pB0, pB1, m_reg, mnB, alB);
  ARESC(alB);
  finishSM(pB0, pB1, alB, l_reg, pa0, pa1, pa2, pa3); ASBAR();
  pv_d0(o, vb0 + ((NT - 1) & 3) * SHM_V, pa0, pa1, pa2, pa3);
  if (hi == 0) li_l[r32] = l_reg; asm volatile("s_waitcnt lgkmcnt(0)" ::: "memory");
#pragma unroll
  for (int r = 0; r < 16; ++r) { const float rl = __builtin_amdgcn_rcpf(li_l[crow(r, hi)]);
#pragma unroll
    for (int d = 0; d < 4; ++d) o[d][r] *= rl; }
  AWAIT_BAR(0);
#undef ADMA
#undef ARESC
}

__device__ __forceinline__ void attn_unit(int b, int h, int qb, const bf16_t* Q, const bf16_t* K, const bf16_t* V, bf16_t* O, float* stash,
                                          float lam, const float* subg, float osc, char* lds) {
  const long rowbase = (long)b * SEQ, q0 = (long)qb * 256;
  const bf16_t* Qb = Q + (rowbase + q0) * 1024; const bf16_t* Kh = K + rowbase * 1024; const bf16_t* Vh = V + rowbase * 1024;
  unsigned keep[32];
#pragma unroll 1
  for (int c = 0; c < 2; ++c) {
    f32x16 o[4];
    attn_pass<false>(Qb, Kh, Vh, h * 128 + c * 64, h * 128 + c * 64, h * 128, lds, o);
    int zz = 0; asm volatile("" : "+v"(zz));
    const int tid = (int)threadIdx.x + zz, wid = tid >> 6, lane = tid & 63, r32 = lane & 31, hi = lane >> 5;
    (void)stash;
    if (c == 0) {
#pragma unroll
      for (int d = 0; d < 4; ++d)
#pragma unroll
        for (int q = 0; q < 8; ++q) keep[d * 8 + q] = cvtpk(o[d][2 * q], o[d][2 * q + 1]);
    } else {
      float g4[4];
#pragma unroll
      for (int d = 0; d < 4; ++d) g4[d] = subg[32 * d + r32] * osc;
      bf16_t* Ow = O + (rowbase + q0 + wid * QBLK) * 1024;
#pragma unroll
      for (int q = 0; q < 4; ++q) {
        f32x4a s4[4];
#pragma unroll
        for (int d = 0; d < 4; ++d) { const unsigned w0 = keep[d * 8 + 2 * q], w1 = keep[d * 8 + 2 * q + 1];
          s4[d] = (f32x4a){__uint_as_float(w0 << 16), __uint_as_float(w0 & 0xffff0000u), __uint_as_float(w1 << 16), __uint_as_float(w1 & 0xffff0000u)}; }
#pragma unroll
        for (int j = 0; j < 4; ++j) { const int r = 4 * q + j;
          float e[4];
#pragma unroll
          for (int d = 0; d < 4; ++d) e[d] = s4[d][j] - lam * o[d][r];
          float ss = (e[0] * e[0] + e[1] * e[1]) + (e[2] * e[2] + e[3] * e[3]);
          ss = lane_xor_add<1>(ss); ss = lane_xor_add<2>(ss); ss = lane_xor_add<4>(ss); ss = lane_xor_add<8>(ss); ss = lane_xor_add<16>(ss);
          const float rs = __builtin_amdgcn_rsqf(ss * (1.0f / 128.0f) + 1e-5f);
          const int orow = crow(r, hi);
#pragma unroll
          for (int d = 0; d < 4; ++d) Ow[tiled(orow, h * 128 + d * 32 + r32, 32)] = (bf16_t)(cvtpk(e[d] * rs * g4[d], 0.f) & 0xffffu);
        }
      }
    }
  }
}
#undef AKSW
#undef ASBAR
}
#ifndef LAS
#define LAS __attribute__((address_space(3)))
#endif
#define XB_TMO      128
#define XB_XCNT(j)  (256  + 64 * (j))
#define XB_XSUB(j)  (1280 + 64 * (j))
#define XB_XGEN(j)  (2304 + 64 * (j))
#define XB_TOP      3328
#define XB_TOPGEN   3392
#define XCD_BAR_WORDS 3456
#define XB_SPIN_CAP (1u << 18)

__device__ __forceinline__ unsigned xb_ld(unsigned* p)              { return __hip_atomic_load(p, __ATOMIC_RELAXED, __HIP_MEMORY_SCOPE_AGENT); }
__device__ __forceinline__ unsigned xb_add(unsigned* p, unsigned v) { return __hip_atomic_fetch_add(p, v, __ATOMIC_RELAXED, __HIP_MEMORY_SCOPE_AGENT); }
__device__ __forceinline__ unsigned xb_xcc_id() { return (unsigned)__builtin_amdgcn_s_getreg((3 << 11) | 20) & 0xFu; }
#define XB_SPIN(cond, bar) do { unsigned _sp = 0; while (cond) { __builtin_amdgcn_s_sleep(1); \
    if ((++_sp & 255u) == 0u) { if (xb_ld(&(bar)[XB_TMO])) break; if (_sp > XB_SPIN_CAP) { atomicAdd(&(bar)[XB_TMO], 1u); break; } } } } while (0)

struct XcdBarrier {
    unsigned* bar; unsigned x;
    volatile LAS unsigned* st;
};

__device__ __forceinline__ XcdBarrier xcd_barrier_post(unsigned* bar, volatile LAS unsigned* st) {
    XcdBarrier b; b.bar = bar; b.x = xb_xcc_id(); b.st = st;
    if (threadIdx.x == 0) (void)xb_add(&bar[XB_XCNT(b.x)], 1u);
    return b;
}
__device__ __forceinline__ void xcd_barrier_complete(unsigned* bar, unsigned x, unsigned& nloc, unsigned& nx) {
    const unsigned G = gridDim.x * gridDim.y * gridDim.z;
    unsigned sum, cnt, mine, sp = 0u;
    for (;;) {
        sum = 0u; cnt = 0u; mine = 0u;
#pragma unroll
        for (unsigned j = 0; j < 16; ++j) { const unsigned c = xb_ld(&bar[XB_XCNT(j)]); sum += c; cnt += (c > 0u) ? 1u : 0u; mine = (j == x) ? c : mine; }
        if (sum == G) break;
        __builtin_amdgcn_s_sleep(1);
        if ((++sp & 255u) == 0u) { if (xb_ld(&bar[XB_TMO])) break; if (sp > XB_SPIN_CAP) { atomicAdd(&bar[XB_TMO], 1u); break; } }
    }
    nloc = mine > 0u ? mine : 1u; nx = cnt > 0u ? cnt : 1u;
}

__device__ __forceinline__ void xcd_barrier(const XcdBarrier& b) {
    asm volatile("s_waitcnt vmcnt(0)" ::: "memory");
    __syncthreads();
    if (threadIdx.x == 0) {
        unsigned* bar = b.bar;
        __builtin_amdgcn_s_waitcnt(0);
        unsigned nloc = b.st[0], nx = b.st[1];
        if (nloc == 0u) { xcd_barrier_complete(bar, b.x, nloc, nx); b.st[0] = nloc; b.st[1] = nx; }
        const unsigned old = xb_add(&bar[XB_XSUB(b.x)], 1u);
        const unsigned gen = old / nloc;
        if (old + 1u == (gen + 1u) * nloc) {
            __builtin_amdgcn_fence(__ATOMIC_RELEASE, "agent");
            asm volatile("s_waitcnt vmcnt(0)" ::: "memory");
            const unsigned og = xb_add(&bar[XB_TOP], 1u);
            const unsigned tg = og / nx;
            if (og + 1u == (tg + 1u) * nx) xb_add(&bar[XB_TOPGEN], 1u);
            else XB_SPIN(xb_ld(&bar[XB_TOPGEN]) == tg, bar);
            __builtin_amdgcn_fence(__ATOMIC_ACQUIRE, "agent");
            xb_add(&bar[XB_XGEN(b.x)], 1u);
            asm volatile("s_waitcnt vmcnt(0)" ::: "memory");
        } else {
            XB_SPIN(xb_ld(&bar[XB_XGEN(b.x)]) == gen, bar);
            __builtin_amdgcn_fence(__ATOMIC_ACQUIRE, "agent");
            asm volatile("s_waitcnt vmcnt(0)" ::: "memory");
        }
    }
    __syncthreads();
}


namespace cg = cooperative_groups;
#define LAS __attribute__((address_space(3)))
typedef unsigned short bf16;
typedef unsigned v4u __attribute__((ext_vector_type(4)));
typedef float f32x4 __attribute__((ext_vector_type(4)));
typedef short bf16x8 __attribute__((ext_vector_type(8)));
constexpr int NWAVES = 8, NTHR = 512;
constexpr int BATCH = 32, SEQ = 2048, D = 1024, M = BATCH * SEQ, FF = 2816, FF2 = 2 * FF, NH = 8;
constexpr int MH = M / 2;
constexpr size_t MiB = 1u << 20;
constexpr size_t WS_WQKV = 0, WS_WO = 6 * MiB, WS_WIN = 8 * MiB, WS_WOUT = 14 * MiB, WS_WUP0 = 16 * MiB, WS_WUP1 = 27 * MiB, WS_WDN0 = 38 * MiB, WS_WDN1 = 44 * MiB;
constexpr size_t WS_COS = 64 * MiB, WS_SIN = 72 * MiB;
constexpr size_t WS_SSQ = 80 * MiB, SSQ_BYTES = 4 * MiB;
constexpr size_t WS_CTL = 100 * MiB, CTL_BYTES = 16384;
constexpr size_t WS_XB = 104 * MiB;
constexpr size_t WS_R = 232 * MiB;
constexpr size_t WS_Q = WS_R, WS_K = WS_R + 128 * MiB, WS_V = WS_R + 256 * MiB, WS_O = WS_R + 384 * MiB;
constexpr size_t WS_G = WS_R, WS_U = WS_R + 352 * MiB;
constexpr size_t WS_HU = WS_R + 352 * MiB, WS_HP = WS_HU + 16 * MiB;
constexpr size_t WS_STASH = 936 * MiB;
constexpr size_t WS_END = 1000 * MiB;
constexpr int LDS_BYTES = 147456;
static_assert(att::SHM_TOTAL <= 131072, "attention LDS");

__device__ __forceinline__ unsigned f2bf(float f) { unsigned u = __builtin_bit_cast(unsigned, f); return (u + 0x7fffu + ((u >> 16) & 1u)) >> 16; }
__device__ __forceinline__ unsigned pk2(float lo, float hi) { return f2bf(lo) | (f2bf(hi) << 16); }
__device__ __forceinline__ float bflo(unsigned w) { return __builtin_bit_cast(float, w << 16); }
__device__ __forceinline__ float bfhi(unsigned w) { return __builtin_bit_cast(float, w & 0xffff0000u); }
__device__ __forceinline__ float wave_sum(float v) {
    v = lane_xor_add<1>(v); v = lane_xor_add<2>(v); v = lane_xor_add<4>(v); v = lane_xor_add<8>(v); v = lane_xor_add<16>(v); v = lane_xor_add<32>(v);
    return v;
}
__device__ __forceinline__ int dest_row(int mode, int n) {
    if (mode == 1 && n < 2048) { const int d = n & 63, dd = d & 31; return (n & ~63) + 8 * (dd >> 2) + (dd & 3) + ((d >> 5) << 2); }
    if (mode == 3) { if (n < D) return 2 * D + n; const int isu = n >= 2 * D ? 1 : 0, ff = n - D - isu * D, fl = ff & 127; return (ff >> 7) * 256 + 128 * ((fl >> 2) & 1) + 8 * (fl >> 3) + 4 * isu + (fl & 3); }
    if (mode == 2) { const int isval = n >= FF ? 1 : 0, ff = n - isval * FF, fl = ff & 127; return (ff >> 7) * 256 + 128 * ((fl >> 2) & 1) + 8 * (fl >> 3) + 4 * isval + (fl & 3); }
    return n;
}
__device__ __forceinline__ void transpose_item(const float* W, int K, int N, bf16* WT, const float* gk, int mode, LAS float* scr, int item, int lane) {
    const int nblk = N / 32, kb = item / nblk, nb = item % nblk, k0 = 64 * kb, n0 = 32 * nb;
    f32x4 v[8]; float g[8];
#pragma unroll
    for (int i = 0; i < 8; ++i) { const int kk = 8 * i + (lane >> 3); v[i] = *(const f32x4*)(W + (size_t)(k0 + kk) * N + n0 + 4 * (lane & 7)); g[i] = gk ? gk[k0 + kk] : 1.f; }
#pragma unroll
    for (int i = 0; i < 8; ++i) { const int kk = 8 * i + (lane >> 3); LAS float* d = scr + kk * 33 + 4 * (lane & 7);
        d[0] = v[i][0] * g[i]; d[1] = v[i][1] * g[i]; d[2] = v[i][2] * g[i]; d[3] = v[i][3] * g[i]; }
    asm volatile("s_waitcnt lgkmcnt(0)" ::: "memory");
    const int c = lane & 7;
#pragma unroll
    for (int j = 0; j < 4; ++j) { const int n = (lane >> 3) + 8 * j; const LAS float* s = scr + (8 * c) * 33 + n;
        v4u o; o.x = pk2(s[0 * 33], s[1 * 33]); o.y = pk2(s[2 * 33], s[3 * 33]); o.z = pk2(s[4 * 33], s[5 * 33]); o.w = pk2(s[6 * 33], s[7 * 33]);
        *(v4u*)(WT + (size_t)dest_row(mode, n0 + n) * K + k0 + 8 * c) = o; }
    asm volatile("s_waitcnt lgkmcnt(0)" ::: "memory");
}
__device__ __forceinline__ void sincos_cw(float a, float& s, float& c) {
    const float kf = rintf(a * 0.63661977236758134f); const int k = (int)kf;
    float r = fmaf(kf, -1.5703125f, a); r = fmaf(kf, -4.837512969970703125e-4f, r); r = fmaf(kf, -7.54978995489188216e-8f, r);
    const float z = r * r;
    const float sp = fmaf(r * z, fmaf(z, fmaf(z, -1.9515295891e-4f, 8.3321608736e-3f), -1.6666654611e-1f), r);
    const float cp = fmaf(z * z, fmaf(z, fmaf(z, 2.443315711809948e-5f, -1.388731625493765e-3f), 4.166664568298827e-2f), fmaf(z, -0.5f, 1.0f));
    const float ss = (k & 1) ? cp : sp, cc = (k & 1) ? sp : cp;
    s = (k & 2) ? -ss : ss; c = ((k + 1) & 2) ? -cc : cc;
}

struct Args {
    const float* x; const int* pos;
    const float *attn_g, *w_qkv, *lq1, *lk1, *lq2, *lk2, *subg, *w_o, *conv_g, *w_in, *conv_w, *w_out, *ffn_g, *w_up, *ffn_cw, *ffn_cb, *w_dn, *fin_g;
    float* out; unsigned char* ws;
};

__device__ __forceinline__ void ffn_fix_rows(int pm, bf16* Gm, const float* HU, const float* HP, const float* cw, int tid) {
    for (int it = tid; it < 2 * 22 * 32; it += NTHR) {
        const int q = it & 31, pn = (it >> 5) % 22, which = it / (32 * 22);
        if (which == 0 ? ((pm & 7) == 0) : ((pm & 7) == 7)) continue;
        const int j0 = 128 * (q & 1) + 8 * (q >> 1), f0 = 128 * pn + 4 * q, nb = which == 0 ? pm - 1 : pm + 1;
        const size_t hb = ((size_t)pm * 2 + which) * FF2 + pn * 256 + j0, nbb = ((size_t)nb * 2 + (1 - which)) * FF2 + pn * 256 + j0;
        const f32x4 pg = *(const f32x4*)(HP + hb), pv = *(const f32x4*)(HP + hb + 4), ug = *(const f32x4*)(HU + nbb), uv = *(const f32x4*)(HU + nbb + 4);
        const int jw = which == 0 ? 0 : 2;
        const f32x4 wg = *(const f32x4*)(cw + (size_t)jw * FF2 + f0), wv = *(const f32x4*)(cw + (size_t)jw * FF2 + FF + f0);
        const f32x4 yg = pg + wg * ug, yv = pv + wv * uv;
        unsigned long long o = (unsigned long long)pk2(pg8::silu_f(yg[0]) * yv[0], pg8::silu_f(yg[1]) * yv[1]) | ((unsigned long long)pk2(pg8::silu_f(yg[2]) * yv[2], pg8::silu_f(yg[3]) * yv[3]) << 32);
        *(unsigned long long*)(Gm + tiled(pm * 256 + (which ? 255 : 0), f0, FF >> 5)) = o;
    }
}
__device__ __forceinline__ void mixer_ew_phase(const bf16* CU, const bf16* Bq, bf16* Y, const float* cw, int gtid, int nthreads) {
    constexpr int TC = 32, NFC = D / 8, NITEM = (M / TC) * NFC, NCT = D >> 5;
    for (int it = gtid; it < NITEM; it += nthreads) {
        const int fc = it % NFC, tc = it / NFC, t0 = tc * TC, f0 = fc * 8;
        float w[3][8];
#pragma unroll
        for (int j = 0; j < 3; ++j)
#pragma unroll
            for (int h = 0; h < 2; ++h) { const f32x4 a = *(const f32x4*)(cw + (size_t)j * D + f0 + 4 * h);
#pragma unroll
                for (int e = 0; e < 4; ++e) w[j][4 * h + e] = a[e]; }
        const v4u zero = {0u, 0u, 0u, 0u};
        v4u p = (t0 % SEQ == 0) ? zero : *(const v4u*)(CU + tiled(t0 - 1, f0, NCT));
        v4u c = *(const v4u*)(CU + tiled(t0, f0, NCT));
#pragma unroll 4
        for (int i = 0; i < TC; ++i) {
            const v4u n = (i == TC - 1 && (t0 + TC) % SEQ == 0) ? zero : *(const v4u*)(CU + tiled(t0 + i + 1, f0, NCT));
            const v4u b_ = *(const v4u*)(Bq + tiled(t0 + i, f0, NCT));
            v4u o;
#pragma unroll
            for (int q = 0; q < 4; ++q) {
                const float y0 = bflo(b_[q]) * fmaf(w[0][2 * q], bflo(p[q]), fmaf(w[1][2 * q], bflo(c[q]), w[2][2 * q] * bflo(n[q])));
                const float y1 = bfhi(b_[q]) * fmaf(w[0][2 * q + 1], bfhi(p[q]), fmaf(w[1][2 * q + 1], bfhi(c[q]), w[2][2 * q + 1] * bfhi(n[q])));
                o[q] = pk2(y0, y1);
            }
            *(v4u*)(Y + tiled(t0 + i, f0, NCT)) = o;
            p = c; c = n;
        }
    }
}

#ifndef PROBE_ATTN
#define PROBE_ATTN 1
#endif
#ifndef PROBE_EW
#define PROBE_EW 1
#endif
#ifndef PROBE_QKV
#define PROBE_QKV 1
#endif
__device__ __forceinline__ int opaque_bx() { int b = blockIdx.x; asm volatile("" : "+s"(b)); return b; }
#ifndef PROBE_UP
#define PROBE_UP 1
#endif
#ifndef STAGGER_TICKS
#define STAGGER_TICKS 0
#endif
__device__ __forceinline__ void stagger_start(int ticks) {
    if (ticks <= 0) return;
    const unsigned long long t0 = __builtin_amdgcn_s_memrealtime(); const unsigned long long d = (unsigned long long)(((blockIdx.x >> 3) & 3) * ticks);
    while (__builtin_amdgcn_s_memrealtime() - t0 < d) __builtin_amdgcn_s_sleep(16);
}
typedef const __attribute__((address_space(4))) Args* CArgs;
__device__ __forceinline__ CArgs get_args() { CArgs p = (CArgs)__builtin_amdgcn_kernarg_segment_ptr(); asm volatile("" : "+s"(p)); return p; }
#define WSP(off) (a->ws + (off))
#define WUP_T(l) ((bf16*)WSP(WS_WUP0 + (size_t)(l) * (WS_WUP1 - WS_WUP0)))
#define WDN_T(l) ((bf16*)WSP(WS_WDN0 + (size_t)(l) * (WS_WDN1 - WS_WDN0)))
#define SSQ(i) ((float*)WSP(WS_SSQ + (size_t)(i) * SSQ_BYTES))
#define GEO() int tid = threadIdx.x; asm volatile("" : "+v"(tid)); const int lane = tid & 63, wave = __builtin_amdgcn_readfirstlane(tid >> 6); const int G = gridDim.x, bx = blockIdx.x; \
    const int vcu = (G % 8 == 0) ? (bx % 8) * (G / 8) + bx / 8 : bx; const int gw = vcu * NWAVES + wave, NGW = G * NWAVES, gtid = bx * NTHR + tid, NT = G * NTHR; \
    (void)lane; (void)gw; (void)NGW; (void)gtid; (void)NT; (void)vcu

__global__ void __launch_bounds__(NTHR, 2) mega_fwd(Args a_unused) {
    extern __shared__ __attribute__((aligned(16))) unsigned char lds[];
    cg::grid_group grid = cg::this_grid();
    LAS unsigned char* ldsl = (LAS unsigned char*)lds;
    volatile LAS unsigned* bst = (volatile LAS unsigned*)(ldsl + 147456 - 64);
    if (threadIdx.x < 2) bst[threadIdx.x] = 0u;
    __syncthreads();
    if (blockIdx.x == 0) { unsigned* cw0 = (unsigned*)(get_args()->ws + WS_CTL); for (int i = threadIdx.x; i < (int)(CTL_BYTES / 4); i += NTHR) cw0[i] = 0u; }
#define GRID_SYNC() xcd_barrier(bar)

#ifndef PROBE_PRO
#define PROBE_PRO 1
#endif
    for (int prep = 0; prep < PROBE_PRO; ++prep)
    {
        CArgs a = get_args(); GEO();
        bf16* Wqkv_t = (bf16*)WSP(WS_WQKV); bf16* Wo_t = (bf16*)WSP(WS_WO); bf16* Win_t = (bf16*)WSP(WS_WIN); bf16* Wout_t = (bf16*)WSP(WS_WOUT);
        float* tcos = (float*)WSP(WS_COS); float* tsin = (float*)WSP(WS_SIN); bf16* XB = (bf16*)WSP(WS_XB);
        LAS float* scr = (LAS float*)(ldsl + wave * 16384);
        constexpr int I_QKV = (D / 64) * (3 * D / 32), I_O = (D / 64) * (D / 32), I_UP = (D / 64) * (FF2 / 32), I_DN = (FF / 64) * (D / 32);
        constexpr int NITEMS = 2 * I_QKV + 2 * I_O + 2 * I_UP + 2 * I_DN;
        for (int it = gw; it < NITEMS; it += NGW) {
            int r = it;
            if (r < I_QKV) { transpose_item(a->w_qkv, D, 3 * D, Wqkv_t, a->attn_g, 1, scr, r, lane); continue; } r -= I_QKV;
            if (r < I_QKV) { transpose_item(a->w_in, D, 3 * D, Win_t, a->conv_g, 3, scr, r, lane); continue; } r -= I_QKV;
            if (r < I_O) { transpose_item(a->w_o, D, D, Wo_t, nullptr, 0, scr, r, lane); continue; } r -= I_O;
            if (r < I_O) { transpose_item(a->w_out, D, D, Wout_t, nullptr, 0, scr, r, lane); continue; } r -= I_O;
            if (r < I_UP) { transpose_item(a->w_up, D, FF2, WUP_T(0), a->ffn_g, 2, scr, r, lane); continue; } r -= I_UP;
            if (r < I_UP) { transpose_item(a->w_up + (size_t)D * FF2, D, FF2, WUP_T(1), a->ffn_g + D, 2, scr, r, lane); continue; } r -= I_UP;
            if (r < I_DN) { transpose_item(a->w_dn, FF, D, WDN_T(0), nullptr, 0, scr, r, lane); continue; } r -= I_DN;
            transpose_item(a->w_dn + (size_t)FF * D, FF, D, WDN_T(1), nullptr, 0, scr, r, lane);
        }
        const int* pos = a->pos;
        for (int i = gtid; i < M * 32; i += NT) {
            const int d = i & 31; const float inv = __builtin_amdgcn_exp2f(-(float)d * (13.287712379549449f / 32.0f));
            float s, c; sincos_cw((float)pos[i >> 5] * inv, s, c); tcos[i] = c; tsin[i] = s;
        }
        const float* x = a->x; float* ssq0 = SSQ(0);
        for (int rg = gw; rg < M / 16; rg += NGW) {
            const int row = rg * 16 + (lane >> 2); const float* xr = x + (size_t)row * D + (lane & 3) * 8; bf16* tb = XB + (size_t)rg * (32 * 512) + lane * 8; float s = 0.f;
#pragma unroll 8
            for (int ct = 0; ct < 32; ++ct) { const f32x4 p = __builtin_nontemporal_load((const f32x4*)(xr + ct * 32)), q = __builtin_nontemporal_load((const f32x4*)(xr + ct * 32 + 4));
                s += ((p.x * p.x + p.y * p.y) + (p.z * p.z + p.w * p.w)) + ((q.x * q.x + q.y * q.y) + (q.z * q.z + q.w * q.w));
                v4u o; o.x = pk2(p.x, p.y); o.y = pk2(p.z, p.w); o.z = pk2(q.x, q.y); o.w = pk2(q.z, q.w); *(v4u*)(tb + ct * 512) = o; }
            s = lane_xor_add<1>(s); s = lane_xor_add<2>(s);
            *(f32x4*)(ssq0 + (size_t)row * 16 + 4 * (lane & 3)) = (f32x4){(lane & 3) == 0 ? s : 0.f, 0.f, 0.f, 0.f};
        }
    }
    grid.sync();
    XcdBarrier bar = xcd_barrier_post((unsigned*)(get_args()->ws + WS_CTL), bst);

#ifdef PROBE_SYNC
    for (int rep = 0; rep < PROBE_SYNC; ++rep) GRID_SYNC();
#endif
    {
        CArgs a = get_args();
        pg8::Gemm g{(bf16*)WSP(WS_XB), (bf16*)WSP(WS_WQKV), M, 3 * D, D}; pg8::StaticOrder S; S.init(M, 3 * D, gridDim.x, opaque_bx());
        pg8::EpiRope E{(bf16*)WSP(WS_Q), (bf16*)WSP(WS_K), (bf16*)WSP(WS_V), SSQ(0), (float*)WSP(WS_COS), (float*)WSP(WS_SIN), 0.125f * 1.4426950408889634f};
        stagger_start(STAGGER_TICKS);
        for (int rep = 0; rep < PROBE_QKV; ++rep) pg8::gemm_phase<pg8::EpiRope, pg8::StaticOrder, true, true>(ldsl, g, S, E);
#ifdef PROBE_STORE
        { pg8::EpiStoreOnly EN{(bf16*)WSP(WS_O), 2048, 8}; pg8::gemm_phase<pg8::EpiStoreOnly, pg8::StaticOrder, true, true>(ldsl, g, S, EN); }
#endif
#ifdef PROBE_LOAD
        { pg8::EpiLoadOnly EN{(float*)WSP(WS_STASH), SSQ(0), (float*)WSP(WS_COS), (float*)WSP(WS_SIN)}; pg8::gemm_phase<pg8::EpiLoadOnly, pg8::StaticOrder, true, true>(ldsl, g, S, EN); }
#endif
#ifdef PROBE_KLOOP
        { pg8::EpiNull EN{(float*)WSP(WS_STASH)}; pg8::gemm_phase<pg8::EpiNull, pg8::StaticOrder, true, true>(ldsl, g, S, EN); }
#endif
    }
    GRID_SYNC();
    {
        CArgs a = get_args(); GEO();
        const float lambda_init = 0.8f - 0.6f * 1.0f;
        const float s1 = wave_sum(a->lq1[lane] * a->lk1[lane]), s2 = wave_sum(a->lq2[lane] * a->lk2[lane]);
        const float lam = __expf(s1) - __expf(s2) + lambda_init;
        const bf16* Qb = (const bf16*)WSP(WS_Q); const bf16* Kb = (const bf16*)WSP(WS_K); const bf16* Vb = (const bf16*)WSP(WS_V); bf16* Ob = (bf16*)WSP(WS_O);
        float* stash = (float*)WSP(WS_STASH); const float* subg = a->subg;
#pragma unroll 1
        for (int rep = 0; rep < PROBE_ATTN; ++rep)
#pragma unroll 1
        for (int i = 0;; ++i) {
            const int idf = i * G + vcu; if (idf >= BATCH * NH * (SEQ / 256)) break;
            const int id = BATCH * NH * (SEQ / 256) - 1 - idf;
            const int bh = id >> 3, qb = id & 7;
            att::attn_unit(bh >> 3, bh & 7, qb, Qb, Kb, Vb, Ob, stash, lam, subg, 1.0f - lambda_init, (char*)lds);
        }
    }
    GRID_SYNC();
    {
        CArgs a = get_args();
        pg8::Gemm g{(bf16*)WSP(WS_O), (bf16*)WSP(WS_WO), M, D, D}; pg8::StaticOrder S; S.init(M, D, gridDim.x, opaque_bx());
        pg8::EpiRes<false> E{nullptr, (bf16*)WSP(WS_XB), SSQ(1)};
        pg8::gemm_phase<pg8::EpiRes<false>, pg8::StaticOrder, true, true>(ldsl, g, S, E);
    }
    GRID_SYNC();
#pragma unroll 1
    for (int layer = 0; layer < 2; ++layer) {
        if (layer == 1) {
            {   CArgs a = get_args();
                pg8::Gemm g{(bf16*)WSP(WS_XB), (bf16*)WSP(WS_WIN), M, 3 * D, D}; pg8::StaticOrder S; S.init(M, 3 * D, gridDim.x, opaque_bx());
                pg8::EpiMix E{(bf16*)WSP(WS_Q), (bf16*)WSP(WS_K), SSQ(2)};
                pg8::gemm_phase<pg8::EpiMix, pg8::StaticOrder, true, true>(ldsl, g, S, E); }
            GRID_SYNC();
            {   CArgs a = get_args(); GEO();
                mixer_ew_phase((const bf16*)WSP(WS_Q), (const bf16*)WSP(WS_K), (bf16*)WSP(WS_O), a->conv_w, gtid, NT); }
            GRID_SYNC();
            {   CArgs a = get_args();
                pg8::Gemm g{(bf16*)WSP(WS_O), (bf16*)WSP(WS_WOUT), M, D, D}; pg8::StaticOrder S; S.init(M, D, gridDim.x, opaque_bx());
                pg8::EpiRes<false> E{nullptr, (bf16*)WSP(WS_XB), SSQ(3)};
                pg8::gemm_phase<pg8::EpiRes<false>, pg8::StaticOrder, true, true>(ldsl, g, S, E); }
            GRID_SYNC();
        }
        {   CArgs a = get_args();
            pg8::Gemm g{(bf16*)WSP(WS_XB), WUP_T(layer), M, FF2, D}; pg8::StaticOrder S; S.init(M, FF2, gridDim.x, opaque_bx());
            pg8::EpiFfn E{(bf16*)WSP(WS_G), SSQ(layer == 0 ? 1 : 3), a->ffn_cw + (size_t)layer * 3 * FF2, a->ffn_cb + (size_t)layer * FF2, (float*)WSP(WS_HU), (float*)WSP(WS_HP), ldsl + 131072};
            stagger_start(STAGGER_TICKS);
            for (int rep = 0; rep < PROBE_UP; ++rep) pg8::gemm_phase<pg8::EpiFfn, pg8::StaticOrder, true, true>(ldsl, g, S, E); }
        GRID_SYNC();
        {   CArgs a = get_args();
            pg8::Gemm g{(bf16*)WSP(WS_G), WDN_T(layer), M, D, FF}; pg8::StaticOrder S; S.init(M, D, gridDim.x, opaque_bx()); S.rev = true;
            {   int tid = threadIdx.x; asm volatile("" : "+v"(tid));
                const float* cwl = a->ffn_cw + (size_t)layer * 3 * FF2;
#pragma unroll 1
                for (int i = 0;; ++i) { pg8::Unit u; if (!S.next(i, u)) break; ffn_fix_rows(u.pm, (bf16*)WSP(WS_G), (const float*)WSP(WS_HU), (const float*)WSP(WS_HP), cwl, tid); }
                asm volatile("s_waitcnt vmcnt(0)" ::: "memory"); __syncthreads(); }
#ifdef PROBE_DOWN
            { pg8::EpiNull EN{(float*)WSP(WS_STASH)}; pg8::gemm_phase<pg8::EpiNull, pg8::StaticOrder, true, true>(ldsl, g, S, EN); }
#endif
            pg8::EpiRes<false> E{nullptr, (bf16*)WSP(WS_XB), SSQ(layer == 0 ? 2 : 4)};
            pg8::gemm_phase<pg8::EpiRes<false>, pg8::StaticOrder, true, true>(ldsl, g, S, E); }
        GRID_SYNC();
    }
    {   CArgs a = get_args(); GEO();
        float* out = a->out; const float* fg = a->fin_g; const float* ssq4 = SSQ(4); const bf16* XB = (const bf16*)WSP(WS_XB);
        for (int rg = gw; rg < M / 16; rg += NGW) {
            const int row = rg * 16 + (lane >> 2); const float rs = pg8::row_rstd(ssq4, row);
            const bf16* tb = XB + (size_t)rg * (32 * 512) + lane * 8; float* ob = out + (size_t)row * D + (lane & 3) * 8; const float* gp = fg + (lane & 3) * 8;
#pragma unroll 8
            for (int ct = 0; ct < 32; ++ct) { const v4u q = *(const v4u*)(tb + ct * 512); const f32x4 g0 = *(const f32x4*)(gp + ct * 32), g1 = *(const f32x4*)(gp + ct * 32 + 4);
                __builtin_nontemporal_store((f32x4){bflo(q.x), bfhi(q.x), bflo(q.y), bfhi(q.y)} * rs * g0, (f32x4*)(ob + ct * 32)); __builtin_nontemporal_store((f32x4){bflo(q.z), bfhi(q.z), bflo(q.w), bfhi(q.w)} * rs * g1, (f32x4*)(ob + ct * 32 + 4)); }
        }
    }
}

extern "C" void kernel_launch(void* const* d_in, const int* in_sizes, int n_in, void* d_out, int out_size, void* d_ws, size_t ws_size, hipStream_t stream) {
    static int grid = 0;
    if (grid == 0) {
        if (n_in != 20 || in_sizes[0] != M * D || out_size != M * D || ws_size < WS_END) { fprintf(stderr, "kernel_launch: shape mismatch n_in %d in0 %d out %d ws %zu\n", n_in, n_in > 0 ? in_sizes[0] : -1, out_size, ws_size); grid = -1; return; }
        int dev = 0, cus = 0, per_cu = 0;
        if (hipGetDevice(&dev) != hipSuccess || hipDeviceGetAttribute(&cus, hipDeviceAttributeMultiprocessorCount, dev) != hipSuccess) { grid = -1; return; }
        if (hipFuncSetAttribute((const void*)mega_fwd, hipFuncAttributeMaxDynamicSharedMemorySize, LDS_BYTES) != hipSuccess) { fprintf(stderr, "kernel_launch: hipFuncSetAttribute failed\n"); grid = -1; return; }
        if (hipOccupancyMaxActiveBlocksPerMultiprocessor(&per_cu, (const void*)mega_fwd, NTHR, LDS_BYTES) != hipSuccess || per_cu < 1) { fprintf(stderr, "kernel_launch: occupancy query says %d\n", per_cu); per_cu = 1; }
        (void)hipGetLastError();
        grid = cus;
    }
    if (grid < 0) return;
    Args a{};
    a.x = (const float*)d_in[0]; a.pos = (const int*)d_in[1];
    a.attn_g = (const float*)d_in[2]; a.w_qkv = (const float*)d_in[3]; a.lq1 = (const float*)d_in[4]; a.lk1 = (const float*)d_in[5]; a.lq2 = (const float*)d_in[6]; a.lk2 = (const float*)d_in[7];
    a.subg = (const float*)d_in[8]; a.w_o = (const float*)d_in[9]; a.conv_g = (const float*)d_in[10]; a.w_in = (const float*)d_in[11]; a.conv_w = (const float*)d_in[12]; a.w_out = (const float*)d_in[13];
    a.ffn_g = (const float*)d_in[14]; a.w_up = (const float*)d_in[15]; a.ffn_cw = (const float*)d_in[16]; a.ffn_cb = (const float*)d_in[17]; a.w_dn = (const float*)d_in[18]; a.fin_g = (const float*)d_in[19];
    a.out = (float*)d_out; a.ws = (unsigned char*)d_ws;
    void* args[] = {&a};
    const hipError_t e = hipLaunchCooperativeKernel((const void*)mega_fwd, dim3(grid), dim3(NTHR), args, LDS_BYTES, stream);
    if (e != hipSuccess) fprintf(stderr, "kernel_launch: cooperative launch failed: %s (grid %d)\n", hipGetErrorString(e), grid);
}
```
